# Optimizing an MI355X kernel written in HIP

```python
import jax
import jax.numpy as jnp
from jax import lax
import numpy as np

D_MODEL = 1024
BATCH = 4
SEQ = 4096
DEPTH = 4

RW_HEADS = 8
RW_HEAD = 64
RW_DIM = RW_HEADS * RW_HEAD
RW_LORA_W = 64
RW_LORA_A = 64
RW_LORA_G = 128
RW_SPLITS = [RW_DIM, 2 * RW_DIM, 3 * RW_DIM, 3 * RW_DIM + RW_LORA_W,
             3 * RW_DIM + RW_LORA_W + RW_LORA_A]
SG_GROUPS = 4
SG_CHUNK = 128
SG_GROUP_DIM = 128
SG_DIM = SG_GROUPS * SG_GROUP_DIM
AB_SHIFT_DIM = 3 * RW_DIM + RW_LORA_W + RW_LORA_A + RW_LORA_G
AB_IN_DIM = AB_SHIFT_DIM + 2 * SG_DIM
AB_MIX_DIM = RW_DIM + SG_DIM

MLA_HEADS = 16
MLA_Q_RANK = 256
MLA_KV_RANK = 256
MLA_NOPE = 64
MLA_ROPE = 32
MLA_V = 64
MLA_QK = MLA_NOPE + MLA_ROPE
MLA_IN_DIM = MLA_Q_RANK + MLA_KV_RANK + MLA_ROPE
MLA_MIX_DIM = MLA_HEADS * MLA_V
ROPE_THETA = 10000.0
Q_BLOCK = 128

MEM_LEN = 256
XA_HEADS = 4
XA_HEAD = D_MODEL // XA_HEADS

MOE_GROUPS = 4
MOE_PER_GROUP = 8
MOE_EXPERTS = MOE_GROUPS * MOE_PER_GROUP
MOE_TOPK = 2
MOE_FF = 512
MOE_BLOCK = 128

DN_ALPHA = (2 * DEPTH) ** 0.25
DN_BETA = (8 * DEPTH) ** -0.25
LN_EPS = 1e-5
RMS_EPS = 1e-6
RW_GN_EPS = 64e-5
N_EVEN = (DEPTH + 1) // 2
N_ODD = DEPTH // 2

kernel_name = 'hybrid_rwkv7_sgmlp_mla_hmoe_deepnorm'


def _standardize(x, eps):
    xf = x.astype(jnp.float32)
    mu = jnp.mean(xf, -1, keepdims=True)
    var = jnp.mean(jnp.square(xf - mu), -1, keepdims=True)
    return ((xf - mu) * lax.rsqrt(var + eps)).astype(x.dtype)


def layer_norm(x, g, b, eps=LN_EPS):
    return _standardize(x, eps) * g + b


def rms_norm(x, g, eps=RMS_EPS):
    xf = x.astype(jnp.float32)
    return (xf * lax.rsqrt(jnp.mean(xf * xf, -1, keepdims=True) + eps)).astype(x.dtype) * g


def token_shift(p):
    return jnp.pad(p, ((0, 0), (1, 0), (0, 0)))[:, :-1]


def rwkv7_recurrence(r, w, k, v, kk, a):
    B, S, H, N = r.shape

    def step(state, inp):
        r_t, w_t, k_t, v_t, kk_t, a_t = inp
        sa = jnp.einsum('bhvk,bhk->bhv', state, -kk_t)
        state = (state * w_t[:, :, None, :]
                 + sa[..., None] * (kk_t * a_t)[:, :, None, :]
                 + v_t[..., None] * k_t[:, :, None, :])
        return state, jnp.einsum('bhvk,bhk->bhv', state, r_t)

    xs = tuple(jnp.moveaxis(t.astype(jnp.float32), 1, 0) for t in (r, w, k, v, kk, a))
    state0 = jnp.zeros((B, H, N, N), jnp.float32)
    _, y = lax.scan(step, state0, xs)
    return jnp.moveaxis(y, 0, 1)


def rwkv7_mix(p, w0, w2, a0, a2, g2, k_k, k_a, r_k, gn_g, gn_b):
    B, S, _ = p.shape
    heads = lambda t: t.reshape(B, S, RW_HEADS, RW_HEAD)
    r, k, v, w_lo, a_lo, g_lo = jnp.split(p, RW_SPLITS, axis=-1)
    w_log = -jax.nn.softplus(-(w0 + jnp.tanh(w_lo) @ w2)) - 0.5
    decay = jnp.exp(-jnp.exp(w_log.astype(jnp.float32)))
    a = jax.nn.sigmoid(a0 + a_lo @ a2)
    g = jax.nn.sigmoid(g_lo) @ g2
    kk = heads(k * k_k).astype(jnp.float32)
    kk = kk / jnp.maximum(jnp.sqrt(jnp.sum(kk * kk, -1, keepdims=True)), 1e-12)
    k = k * (1.0 + (a - 1.0) * k_a)
    r_h, k_h, v_h = heads(r), heads(k), heads(v)
    y = rwkv7_recurrence(r_h, heads(decay), k_h, v_h, kk, heads(a))
    y = _standardize(y, RW_GN_EPS).astype(p.dtype).reshape(B, S, RW_DIM) * gn_g + gn_b
    bonus = jnp.sum(r_h * k_h * r_k, -1, keepdims=True) * v_h
    return (y + bonus.reshape(B, S, RW_DIM)) * g


def spatial_gating(pu, pv, ln_g, ln_b, ws, bs):
    B, S, _ = pu.shape
    n_chunk = S // SG_CHUNK
    u = jax.nn.gelu(pu)
    z = jax.nn.gelu(pv).reshape(B, n_chunk, SG_CHUNK, SG_GROUPS, SG_GROUP_DIM)
    z = layer_norm(z, ln_g, ln_b)
    causal = jnp.tril(jnp.ones((SG_CHUNK, SG_CHUNK), dtype=bool))
    wm = jnp.where(causal, ws, jnp.zeros_like(ws))
    zs = jnp.einsum('gts,bcsgd->bctgd', wm, z) + bs.T[:, :, None]
    return u * zs.reshape(B, S, SG_DIM)


def mixer_ab(x, w_in, mu, w0, w2, a0, a2, g2, k_k, k_a, r_k, gn_g, gn_b,
             ln_g, ln_b, ws, bs, w_out):
    p = x @ w_in
    ps = p[..., :AB_SHIFT_DIM]
    pu = p[..., AB_SHIFT_DIM:AB_SHIFT_DIM + SG_DIM]
    pv = p[..., AB_SHIFT_DIM + SG_DIM:]
    ps = ps + (token_shift(ps) - ps) * mu
    ya = rwkv7_mix(ps, w0, w2, a0, a2, g2, k_k, k_a, r_k, gn_g, gn_b)
    yb = spatial_gating(pu, pv, ln_g, ln_b, ws, bs)
    return jnp.concatenate([ya, yb], axis=-1) @ w_out


def rope(x):
    S = x.shape[1]
    half = x.shape[-1] // 2
    inv = ROPE_THETA ** (-jnp.arange(half, dtype=jnp.float32) / half)
    ang = jnp.arange(S, dtype=jnp.float32)[:, None] * inv[None, :]
    cos = jnp.cos(ang)[None, :, None, :]
    sin = jnp.sin(ang)[None, :, None, :]
    xf = x.astype(jnp.float32)
    x1, x2 = xf[..., :half], xf[..., half:]
    return jnp.concatenate([x1 * cos - x2 * sin, x1 * sin + x2 * cos], -1).astype(x.dtype)


def causal_block_attention(q, k, v):
    B, S, H, Dk = q.shape
    n_blk = S // Q_BLOCK
    scale = Dk ** -0.5
    qb = jnp.moveaxis(q.reshape(B, n_blk, Q_BLOCK, H, Dk), 1, 0)
    k_idx = jnp.arange(S)

    def one_block(args):
        q_blk, i = args
        s = jnp.einsum('bqhd,bkhd->bhqk', q_blk, k).astype(jnp.float32) * scale
        q_idx = i * Q_BLOCK + jnp.arange(Q_BLOCK)
        s = jnp.where(k_idx[None, :] <= q_idx[:, None], s, -jnp.inf)
        pr = jax.nn.softmax(s, axis=-1).astype(v.dtype)
        return jnp.einsum('bhqk,bkhd->bqhd', pr, v)

    o = lax.map(one_block, (qb, jnp.arange(n_blk)))
    return jnp.moveaxis(o, 0, 1).reshape(B, S, H, v.shape[-1])


def mla(x, w_in, q_norm, kv_norm, wq_b, wkv_b, w_out):
    B, S, _ = x.shape
    p = x @ w_in
    cq = p[..., :MLA_Q_RANK]
    ckv = p[..., MLA_Q_RANK:MLA_Q_RANK + MLA_KV_RANK]
    k_pe = p[..., MLA_Q_RANK + MLA_KV_RANK:]
    q = (rms_norm(cq, q_norm) @ wq_b).reshape(B, S, MLA_HEADS, MLA_QK)
    kv = (rms_norm(ckv, kv_norm) @ wkv_b).reshape(B, S, MLA_HEADS, MLA_NOPE + MLA_V)
    q_nope, q_pe = q[..., :MLA_NOPE], rope(q[..., MLA_NOPE:])
    k_nope, v = kv[..., :MLA_NOPE], kv[..., MLA_NOPE:]
    k_pe = rope(k_pe[:, :, None, :])
    qf = jnp.concatenate([q_nope, q_pe], -1)
    kf = jnp.concatenate([k_nope, jnp.broadcast_to(k_pe, (B, S, MLA_HEADS, MLA_ROPE))], -1)
    o = causal_block_attention(qf, kf, v)
    return o.reshape(B, S, MLA_MIX_DIM) @ w_out


def mem_cross_attention(x, mem, wq, wkv, wo):
    B, S, D = x.shape
    M = mem.shape[1]
    q = (x @ wq).reshape(B, S, XA_HEADS, XA_HEAD)
    kv = (mem @ wkv).reshape(B, M, 2, XA_HEADS, XA_HEAD)
    k, v = kv[:, :, 0], kv[:, :, 1]
    s = jnp.einsum('bqhd,bmhd->bhqm', q, k).astype(jnp.float32) * (XA_HEAD ** -0.5)
    pr = jax.nn.softmax(s, axis=-1).astype(v.dtype)
    o = jnp.einsum('bhqm,bmhd->bqhd', pr, v)
    return o.reshape(B, S, D) @ wo


def grouped_experts(xf, expert, gate, w_gate, w_up, w_down):
    T, D = xf.shape
    A = T * MOE_TOPK
    n_blk = -(-A // MOE_BLOCK) + MOE_EXPERTS
    L = n_blk * MOE_BLOCK
    flat_e = expert.reshape(-1)
    order = jnp.argsort(flat_e)
    sorted_e = flat_e[order]
    tok = (order // MOE_TOPK).astype(jnp.int32)
    counts = jnp.bincount(flat_e, length=MOE_EXPERTS)
    padded = (counts + MOE_BLOCK - 1) // MOE_BLOCK * MOE_BLOCK
    pad_end = jnp.cumsum(padded)
    pad_start = pad_end - padded
    start = jnp.cumsum(counts) - counts
    dest = (pad_start[sorted_e] + jnp.arange(A) - start[sorted_e]).astype(jnp.int32)
    row_tok = jnp.full((L,), T, dtype=jnp.int32).at[dest].set(tok)
    blk_expert = jnp.minimum(
        jnp.searchsorted(pad_end, jnp.arange(n_blk) * MOE_BLOCK, side='right'),
        MOE_EXPERTS - 1)
    x_rows = jnp.concatenate([xf, jnp.zeros((1, D), xf.dtype)], 0)[row_tok]
    x_rows = x_rows.reshape(n_blk, MOE_BLOCK, D)

    def expert_block(args):
        xb, e = args
        h = jax.nn.silu(xb @ w_gate[e]) * (xb @ w_up[e])
        return h @ w_down[e]

    y_rows = lax.map(expert_block, (x_rows, blk_expert)).reshape(L, D)
    y_assign = y_rows[dest] * gate.reshape(-1)[order][:, None]
    return jax.ops.segment_sum(y_assign, tok, num_segments=T)


def hier_moe(x, w_group, b_group, w_expert, b_expert, w_gate, w_up, w_down):
    B, S, D = x.shape
    xf = x.reshape(-1, D)
    T = xf.shape[0]
    g_logits = (xf @ w_group).astype(jnp.float32) + b_group
    g_prob = jax.nn.softmax(g_logits, axis=-1)
    grp = jnp.argmax(g_logits, axis=-1)
    p_grp = jnp.take_along_axis(g_prob, grp[:, None], axis=-1)
    e_logits = ((xf @ w_expert).astype(jnp.float32) + b_expert).reshape(
        T, MOE_GROUPS, MOE_PER_GROUP)
    e_logits = jnp.take_along_axis(e_logits, grp[:, None, None], axis=1)[:, 0]
    top_v, top_i = lax.top_k(e_logits, MOE_TOPK)
    gate = (jax.nn.softmax(top_v, axis=-1) * p_grp).astype(x.dtype)
    expert = (grp[:, None] * MOE_PER_GROUP + top_i).astype(jnp.int32)
    y = grouped_experts(xf, expert, gate, w_gate, w_up, w_down)
    return y.reshape(B, S, D)


def setup_inputs(seed: int = 0) -> dict:
    key = jax.random.key(seed)
    ks = iter(jax.random.split(key, 48))

    def normal(shape, scale):
        return jax.random.normal(next(ks), shape, jnp.float32) * scale

    def gain(shape):
        return 1.0 + normal(shape, 0.02)

    D = D_MODEL
    NE, NO, L = N_EVEN, N_ODD, DEPTH
    return {
        'x': normal((BATCH, SEQ, D), 1.0),
        'mem': normal((BATCH, MEM_LEN, D), 1.0),
        'ab_w_in': normal((NE, D, AB_IN_DIM), D ** -0.5),
        'ab_mu': jax.random.uniform(next(ks), (NE, AB_SHIFT_DIM), jnp.float32),
        'rw_w0': jax.random.uniform(next(ks), (NE, RW_DIM), jnp.float32, -6.5, -1.5),
        'rw_w2': normal((NE, RW_LORA_W, RW_DIM), 0.5 * RW_LORA_W ** -0.5),
        'rw_a0': normal((NE, RW_DIM), 0.3),
        'rw_a2': normal((NE, RW_LORA_A, RW_DIM), RW_LORA_A ** -0.5),
        'rw_g2': normal((NE, RW_LORA_G, RW_DIM), RW_LORA_G ** -0.5),
        'rw_k_k': 0.85 + normal((NE, RW_DIM), 0.05),
        'rw_k_a': 1.0 + normal((NE, RW_DIM), 0.05),
        'rw_r_k': normal((NE, RW_HEADS, RW_HEAD), 0.1),
        'rw_gn_g': gain((NE, RW_DIM)),
        'rw_gn_b': normal((NE, RW_DIM), 0.02),
        'sg_ln_g': gain((NE, SG_GROUPS, SG_GROUP_DIM)),
        'sg_ln_b': normal((NE, SG_GROUPS, SG_GROUP_DIM), 0.02),
        'sg_ws': normal((NE, SG_GROUPS, SG_CHUNK, SG_CHUNK), 0.5 * SG_CHUNK ** -0.5),
        'sg_b': 1.0 + normal((NE, SG_GROUPS, SG_CHUNK), 0.1),
        'ab_w_out': normal((NE, AB_MIX_DIM, D), DN_BETA * AB_MIX_DIM ** -0.5),
        'mla_w_in': normal((NO, D, MLA_IN_DIM), D ** -0.5),
        'mla_q_norm': gain((NO, MLA_Q_RANK)),
        'mla_kv_norm': gain((NO, MLA_KV_RANK)),
        'mla_wq_b': normal((NO, MLA_Q_RANK, MLA_HEADS * MLA_QK), MLA_Q_RANK ** -0.5),
        'mla_wkv_b': normal((NO, MLA_KV_RANK, MLA_HEADS * (MLA_NOPE + MLA_V)), MLA_KV_RANK ** -0.5),
        'mla_w_out': normal((NO, MLA_MIX_DIM, D), DN_BETA * MLA_MIX_DIM ** -0.5),
        'ln1_g': gain((L, D)),
        'ln1_b': normal((L, D), 0.02),
        'xa_wq': normal((L, D, D), D ** -0.5),
        'xa_wkv': normal((L, D, 2 * D), D ** -0.5),
        'xa_wo': normal((L, D, D), DN_BETA * D ** -0.5),
        'ln2_g': gain((L, D)),
        'ln2_b': normal((L, D), 0.02),
        'moe_w_group': normal((L, D, MOE_GROUPS), D ** -0.5),
        'moe_b_group': normal((L, MOE_GROUPS), 0.01),
        'moe_w_expert': normal((L, D, MOE_EXPERTS), D ** -0.5),
        'moe_b_expert': normal((L, MOE_EXPERTS), 0.01),
        'moe_w_gate': normal((L, MOE_EXPERTS, D, MOE_FF), D ** -0.5),
        'moe_w_up': normal((L, MOE_EXPERTS, D, MOE_FF), D ** -0.5),
        'moe_w_down': normal((L, MOE_EXPERTS, MOE_FF, D), DN_BETA * MOE_FF ** -0.5),
        'ln3_g': gain((L, D)),
        'ln3_b': normal((L, D), 0.02),
    }


def reference(x, mem, ab_w_in, ab_mu, rw_w0, rw_w2, rw_a0, rw_a2, rw_g2, rw_k_k,
              rw_k_a, rw_r_k, rw_gn_g, rw_gn_b, sg_ln_g, sg_ln_b, sg_ws, sg_b,
              ab_w_out, mla_w_in, mla_q_norm, mla_kv_norm, mla_wq_b, mla_wkv_b,
              mla_w_out, ln1_g, ln1_b, xa_wq, xa_wkv, xa_wo, ln2_g, ln2_b,
              moe_w_group, moe_b_group, moe_w_expert, moe_b_expert, moe_w_gate,
              moe_w_up, moe_w_down, ln3_g, ln3_b):
    h = x
    for layer in range(DEPTH):
        j = layer // 2
        if layer % 2 == 0:
            mix = mixer_ab(h, ab_w_in[j], ab_mu[j], rw_w0[j], rw_w2[j], rw_a0[j],
                           rw_a2[j], rw_g2[j], rw_k_k[j], rw_k_a[j], rw_r_k[j],
                           rw_gn_g[j], rw_gn_b[j], sg_ln_g[j], sg_ln_b[j], sg_ws[j],
                           sg_b[j], ab_w_out[j])
        else:
            mix = mla(h, mla_w_in[j], mla_q_norm[j], mla_kv_norm[j], mla_wq_b[j],
                      mla_wkv_b[j], mla_w_out[j])
        h = layer_norm(DN_ALPHA * h + mix, ln1_g[layer], ln1_b[layer])
        xa = mem_cross_attention(h, mem, xa_wq[layer], xa_wkv[layer], xa_wo[layer])
        h = layer_norm(DN_ALPHA * h + xa, ln2_g[layer], ln2_b[layer])
        ff = hier_moe(h, moe_w_group[layer], moe_b_group[layer], moe_w_expert[layer],
                      moe_b_expert[layer], moe_w_gate[layer], moe_w_up[layer],
                      moe_w_down[layer])
        h = layer_norm(DN_ALPHA * h + ff, ln3_g[layer], ln3_b[layer])
    return h
```

```cpp
#include <hip/hip_runtime.h>
#include <stdint.h>
#include <stdio.h>

#ifndef MEGA
#define MEGA 1
#endif
#ifndef FAST_GEMM
#define FAST_GEMM 1
#endif
#ifndef FAST_REC
#define FAST_REC 1
#endif

typedef _Float16 f16;
typedef f16 f16x8 __attribute__((ext_vector_type(8)));
typedef f16 f16x4 __attribute__((ext_vector_type(4)));
typedef float f32x4 __attribute__((ext_vector_type(4)));
typedef float f32x2 __attribute__((ext_vector_type(2)));
#define LAS __attribute__((address_space(3)))

namespace {

constexpr int T = 16384, SEQ = 4096, D = 1024;
constexpr float DN_ALPHA = 1.681792830507429f;
constexpr float LOG2E = 1.4426950408889634f;

constexpr size_t al(size_t x) { return (x + 255) & ~(size_t)255; }
constexpr size_t OFF_BAR   = 0;
constexpr size_t OFF_CNT   = 16384;
constexpr size_t OFF_ROPE  = 32768;
constexpr size_t OFF_H32   = OFF_ROPE + al((size_t)SEQ * 16 * 8);
constexpr size_t OFF_MUP   = OFF_H32;
constexpr size_t OFF_MCP   = OFF_MUP + al((size_t)128 * 16 * 1024 * 4);
constexpr size_t OFF_MU    = OFF_MCP + al((size_t)128 * 16 * 1024 * 4);
constexpr size_t OFF_MC    = OFF_MU + al((size_t)128 * 1024 * 4);
constexpr size_t OFF_RUC   = OFF_MC + al((size_t)128 * 1024 * 4);
static_assert(OFF_RUC + 4096 <= OFF_H32 + (size_t)T * D * 4, "fold vectors fit in the old f32 residual buffer");
constexpr size_t OFF_H16   = OFF_H32 + al((size_t)T * D * 4);
constexpr size_t OFF_MEM16 = OFF_H16 + al((size_t)T * D * 2);
constexpr size_t OFF_KVMEM = OFF_MEM16 + al((size_t)1024 * 1024 * 2);
constexpr size_t OFF_XM    = OFF_KVMEM + al((size_t)4 * 1024 * 2048 * 2);
constexpr size_t OFF_XN    = OFF_XM + al((size_t)16 * 1024 * 1024 * 2);
constexpr size_t OFF_XUP   = OFF_XN + al((size_t)16 * 1024 * 1024 * 2);
constexpr size_t OFF_XCP   = OFF_XUP + al((size_t)16 * 1024 * 16 * 4);
constexpr size_t OFF_XU    = OFF_XCP + al((size_t)16 * 1024 * 16 * 4);
constexpr size_t OFF_XC    = OFF_XU + al((size_t)16 * 1024 * 4);
constexpr size_t W_ABIN    = OFF_XC + al((size_t)16 * 1024 * 4);
constexpr size_t W_W2T     = W_ABIN + al((size_t)2 * 2816 * 1024 * 2);
constexpr size_t W_A2T     = W_W2T + al((size_t)2 * 512 * 64 * 2);
constexpr size_t W_G2T     = W_A2T + al((size_t)2 * 512 * 64 * 2);
constexpr size_t W_SGW     = W_G2T + al((size_t)2 * 512 * 128 * 2);
constexpr size_t W_ABOUT   = W_SGW + al((size_t)2 * 4 * 128 * 128 * 2);
constexpr size_t W_MLAIN   = W_ABOUT + al((size_t)2 * 1024 * 1024 * 2);
constexpr size_t W_Q       = W_MLAIN + al((size_t)2 * 640 * 1024 * 2);
constexpr size_t W_KV      = W_Q + al((size_t)2 * 1536 * 256 * 2);
constexpr size_t W_MLAOUT  = W_KV + al((size_t)2 * 2048 * 256 * 2);
constexpr size_t W_XAQ     = W_MLAOUT + al((size_t)2 * 1024 * 1024 * 2);
constexpr size_t W_XAKV    = W_XAQ + al((size_t)4 * 1024 * 1024 * 2);
constexpr size_t W_XAO     = W_XAKV + al((size_t)4 * 2048 * 1024 * 2);
constexpr size_t W_ROUTER  = W_XAO + al((size_t)4 * 1024 * 1024 * 2);
constexpr size_t W_GU      = W_ROUTER + al((size_t)4 * 128 * 1024 * 2);
constexpr size_t W_D       = W_GU + al((size_t)4 * 32 * 1024 * 1024 * 2);
constexpr size_t OFF_SCR   = W_D + al((size_t)4 * 32 * 1024 * 512 * 2);
constexpr size_t S_P16   = OFF_SCR;
constexpr size_t S_PS16  = S_P16 + al((size_t)T * 2816 * 2);
constexpr size_t S_WD32  = S_PS16 + al((size_t)T * 1792 * 2);
constexpr size_t S_NKK   = S_WD32 + al((size_t)T * 512 * 4);
constexpr size_t S_BB    = S_NKK + al((size_t)T * 512 * 2);
constexpr size_t S_KP    = S_BB + al((size_t)T * 512 * 2);
constexpr size_t S_G16   = S_KP + al((size_t)T * 512 * 2);
constexpr size_t S_BSUM  = S_G16 + al((size_t)T * 512 * 2);
constexpr size_t S_Y32   = S_BSUM + al((size_t)T * 8 * 4);
constexpr size_t S_ZT    = S_Y32 + al((size_t)T * 512 * 4);
constexpr size_t S_MIX16 = S_ZT + al((size_t)512 * 128 * 128 * 2);
constexpr size_t S_YT    = S_MIX16 + al((size_t)T * 1024 * 2);
constexpr size_t S_SMID  = S_YT + al((size_t)T * 512 * 4);
constexpr size_t S_END_EVEN = S_SMID + al((size_t)32 * 64 * 64 * 4);
constexpr size_t S_CQKV  = OFF_SCR;
constexpr size_t S_KPE   = S_CQKV + al((size_t)T * 512 * 2);
constexpr size_t S_Q16   = S_KPE + al((size_t)T * 32 * 2);
constexpr size_t S_KN16  = S_Q16 + al((size_t)T * 1536 * 2);
constexpr size_t S_VT16  = S_KN16 + al((size_t)T * 1024 * 2);
constexpr size_t S_SSQ   = S_VT16 + al((size_t)T * 1024 * 2);
constexpr size_t S_END_ODD = S_SSQ + al((size_t)T * 8 * 4);
constexpr size_t S_XP16  = OFF_SCR;
constexpr size_t S_XLP   = S_XP16 + al((size_t)T * 1024 * 2);
constexpr size_t S_XSTAT = S_XLP + al((size_t)T * 16 * 4);
constexpr size_t S_PST1  = S_XSTAT + al((size_t)T * 2 * 4);
constexpr size_t S_PST2  = OFF_SCR + (size_t)192 * 1024 * 1024;
static_assert(S_PST2 + (size_t)T * 32 * 4 <= S_MIX16, "pst2 overlay");
constexpr size_t S_LIST  = OFF_SCR;
constexpr size_t S_GATES = S_LIST + al((size_t)32 * 16384 * 4);
constexpr size_t S_HBUF  = S_GATES + al((size_t)T * 2 * 4);
constexpr size_t S_FF16  = S_HBUF + al((size_t)36864 * 512 * 2);
constexpr size_t S_END_MOE = S_FF16 + al((size_t)2 * T * 1024 * 2);
constexpr size_t S_Y32R  = OFF_SCR + (size_t)128 * 1024 * 1024;
static_assert(S_Y32R + (size_t)T * 1024 * 4 <= S_MIX16, "y32 overlay");
static_assert(S_END_ODD <= S_MIX16, "odd overlay");
static_assert(S_END_MOE <= S_MIX16, "moe overlay");
static_assert(S_END_EVEN <= (size_t)1024 * 1024 * 1024, "workspace");

constexpr int SMEM_MAIN = 65536;
constexpr int SMEM_BYTES = SMEM_MAIN + 2048;

struct Params {
    const float* in[41];
    float* out;
    char* ws;
    int ph_begin, ph_end;
};

__device__ __forceinline__ int opq_s(int x) { asm volatile("" : "+v"(x)); return __builtin_amdgcn_readfirstlane(x); }
__device__ __forceinline__ int opq_v(int x) { asm volatile("" : "+v"(x)); return x; }
#define TID opq_v((int)threadIdx.x)
#define BID opq_s((int)blockIdx.x)
#define NBLK opq_s((int)gridDim.x)
__device__ __forceinline__ const float* opq_p(const float* q) {
    const uint64_t u = (uint64_t)q; uint32_t lo = (uint32_t)u, hi = (uint32_t)(u >> 32);
    asm volatile("" : "+v"(lo), "+v"(hi));
    lo = __builtin_amdgcn_readfirstlane(lo); hi = __builtin_amdgcn_readfirstlane(hi);
    return (const float*)(((uint64_t)hi << 32) | lo);
}
typedef const __attribute__((address_space(4))) Params* KargPtr;
__device__ __forceinline__ KargPtr kparams() {
    const uint64_t u = (uint64_t)__builtin_amdgcn_kernarg_segment_ptr(); uint32_t lo = (uint32_t)u, hi = (uint32_t)(u >> 32);
    asm volatile("" : "+v"(lo), "+v"(hi));
    lo = __builtin_amdgcn_readfirstlane(lo); hi = __builtin_amdgcn_readfirstlane(hi);
    return (KargPtr)(((uint64_t)hi << 32) | lo);
}
#define IN(k) (kparams()->in[k])
#define WS (kparams()->ws)

__device__ __forceinline__ float sigmoid_(float x) { return 1.0f / (1.0f + __expf(-x)); }
__device__ __forceinline__ float tanh_(float x) { return 1.0f - 2.0f / (1.0f + __expf(2.0f * x)); }
__device__ __forceinline__ float gelu_(float x) { const float u = 0.7978845608028654f * (x + 0.044715f * x * x * x); return 0.5f * x * (1.0f + tanh_(u)); }
__device__ __forceinline__ float dpp_ror(float x, int) { return x; }
__device__ __forceinline__ float row16_sum(float x) {
    x += __builtin_bit_cast(float, __builtin_amdgcn_update_dpp(0, __builtin_bit_cast(int, x), 0x128, 0xf, 0xf, false));
    x += __builtin_bit_cast(float, __builtin_amdgcn_update_dpp(0, __builtin_bit_cast(int, x), 0x124, 0xf, 0xf, false));
    x += __builtin_bit_cast(float, __builtin_amdgcn_update_dpp(0, __builtin_bit_cast(int, x), 0x122, 0xf, 0xf, false));
    x += __builtin_bit_cast(float, __builtin_amdgcn_update_dpp(0, __builtin_bit_cast(int, x), 0x121, 0xf, 0xf, false));
    return x;
}
__device__ __forceinline__ float wave_sum(float x) {
    x += __shfl_xor(x, 32); x += __shfl_xor(x, 16); x += __shfl_xor(x, 8); x += __shfl_xor(x, 4); x += __shfl_xor(x, 2); x += __shfl_xor(x, 1);
    return x;
}
__device__ __forceinline__ f16x4 cvt4(f32x4 v) { return __builtin_convertvector(v, f16x4); }
__device__ __forceinline__ f32x4 cvt4f(f16x4 v) { return __builtin_convertvector(v, f32x4); }

#define BSYNC() do { asm volatile("s_waitcnt lgkmcnt(0)" ::: "memory"); __syncthreads(); } while (0)

#define XB_TMO      128
#define XB_XCNT(j)  (256  + 64 * (j))
#define XB_XSUB(j)  (1280 + 64 * (j))
#define XB_XGEN(j)  (2304 + 64 * (j))
#define XB_TOP      3328
#define XB_TOPGEN   3392
#define XCD_BAR_WORDS 3456
#define XB_SPIN_CAP (1u << 22)
__device__ __forceinline__ unsigned xb_ld(unsigned* p) { return __hip_atomic_load(p, __ATOMIC_RELAXED, __HIP_MEMORY_SCOPE_AGENT); }
__device__ __forceinline__ unsigned xb_add(unsigned* p, unsigned v) { return __hip_atomic_fetch_add(p, v, __ATOMIC_RELAXED, __HIP_MEMORY_SCOPE_AGENT); }
__device__ __forceinline__ unsigned xb_xcc_id() { return (unsigned)__builtin_amdgcn_s_getreg((3 << 11) | 20) & 0xFu; }
#define XB_SPIN(cond, bar) do { unsigned _sp = 0; while (cond) { __builtin_amdgcn_s_sleep(1); \
    if ((++_sp & 255u) == 0u) { if (xb_ld(&(bar)[XB_TMO])) break; if (_sp > XB_SPIN_CAP) { atomicAdd(&(bar)[XB_TMO], 1u); break; } } } } while (0)
struct XcdBarrier { unsigned* bar; unsigned x; volatile LAS unsigned* st; };
__device__ __forceinline__ XcdBarrier xcd_barrier_post(unsigned* bar, volatile LAS unsigned* st) {
    XcdBarrier b; b.bar = bar; b.x = xb_xcc_id(); b.st = st;
    if (threadIdx.x == 0) (void)xb_add(&bar[XB_XCNT(b.x)], 1u);
    return b;
}
__device__ __forceinline__ void xcd_barrier_complete(unsigned* bar, unsigned x, unsigned& nloc, unsigned& nx) {
    const unsigned G = gridDim.x;
    unsigned sum, cnt, mine, sp = 0u;
    for (;;) {
        sum = 0u; cnt = 0u; mine = 0u;
#pragma unroll
        for (unsigned j = 0; j < 16; ++j) { const unsigned c = xb_ld(&bar[XB_XCNT(j)]); sum += c; cnt += (c > 0u) ? 1u : 0u; mine = (j == x) ? c : mine; }
        if (sum == G) break;
        __builtin_amdgcn_s_sleep(1);
        if ((++sp & 255u) == 0u) { if (xb_ld(&bar[XB_TMO])) break; if (sp > XB_SPIN_CAP) { atomicAdd(&bar[XB_TMO], 1u); break; } }
    }
    nloc = mine > 0u ? mine : 1u; nx = cnt > 0u ? cnt : 1u;
}
__device__ __forceinline__ void xcd_barrier(const XcdBarrier& b) {
    asm volatile("s_waitcnt vmcnt(0)" ::: "memory");
    __syncthreads();
    if (threadIdx.x == 0) {
        unsigned* bar = b.bar;
        __builtin_amdgcn_s_waitcnt(0);
        unsigned nloc = b.st[0], nx = b.st[1];
        if (nloc == 0u) { xcd_barrier_complete(bar, b.x, nloc, nx); b.st[0] = nloc; b.st[1] = nx; }
        const unsigned old = xb_add(&bar[XB_XSUB(b.x)], 1u);
        const unsigned gen = old / nloc;
        if (old + 1u == (gen + 1u) * nloc) {
            __builtin_amdgcn_fence(__ATOMIC_RELEASE, "agent");
            asm volatile("s_waitcnt vmcnt(0)" ::: "memory");
            const unsigned og = xb_add(&bar[XB_TOP], 1u);
            const unsigned tg = og / nx;
            if (og + 1u == (tg + 1u) * nx) xb_add(&bar[XB_TOPGEN], 1u);
            else XB_SPIN(xb_ld(&bar[XB_TOPGEN]) == tg, bar);
            __builtin_amdgcn_fence(__ATOMIC_ACQUIRE, "agent");
            xb_add(&bar[XB_XGEN(b.x)], 1u);
            asm volatile("s_waitcnt vmcnt(0)" ::: "memory");
        } else {
            XB_SPIN(xb_ld(&bar[XB_XGEN(b.x)]) == gen, bar);
            __builtin_amdgcn_fence(__ATOMIC_ACQUIRE, "agent");
            asm volatile("s_waitcnt vmcnt(0)" ::: "memory");
        }
    }
    __syncthreads();
}

struct NoSeg { __device__ __forceinline__ void operator()(int, f32x4 (&)[4][4]) const {} };
template <bool TRANS, class XR, class WR, class SEG = NoSeg>
__device__ __forceinline__ void gemm_core(f32x4 (&acc)[4][4], XR xrow, WR wrow, const int nk, char* smem, SEG seg = SEG()) {
    const int tid = TID, lane = tid & 63, wid = tid >> 6, wr = wid >> 1, wc = wid & 1, fr = lane & 15, fq = lane >> 4;
#pragma unroll
    for (int m = 0; m < 4; ++m)
#pragma unroll
        for (int n = 0; n < 4; ++n) acc[m][n] = (f32x4){0.f, 0.f, 0.f, 0.f};
#if FAST_GEMM
    const int sc = ((tid & 7) ^ ((tid >> 4) & 7)) * 8;
    const f16* px[4]; const f16* pw[4];
#pragma unroll
    for (int i = 0; i < 4; ++i) { px[i] = xrow((tid >> 3) + 32 * i) + sc; pw[i] = wrow((tid >> 3) + 32 * i) + sc; }
    const int rd0 = ((0 * 4 + fq) ^ (fr >> 1)) * 16, rd1 = ((1 * 4 + fq) ^ (fr >> 1)) * 16;
    const int xoff = (wr * 64 + fr) * 128, woff = 16384 + (wc * 64 + fr) * 128;
    BSYNC();
    auto stage = [&](int kt, int s) {
        char* base = smem + s * 32768 + tid * 16;
#pragma unroll
        for (int i = 0; i < 4; ++i) {
            __builtin_amdgcn_global_load_lds((const void*)(px[i] + kt * 64), (LAS void*)(base + i * 4096), 16, 0, 0);
            __builtin_amdgcn_global_load_lds((const void*)(pw[i] + kt * 64), (LAS void*)(base + 16384 + i * 4096), 16, 0, 0);
        }
    };
    stage(0, 0);
    for (int kt = 0; kt < nk; ++kt) {
        const int s = kt & 1;
        asm volatile("s_waitcnt vmcnt(0)" ::: "memory");
        BSYNC();
        if (kt + 1 < nk) stage(kt + 1, s ^ 1);
        seg(kt, acc);
        const char* bs = smem + s * 32768;
#pragma unroll
        for (int kk = 0; kk < 2; ++kk) {
            const int rd = kk ? rd1 : rd0;
            f16x8 xf[4], wf[4];
#pragma unroll
            for (int m = 0; m < 4; ++m) xf[m] = *(const f16x8*)(bs + xoff + m * 2048 + rd);
#pragma unroll
            for (int n = 0; n < 4; ++n) wf[n] = *(const f16x8*)(bs + woff + n * 2048 + rd);
#pragma unroll
            for (int m = 0; m < 4; ++m)
#pragma unroll
                for (int n = 0; n < 4; ++n)
                    acc[m][n] = TRANS ? __builtin_amdgcn_mfma_f32_16x16x32_f16(wf[n], xf[m], acc[m][n], 0, 0, 0)
                                      : __builtin_amdgcn_mfma_f32_16x16x32_f16(xf[m], wf[n], acc[m][n], 0, 0, 0);
        }
    }
#else
    float* ctile = (float*)smem;
    BSYNC();
    for (int i = 0; i < 64; ++i) {
        const int idx = tid + 256 * i, r = idx >> 7, c = idx & 127;
        const f16* xp = xrow(r); const f16* wp = wrow(c);
        float s = 0.f;
        for (int k = 0; k < nk * 64; k += 8) {
            const f16x8 a = *(const f16x8*)(xp + k), b = *(const f16x8*)(wp + k);
#pragma unroll
            for (int e = 0; e < 8; ++e) s += (float)a[e] * (float)b[e];
        }
        ctile[idx] = s;
    }
    BSYNC();
#pragma unroll
    for (int m = 0; m < 4; ++m)
#pragma unroll
        for (int n = 0; n < 4; ++n)
#pragma unroll
            for (int j = 0; j < 4; ++j)
                acc[m][n][j] = TRANS ? ctile[(wr * 64 + m * 16 + fr) * 128 + wc * 64 + n * 16 + 4 * fq + j] : ctile[(wr * 64 + m * 16 + 4 * fq + j) * 128 + wc * 64 + n * 16 + fr];
    BSYNC();
#endif
}

template <class TR> __device__ __forceinline__ void row_stats_table(const float* pst, TR tokrow, float* srow) {
    const int tid = TID;
    float su = 0.f, sq = 0.f;
    if (tid < 128) {
        const float* ps = pst + (size_t)tokrow(tid) * 32;
#pragma unroll
        for (int i = 0; i < 8; ++i) { const f32x4 v = *(const f32x4*)(ps + i * 4); su += v[0] + v[2]; sq += v[1] + v[3]; }
    }
    BSYNC();
    if (tid < 128) {
        const float mean = su * (1.0f / 1024.0f), var = fmaxf(sq * (1.0f / 1024.0f) - mean * mean, 0.f);
        srow[tid * 2] = mean; srow[tid * 2 + 1] = rsqrtf(var + 1e-5f);
    }
}

struct GPipe { int staged, b0; };
template <bool TRANS, class XP, class WP, class SEG = NoSeg>
__device__ __forceinline__ void gemm_core_pf(f32x4 (&acc)[4][4], XP xp, WP wp, int rt, int ct, const int nk, bool has_next, int nrt, int nct, GPipe& gp,
                                             char* smem, SEG seg = SEG()) {
    const int tid = TID, lane = tid & 63, wid = tid >> 6, wr = wid >> 1, wc = wid & 1, fr = lane & 15, fq = lane >> 4;
#pragma unroll
    for (int m = 0; m < 4; ++m)
#pragma unroll
        for (int n = 0; n < 4; ++n) acc[m][n] = (f32x4){0.f, 0.f, 0.f, 0.f};
    const int sc = ((tid & 7) ^ ((tid >> 4) & 7)) * 8;
    const f16* px[4]; const f16* pw[4];
#pragma unroll
    for (int i = 0; i < 4; ++i) { px[i] = xp(rt, ct, (tid >> 3) + 32 * i) + sc; pw[i] = wp(rt, ct, (tid >> 3) + 32 * i) + sc; }
    const int rd0 = ((0 * 4 + fq) ^ (fr >> 1)) * 16, rd1 = ((1 * 4 + fq) ^ (fr >> 1)) * 16;
    const int xoff = (wr * 64 + fr) * 128, woff = 16384 + (wc * 64 + fr) * 128;
    auto stage = [&](int kt, int s) {
        char* base = smem + s * 32768 + tid * 16;
#pragma unroll
        for (int i = 0; i < 4; ++i) {
            __builtin_amdgcn_global_load_lds((const void*)(px[i] + kt * 64), (LAS void*)(base + i * 4096), 16, 0, 0);
            __builtin_amdgcn_global_load_lds((const void*)(pw[i] + kt * 64), (LAS void*)(base + 16384 + i * 4096), 16, 0, 0);
        }
    };
    if (!gp.staged) { BSYNC(); gp.b0 = 0; stage(0, 0); }
    const int b0 = gp.b0;
    for (int kt = 0; kt < nk; ++kt) {
        const int s = (kt + b0) & 1;
        asm volatile("s_waitcnt vmcnt(0)" ::: "memory");
        BSYNC();
        if (kt + 1 < nk) stage(kt + 1, s ^ 1);
        else if (has_next) {
            char* base = smem + (s ^ 1) * 32768 + tid * 16;
#pragma unroll
            for (int i = 0; i < 4; ++i) {
                __builtin_amdgcn_global_load_lds((const void*)(xp(nrt, nct, (tid >> 3) + 32 * i) + sc), (LAS void*)(base + i * 4096), 16, 0, 0);
                __builtin_amdgcn_global_load_lds((const void*)(wp(nrt, nct, (tid >> 3) + 32 * i) + sc), (LAS void*)(base + 16384 + i * 4096), 16, 0, 0);
            }
        }
        seg(kt, acc);
        const char* bs = smem + s * 32768;
#pragma unroll
        for (int kk = 0; kk < 2; ++kk) {
            const int rd = kk ? rd1 : rd0;
            f16x8 xf[4], wf[4];
#pragma unroll
            for (int m = 0; m < 4; ++m) xf[m] = *(const f16x8*)(bs + xoff + m * 2048 + rd);
#pragma unroll
            for (int n = 0; n < 4; ++n) wf[n] = *(const f16x8*)(bs + woff + n * 2048 + rd);
#pragma unroll
            for (int m = 0; m < 4; ++m)
#pragma unroll
                for (int n = 0; n < 4; ++n)
                    acc[m][n] = TRANS ? __builtin_amdgcn_mfma_f32_16x16x32_f16(wf[n], xf[m], acc[m][n], 0, 0, 0)
                                      : __builtin_amdgcn_mfma_f32_16x16x32_f16(xf[m], wf[n], acc[m][n], 0, 0, 0);
        }
    }
    gp.staged = has_next ? 1 : 0; gp.b0 = ((nk - 1 + b0) & 1) ^ 1;
}

template <class F> __device__ __forceinline__ void tile_loop2(int nrt, int nct, F f) {
    const int xcd = BID & 7, lb = BID >> 3, nlb = NBLK >> 3;
    const int per = (nrt >> 3) * nct;
    for (int j = lb; j < per; j += nlb) {
        const int jn = j + nlb; const bool hn = jn < per; const int je = hn ? jn : j;
        f(((j / nct) << 3) + xcd, j % nct, hn, ((je / nct) << 3) + xcd, je % nct);
    }
}

template <class F> __device__ __forceinline__ void tile_loop(int nrt, int nct, F f) {
    const int xcd = BID & 7, lb = BID >> 3, nlb = NBLK >> 3;
    const int per = (nrt >> 3) * nct;
    for (int j = lb; j < per; j += nlb) f(((j / nct) << 3) + xcd, j % nct);
}

#define WAVE_IDS const int tid = TID, lane = tid & 63, wid = tid >> 6, wr = wid >> 1, wc = wid & 1, fr = lane & 15, fq = lane >> 4; (void)lane; (void)wid; (void)wr; (void)wc; (void)fr; (void)fq;

template <class RowMap, class KScale>
__device__ __forceinline__ void conv_T(const float* src, f16* dst, int nbatch, int K, int N, size_t src_bs, size_t dst_bs, int ldd, RowMap rowmap, KScale kscale, int& off, float* tile, int myid, int G) {
    const int tk = K / 64, tn = (N + 63) / 64, total = nbatch * tk * tn, t = TID;
    int start = (myid - off) % G; if (start < 0) start += G;
    for (int i = start; i < total; i += G) {
        const int bi = i / (tk * tn), r = i % (tk * tn), k0 = (r / tn) * 64, n0 = (r % tn) * 64;
        BSYNC();
#pragma unroll
        for (int j = 0; j < 4; ++j) {
            const int k = (t >> 4) + 16 * j, c = (t & 15) * 4;
            f32x4 v = {0.f, 0.f, 0.f, 0.f};
            if (n0 + c < N) v = *(const f32x4*)(src + (size_t)bi * src_bs + (size_t)(k0 + k) * N + n0 + c);
            const float s = kscale(k0 + k);
            tile[k * 65 + c + 0] = v[0] * s; tile[k * 65 + c + 1] = v[1] * s; tile[k * 65 + c + 2] = v[2] * s; tile[k * 65 + c + 3] = v[3] * s;
        }
        BSYNC();
        const int n = t >> 2, kc = (t & 3) * 16;
        if (n0 + n < N) {
            f16x8 o0, o1;
#pragma unroll
            for (int j = 0; j < 8; ++j) { o0[j] = (f16)tile[(kc + j) * 65 + n]; o1[j] = (f16)tile[(kc + 8 + j) * 65 + n]; }
            f16* dp = dst + (size_t)bi * dst_bs + (size_t)rowmap(n0 + n) * ldd + k0 + kc;
            *(f16x8*)dp = o0; *(f16x8*)(dp + 8) = o1;
        }
    }
    off = (off + total) % G;
}

template <class RowMap>
__device__ __forceinline__ void conv_T_fold(const float* src, f16* dst, const float* g2all, const float* b2all, float* up, float* cp, RowMap rowmap, int& off, float* tile, int myid, int G) {
    constexpr int K = 1024, N = 512, tk = K / 64, tn = N / 64, total = 128 * tk * tn;
    const int t = TID;
    int start = (myid - off) % G; if (start < 0) start += G;
    for (int i = start; i < total; i += G) {
        const int bi = i / (tk * tn), r = i % (tk * tn), k0 = (r / tn) * 64, n0 = (r % tn) * 64;
        BSYNC();
#pragma unroll
        for (int j = 0; j < 4; ++j) {
            const int k = (t >> 4) + 16 * j, c = (t & 15) * 4;
            const f32x4 v = *(const f32x4*)(src + (size_t)bi * K * N + (size_t)(k0 + k) * N + n0 + c);
            tile[k * 65 + c + 0] = v[0]; tile[k * 65 + c + 1] = v[1]; tile[k * 65 + c + 2] = v[2]; tile[k * 65 + c + 3] = v[3];
        }
        BSYNC();
        const int n = t >> 2, kc = (t & 3) * 16;
        const float* g2 = g2all + (bi >> 5) * 1024 + k0 + kc; const float* b2 = b2all + (bi >> 5) * 1024 + k0 + kc;
        f16x8 o0, o1; float us = 0.f, cs = 0.f;
#pragma unroll
        for (int j = 0; j < 8; ++j) {
            const float v0 = tile[(kc + j) * 65 + n], v1 = tile[(kc + 8 + j) * 65 + n];
            o0[j] = (f16)(v0 * g2[j]); o1[j] = (f16)(v1 * g2[8 + j]);
            us += (float)o0[j] + (float)o1[j]; cs += v0 * b2[j] + v1 * b2[8 + j];
        }
        const int drow = rowmap(n0 + n);
        f16* dp = dst + (size_t)bi * 1024 * 1024 + (size_t)drow * 1024 + k0 + kc;
        *(f16x8*)dp = o0; *(f16x8*)(dp + 8) = o1;
        us += __shfl_xor(us, 1); us += __shfl_xor(us, 2); cs += __shfl_xor(cs, 1); cs += __shfl_xor(cs, 2);
        if ((t & 3) == 0) { const size_t o = ((size_t)bi * 16 + (k0 >> 6)) * 1024 + drow; up[o] = us; cp[o] = cs; }
    }
    off = (off + total) % G;
}

__device__ __forceinline__ void moe_uc_reduce(const Params& p) {
    const float* up = (const float*)(WS + OFF_MUP); const float* cp = (const float*)(WS + OFF_MCP);
    float* mu = (float*)(WS + OFF_MU); float* mc = (float*)(WS + OFF_MC);
    for (int i = BID * 256 + TID; i < 128 * 1024; i += NBLK * 256) {
        const int bi = i >> 10, row = i & 1023;
        float a = 0.f, c = 0.f;
#pragma unroll
        for (int kt = 0; kt < 16; ++kt) { a += up[((size_t)bi * 16 + kt) * 1024 + row]; c += cp[((size_t)bi * 16 + kt) * 1024 + row]; }
        mu[i] = a; mc[i] = c;
    }
}

__device__ __forceinline__ void phase_convert(const Params& p, char* smem) {
    char* ws = WS;
    float* tile = (float*)smem;
    const int gtid = BID * 256 + TID, gsz = NBLK * 256;
    int off = 0;
    const int cb = BID, cn = NBLK;
    auto ident = [](int n) { return n; };
    auto one = [](int) { return 1.0f; };
    {
        const float* x = IN(0); f16* h16 = (f16*)(ws + OFF_H16);
        for (size_t i = gtid; i < (size_t)T * D / 4; i += gsz) *(f16x4*)(h16 + i * 4) = cvt4(*(const f32x4*)(x + i * 4));
        const float* mem = IN(1); f16* m16 = (f16*)(ws + OFF_MEM16);
        for (size_t i = gtid; i < (size_t)1024 * 1024 / 4; i += gsz) *(f16x4*)(m16 + i * 4) = cvt4(*(const f32x4*)(mem + i * 4));
    }
    {
        const float* w = IN(16); f16* o = (f16*)(ws + W_SGW);
        for (int i = gtid; i < 2 * 4 * 128 * 128; i += gsz) { const int s = i & 127, tt = (i >> 7) & 127; o[i] = (s <= tt) ? (f16)w[i] : (f16)0.f; }
    }
    {
        f32x2* rt = (f32x2*)(ws + OFF_ROPE);
        for (int i = gtid; i < SEQ * 16; i += gsz) {
            const int pos = i >> 4, fi = i & 15;
            const double inv = exp2(-(double)fi * (13.287712379549449 / 16.0));
            double rev = (double)pos * inv * 0.15915494309189535;
            rev -= floor(rev);
            const float fr_ = (float)rev;
            rt[i] = (f32x2){__builtin_amdgcn_cosf(fr_), __builtin_amdgcn_sinf(fr_)};
        }
    }
    {
        unsigned* cnt = (unsigned*)(ws + OFF_CNT);
        if (gtid < 128) cnt[gtid] = 0u;
        f16* wr_ = (f16*)(ws + W_ROUTER);
        for (int i = gtid; i < 4 * 92 * 1024; i += gsz) { const int l = i / (92 * 1024), r = i % (92 * 1024); wr_[(size_t)l * 128 * 1024 + 36 * 1024 + r] = (f16)0.f; }
        f16* wm = (f16*)(ws + W_MLAIN);
        for (int i = gtid; i < 2 * 96 * 1024; i += gsz) { const int l = i / (96 * 1024), r = i % (96 * 1024); wm[(size_t)l * 640 * 1024 + 544 * 1024 + r] = (f16)0.f; }
    }
    conv_T(IN(2), (f16*)(ws + W_ABIN), 2, 1024, 2816, (size_t)1024 * 2816, (size_t)2816 * 1024, 1024, ident, one, off, tile, cb, cn);
    conv_T(IN(5), (f16*)(ws + W_W2T), 2, 64, 512, (size_t)64 * 512, (size_t)512 * 64, 64, ident, one, off, tile, cb, cn);
    conv_T(IN(7), (f16*)(ws + W_A2T), 2, 64, 512, (size_t)64 * 512, (size_t)512 * 64, 64, ident, one, off, tile, cb, cn);
    conv_T(IN(8), (f16*)(ws + W_G2T), 2, 128, 512, (size_t)128 * 512, (size_t)512 * 128, 128, ident, one, off, tile, cb, cn);
    conv_T(IN(18), (f16*)(ws + W_ABOUT), 2, 1024, 1024, (size_t)1024 * 1024, (size_t)1024 * 1024, 1024, ident, one, off, tile, cb, cn);
    conv_T(IN(19), (f16*)(ws + W_MLAIN), 2, 1024, 544, (size_t)1024 * 544, (size_t)640 * 1024, 1024, ident, one, off, tile, cb, cn);
    for (int l = 0; l < 2; ++l) {
        const float* qn = IN(20) + l * 256; const float* kvn = IN(21) + l * 256;
        const float qs = 0.10206207261596577f * LOG2E;
        conv_T(IN(22) + (size_t)l * 256 * 1536, (f16*)(ws + W_Q) + (size_t)l * 1536 * 256, 1, 256, 1536, 0, 0, 256, ident, [=](int k) { return qn[k] * qs; }, off, tile, cb, cn);
        conv_T(IN(23) + (size_t)l * 256 * 2048, (f16*)(ws + W_KV) + (size_t)l * 2048 * 256, 1, 256, 2048, 0, 0, 256,
               [](int n) { const int h = n >> 7, j = n & 127; return j < 64 ? h * 64 + j : 1024 + h * 64 + (j - 64); }, [=](int k) { return kvn[k]; }, off, tile, cb, cn);
    }
    conv_T(IN(24), (f16*)(ws + W_MLAOUT), 2, 1024, 1024, (size_t)1024 * 1024, (size_t)1024 * 1024, 1024, ident, one, off, tile, cb, cn);
    {
        const float* w = IN(27); f16* o = (f16*)(ws + W_XAQ); const float sc = 0.0625f * LOG2E;
        for (size_t i = gtid; i < (size_t)4 * 1024 * 1024 / 4; i += gsz) *(f16x4*)(o + i * 4) = cvt4(*(const f32x4*)(w + i * 4) * sc);
    }
    conv_T(IN(28), (f16*)(ws + W_XAKV), 4, 1024, 2048, (size_t)1024 * 2048, (size_t)2048 * 1024, 1024, ident, one, off, tile, cb, cn);
    conv_T(IN(29), (f16*)(ws + W_XAO), 4, 1024, 1024, (size_t)1024 * 1024, (size_t)1024 * 1024, 1024, ident, one, off, tile, cb, cn);
    for (int l = 0; l < 4; ++l) {
        const float* g2 = IN(30) + l * 1024;
        conv_T(IN(32) + (size_t)l * 1024 * 4, (f16*)(ws + W_ROUTER) + (size_t)l * 128 * 1024, 1, 1024, 4, 0, 0, 1024, ident, [=](int k) { return g2[k]; }, off, tile, cb, cn);
        conv_T(IN(34) + (size_t)l * 1024 * 32, (f16*)(ws + W_ROUTER) + (size_t)l * 128 * 1024, 1, 1024, 32, 0, 0, 1024, [](int n) { return n + 4; }, [=](int k) { return g2[k]; }, off, tile, cb, cn);
    }
    {
        const int gw = BID * 4 + (TID >> 6), lane = TID & 63;
        if (gw < 4 * 36) {
            const int l = gw / 36, n = gw % 36;
            const float* g2 = IN(30) + l * 1024; const float* b2 = IN(31) + l * 1024;
            const float* w = (n < 4) ? (IN(32) + (size_t)l * 1024 * 4 + n) : (IN(34) + (size_t)l * 1024 * 32 + (n - 4));
            const int ldw = (n < 4) ? 4 : 32;
            float su = 0.f, sc = 0.f;
            for (int k = lane; k < 1024; k += 64) { const float wv = w[(size_t)k * ldw]; su += g2[k] * wv; sc += b2[k] * wv; }
            su = wave_sum(su); sc = wave_sum(sc);
            if (lane == 0) { float* ruc = (float*)(ws + OFF_RUC) + l * 128; ruc[n] = su; ruc[64 + n] = sc; }
        }
    }
}

__device__ __forceinline__ void convert_moe(const Params& p, char* smem, int cb, int cn) {
    char* ws = WS;
    float* tile = (float*)smem;
    int off = 0;
    auto ident = [](int n) { return n; };
    auto one = [](int) { return 1.0f; };
    conv_T_fold(IN(36), (f16*)(ws + W_GU), IN(30), IN(31), (float*)(ws + OFF_MUP), (float*)(ws + OFF_MCP),
                [](int n) { return (n >> 6) * 128 + ((n >> 5) & 1) * 64 + (n & 31); }, off, tile, cb, cn);
    conv_T_fold(IN(37), (f16*)(ws + W_GU), IN(30), IN(31), (float*)(ws + OFF_MUP), (float*)(ws + OFF_MCP),
                [](int n) { return (n >> 6) * 128 + ((n >> 5) & 1) * 64 + 32 + (n & 31); }, off, tile, cb, cn);
    conv_T(IN(38), (f16*)(ws + W_D), 128, 512, 1024, (size_t)512 * 1024, (size_t)1024 * 512, 512, ident, one, off, tile, cb, cn);
}

template <int MODE>
__device__ __forceinline__ void phase_ln(const f16* src, const f16* ff0, const f16* ff1, const float* gp, const float* bp, const float* g, const float* b,
                                         float* dst32, f16* dst16, float* stat) {
    const int lane = TID & 63, gw = BID * 4 + (TID >> 6), nw = NBLK * 4;
    for (int row = gw; row < T; row += nw) {
        f32x4 v[4]; float s = 0.f;
#pragma unroll
        for (int i = 0; i < 4; ++i) {
            v[i] = cvt4f(*(const f16x4*)(src + (size_t)row * D + i * 256 + lane * 4));
            s += (v[i][0] + v[i][1]) + (v[i][2] + v[i][3]);
        }
        float mean = wave_sum(s) * (1.0f / 1024.0f);
        float q = 0.f;
#pragma unroll
        for (int i = 0; i < 4; ++i) { const f32x4 d = v[i] - mean; q += (d[0] * d[0] + d[1] * d[1]) + (d[2] * d[2] + d[3] * d[3]); }
        float rstd = rsqrtf(wave_sum(q) * (1.0f / 1024.0f) + 1e-5f);
        if (MODE == 1) {
            s = 0.f;
#pragma unroll
            for (int i = 0; i < 4; ++i) {
                const int c = i * 256 + lane * 4; const size_t o = (size_t)row * D + c;
                const f32x4 h2 = (v[i] - mean) * rstd * *(const f32x4*)(gp + c) + *(const f32x4*)(bp + c);
                v[i] = h2 * DN_ALPHA + cvt4f(*(const f16x4*)(ff0 + o)) + cvt4f(*(const f16x4*)(ff1 + o));
                s += (v[i][0] + v[i][1]) + (v[i][2] + v[i][3]);
            }
            mean = wave_sum(s) * (1.0f / 1024.0f);
            q = 0.f;
#pragma unroll
            for (int i = 0; i < 4; ++i) { const f32x4 d = v[i] - mean; q += (d[0] * d[0] + d[1] * d[1]) + (d[2] * d[2] + d[3] * d[3]); }
            rstd = rsqrtf(wave_sum(q) * (1.0f / 1024.0f) + 1e-5f);
        }
        if (MODE == 0 && lane == 0) *(f32x2*)(stat + (size_t)row * 2) = (f32x2){mean, rstd};
#pragma unroll
        for (int i = 0; i < 4; ++i) {
            const int c = i * 256 + lane * 4; const size_t o = (size_t)row * D + c;
            const f32x4 y = (v[i] - mean) * rstd * *(const f32x4*)(g + c) + *(const f32x4*)(b + c);
            if (MODE == 1 && dst32) *(f32x4*)(dst32 + o) = y;
            if (dst16) *(f16x4*)(dst16 + o) = cvt4(y);
        }
    }
}

__device__ __forceinline__ void phase_gemm_res(const f16* X, const f16* Wt, const float* res32, const f16* res16, f16* y16, float* pst, char* smem) {
    WAVE_IDS
    GPipe gp{0, 0};
    tile_loop2(128, 8, [&](int rt, int ct, bool hn, int nrt, int nct) {
        float su[4] = {0.f, 0.f, 0.f, 0.f}, sq[4] = {0.f, 0.f, 0.f, 0.f};
        f32x4 acc[4][4];
        gemm_core_pf<true>(acc, [&](int a, int, int r) { return X + (size_t)(a * 128 + r) * 1024; }, [&](int, int c, int r) { return Wt + (size_t)(c * 128 + r) * 1024; },
                           rt, ct, 16, hn, nrt, nct, gp, smem);
#pragma unroll
        for (int m = 0; m < 4; ++m)
#pragma unroll
            for (int n = 0; n < 4; ++n) {
                const size_t o = (size_t)(rt * 128 + wr * 64 + m * 16 + fr) * 1024 + ct * 128 + wc * 64 + n * 16 + 4 * fq;
                const f32x4 r4 = res32 ? *(const f32x4*)(res32 + o) : cvt4f(*(const f16x4*)(res16 + o));
                const f16x4 y4 = cvt4(r4 * DN_ALPHA + acc[m][n]);
                *(f16x4*)(y16 + o) = y4;
                const f32x4 yr = cvt4f(y4);
                su[m] += (yr[0] + yr[1]) + (yr[2] + yr[3]); sq[m] += (yr[0] * yr[0] + yr[1] * yr[1]) + (yr[2] * yr[2] + yr[3] * yr[3]);
            }
#pragma unroll
        for (int m = 0; m < 4; ++m) {
            float a = su[m], q = sq[m];
            a += __shfl_xor(a, 16); a += __shfl_xor(a, 32); q += __shfl_xor(q, 16); q += __shfl_xor(q, 32);
            if (fq == 0) *(f32x2*)(pst + ((size_t)(rt * 128 + wr * 64 + m * 16 + fr) * 16 + ct * 2 + wc) * 2) = (f32x2){a, q};
        }
    });
}

__device__ __forceinline__ void phase_xa_out(const Params& p, int L, f16* y16, char* smem) {
    WAVE_IDS
    const f16* XP = (const f16*)(WS + S_XP16); const float* LP = (const float*)(WS + S_XLP); const float* PST = (const float*)(WS + S_PST1);
    const float* g1 = IN(25) + L * 1024; const float* b1 = IN(26) + L * 1024;
    float* srow = (float*)(smem + SMEM_MAIN + 1024); float* pst2 = (float*)(WS + S_PST2);
    GPipe gp{0, 0};
    const f16* XNb = (const f16*)(WS + OFF_XN) + (size_t)(L * 4) * 1024 * 1024;
    tile_loop2(128, 8, [&](int rt, int ct, bool hn, int nrt, int nct) {
        row_stats_table(PST, [&](int r) { return rt * 128 + r; }, srow);
        float ratio[4][4];
#pragma unroll
        for (int m = 0; m < 4; ++m) {
            const float* lp = LP + (size_t)(rt * 128 + wr * 64 + m * 16 + fr) * 16;
            float l[4];
#pragma unroll
            for (int h = 0; h < 4; ++h) { const f32x4 v = *(const f32x4*)(lp + 4 * h); l[h] = (v[0] + v[1]) + (v[2] + v[3]); }
            ratio[m][0] = l[1] / l[0]; ratio[m][1] = l[2] / l[1]; ratio[m][2] = l[3] / l[2]; ratio[m][3] = 1.0f / l[3];
        }
        f32x4 acc[4][4];
        gemm_core_pf<true>(acc, [&](int a, int, int r) { return XP + (size_t)(a * 128 + r) * 1024; },
            [&](int a, int c, int r) { return XNb + (size_t)(a >> 5) * 1024 * 1024 + (size_t)(c * 128 + r) * 1024; }, rt, ct, 16, hn, nrt, nct, gp, smem,
            [&](int kt, f32x4 (&a)[4][4]) {
                if (kt == 4 || kt == 8 || kt == 12) {
#pragma unroll
                    for (int m = 0; m < 4; ++m) {
                        const float sc = kt == 4 ? ratio[m][0] : (kt == 8 ? ratio[m][1] : ratio[m][2]);
#pragma unroll
                        for (int n = 0; n < 4; ++n) a[m][n] = a[m][n] * sc;
                    }
                }
            });
        f32x4 gv[4], bv[4];
#pragma unroll
        for (int n = 0; n < 4; ++n) { const int c = ct * 128 + wc * 64 + n * 16 + 4 * fq; gv[n] = *(const f32x4*)(g1 + c); bv[n] = *(const f32x4*)(b1 + c); }
#pragma unroll
        for (int m = 0; m < 4; ++m) {
            const int row = rt * 128 + wr * 64 + m * 16 + fr;
            const f32x2 st = *(const f32x2*)(srow + (wr * 64 + m * 16 + fr) * 2);
            float su = 0.f, sq = 0.f;
#pragma unroll
            for (int n = 0; n < 4; ++n) {
                const size_t o = (size_t)row * 1024 + ct * 128 + wc * 64 + n * 16 + 4 * fq;
                const f32x4 hres = (cvt4f(*(const f16x4*)(y16 + o)) - st[0]) * st[1] * gv[n] + bv[n];
                const f16x4 y4 = cvt4(hres * DN_ALPHA + acc[m][n] * ratio[m][3]);
                *(f16x4*)(y16 + o) = y4;
                const f32x4 yr = cvt4f(y4);
                su += (yr[0] + yr[1]) + (yr[2] + yr[3]); sq += (yr[0] * yr[0] + yr[1] * yr[1]) + (yr[2] * yr[2] + yr[3] * yr[3]);
            }
            su += __shfl_xor(su, 16); su += __shfl_xor(su, 32); sq += __shfl_xor(sq, 16); sq += __shfl_xor(sq, 32);
            if (fq == 0) *(f32x2*)(pst2 + ((size_t)row * 16 + ct * 2 + wc) * 2) = (f32x2){su, sq};
        }
    });
}

__device__ __forceinline__ void phase_memkv(const Params& p, char* smem) {
    WAVE_IDS
    const f16* mem16 = (const f16*)(WS + OFF_MEM16);
    for (int item = BID; item < 4 * 8 * 16; item += NBLK) {
        const int L = item >> 7, rt = (item >> 4) & 7, ct = item & 15;
        const f16* Wt = (const f16*)(WS + W_XAKV) + (size_t)L * 2048 * 1024;
        f16* kv = (f16*)(WS + OFF_KVMEM) + (size_t)L * 1024 * 2048;
        f32x4 acc[4][4];
        gemm_core<true>(acc, [&](int r) { return mem16 + (size_t)(rt * 128 + r) * 1024; }, [&](int r) { return Wt + (size_t)(ct * 128 + r) * 1024; }, 16, smem);
#pragma unroll
        for (int m = 0; m < 4; ++m)
#pragma unroll
            for (int n = 0; n < 4; ++n)
                *(f16x4*)(kv + (size_t)(rt * 128 + wr * 64 + m * 16 + fr) * 2048 + ct * 128 + wc * 64 + n * 16 + 4 * fq) = cvt4(acc[m][n]);
    }
}

__device__ __forceinline__ void xa_pre_item(const Params& p, int item, char* smem) {
    WAVE_IDS
    const int ct = item & 7, rt = (item >> 3) & 7, which = (item >> 6) & 1, b = (item >> 7) & 3, L = item >> 9;
    const f16* kv = (const f16*)(WS + OFF_KVMEM) + (size_t)L * 1024 * 2048;
    f32x4 acc[4][4];
    f16* out;
    if (which == 0) {
        const int hd = rt >> 1, key0 = (rt & 1) * 128;
        const f16* wq = (const f16*)(WS + W_XAQ) + (size_t)L * 1024 * 1024;
        gemm_core<true>(acc, [&](int r) { return kv + (size_t)(b * 256 + key0 + r) * 2048 + hd * 256; }, [&](int r) { return wq + (size_t)(ct * 128 + r) * 1024 + hd * 256; }, 4, smem);
        out = (f16*)(WS + OFF_XM) + (size_t)(L * 4 + b) * 1024 * 1024;
    } else {
        const int hd = ct >> 1, key0 = (ct & 1) * 128;
        const f16* wo = (const f16*)(WS + W_XAO) + (size_t)L * 1024 * 1024;
        gemm_core<true>(acc, [&](int r) { return wo + (size_t)(rt * 128 + r) * 1024 + hd * 256; }, [&](int r) { return kv + (size_t)(b * 256 + key0 + r) * 2048 + 1024 + hd * 256; }, 4, smem);
        out = (f16*)(WS + OFF_XN) + (size_t)(L * 4 + b) * 1024 * 1024;
    }
    if (which == 0) {
        const float* g1 = IN(25) + L * 1024; const float* b1 = IN(26) + L * 1024;
        float* up = (float*)(WS + OFF_XUP) + (size_t)(L * 4 + b) * 1024 * 16; float* cp = (float*)(WS + OFF_XCP) + (size_t)(L * 4 + b) * 1024 * 16;
#pragma unroll
        for (int m = 0; m < 4; ++m) {
            const int row = rt * 128 + wr * 64 + m * 16 + fr;
            float us = 0.f, cs = 0.f;
#pragma unroll
            for (int n = 0; n < 4; ++n) {
                const int k = ct * 128 + wc * 64 + n * 16 + 4 * fq;
                const f16x4 xm = cvt4(acc[m][n] * *(const f32x4*)(g1 + k));
                *(f16x4*)(out + (size_t)row * 1024 + k) = xm;
                const f32x4 xr = cvt4f(xm), cb = acc[m][n] * *(const f32x4*)(b1 + k);
                us += (xr[0] + xr[1]) + (xr[2] + xr[3]); cs += (cb[0] + cb[1]) + (cb[2] + cb[3]);
            }
            us += __shfl_xor(us, 16); us += __shfl_xor(us, 32); cs += __shfl_xor(cs, 16); cs += __shfl_xor(cs, 32);
            if (fq == 0) { up[(size_t)row * 16 + ct * 2 + wc] = us; cp[(size_t)row * 16 + ct * 2 + wc] = cs; }
        }
        return;
    }
#pragma unroll
    for (int m = 0; m < 4; ++m)
#pragma unroll
        for (int n = 0; n < 4; ++n)
            *(f16x4*)(out + (size_t)(rt * 128 + wr * 64 + m * 16 + fr) * 1024 + ct * 128 + wc * 64 + n * 16 + 4 * fq) = cvt4(acc[m][n]);
}

__device__ __forceinline__ void xa_uc_reduce(const Params& p) {
    const float* up = (const float*)(WS + OFF_XUP); const float* cp = (const float*)(WS + OFF_XCP);
    float* xu = (float*)(WS + OFF_XU); float* xc = (float*)(WS + OFF_XC);
    for (int i = BID * 256 + TID; i < 16 * 1024; i += NBLK * 256) {
        float a = 0.f, c = 0.f;
#pragma unroll
        for (int q4 = 0; q4 < 4; ++q4) { const f32x4 v = *(const f32x4*)(up + (size_t)i * 16 + q4 * 4), w = *(const f32x4*)(cp + (size_t)i * 16 + q4 * 4); a += (v[0] + v[1]) + (v[2] + v[3]); c += (w[0] + w[1]) + (w[2] + w[3]); }
        xu[i] = a; xc[i] = c;
    }
}

__device__ __forceinline__ void phase_ab_in(const Params& p, int j, char* smem) {
    WAVE_IDS
    const f16* X = (const f16*)(WS + OFF_H16);
    const f16* Wt = (const f16*)(WS + W_ABIN) + (size_t)j * 2816 * 1024;
    f16* P = (f16*)(WS + S_P16);
    GPipe gp{0, 0};
    tile_loop2(128, 22, [&](int rt, int ct, bool hn, int nrt, int nct) {
        f32x4 acc[4][4];
        gemm_core_pf<true>(acc, [&](int a, int, int r) { return X + (size_t)(a * 128 + r) * 1024; }, [&](int, int c, int r) { return Wt + (size_t)(c * 128 + r) * 1024; },
                           rt, ct, 16, hn, nrt, nct, gp, smem);
#pragma unroll
        for (int m = 0; m < 4; ++m)
#pragma unroll
            for (int n = 0; n < 4; ++n)
                *(f16x4*)(P + (size_t)(rt * 128 + wr * 64 + m * 16 + fr) * 2816 + ct * 128 + wc * 64 + n * 16 + 4 * fq) = cvt4(acc[m][n]);
    });
}

__device__ __forceinline__ void phase_shift(const Params& p, int j) {
    const f16* P = (const f16*)(WS + S_P16); f16* PS = (f16*)(WS + S_PS16);
    const float* mu = IN(3) + j * 1792;
    const int total = T * 224;
    for (int i = BID * 256 + TID; i < total; i += NBLK * 256) {
        const int t = i / 224, c = (i % 224) * 8;
        const f16x8 cur = *(const f16x8*)(P + (size_t)t * 2816 + c);
        f16x8 prv; for (int e = 0; e < 8; ++e) prv[e] = (f16)0.f;
        if ((t & (SEQ - 1)) != 0) prv = *(const f16x8*)(P + (size_t)(t - 1) * 2816 + c);
        f16x8 o;
        const f32x4 mu0 = *(const f32x4*)(mu + c), mu1 = *(const f32x4*)(mu + c + 4);
#pragma unroll
        for (int e = 0; e < 8; ++e) {
            const float a = (float)cur[e]; float v = a + ((float)prv[e] - a) * (e < 4 ? mu0[e & 3] : mu1[e & 3]);
            if (c >= 1536 && c < 1600) v = tanh_(v);
            else if (c >= 1664) v = sigmoid_(v);
            o[e] = (f16)v;
        }
        *(f16x8*)(PS + (size_t)t * 1792 + c) = o;
    }
}

__device__ __forceinline__ void phase_lora(const Params& p, int j, char* smem) {
    WAVE_IDS
    const f16* PS = (const f16*)(WS + S_PS16);
    float* WD = (float*)(WS + S_WD32); f16* NKK = (f16*)(WS + S_NKK); f16* BB = (f16*)(WS + S_BB); f16* KP = (f16*)(WS + S_KP);
    f16* G16 = (f16*)(WS + S_G16); float* BSUM = (float*)(WS + S_BSUM);
    const float* w0 = IN(4) + j * 512; const float* a0 = IN(6) + j * 512; const float* k_k = IN(9) + j * 512; const float* k_a = IN(10) + j * 512; const float* r_k = IN(11) + j * 512;
    GPipe gp{0, 0};
    const f16* Wl0 = (const f16*)(WS + W_W2T) + (size_t)j * 512 * 64; const f16* Wl1 = (const f16*)(WS + W_A2T) + (size_t)j * 512 * 64;
    const f16* Wl2 = (const f16*)(WS + W_G2T) + (size_t)j * 512 * 128;
    tile_loop2(128, 12, [&](int rt, int ct, bool hn, int nrt, int nct) {
        const int type = ct >> 2, c4 = ct & 3;
        f32x4 acc[4][4];
        gemm_core_pf<true>(acc, [&](int a, int c, int r) { const int ty = c >> 2; return PS + (size_t)(a * 128 + r) * 1792 + (ty == 0 ? 1536 : (ty == 1 ? 1600 : 1664)); },
                           [&](int, int c, int r) { const int ty = c >> 2, cc = c & 3; return ty == 0 ? Wl0 + (size_t)(cc * 128 + r) * 64 : (ty == 1 ? Wl1 + (size_t)(cc * 128 + r) * 64 : Wl2 + (size_t)(cc * 128 + r) * 128); },
                           rt, ct, type == 2 ? 2 : 1, hn, nrt, nct, gp, smem);
        if (type == 0) {
#pragma unroll
            for (int m = 0; m < 4; ++m)
#pragma unroll
                for (int n = 0; n < 4; ++n) {
                    const int row = rt * 128 + wr * 64 + m * 16 + fr, col = c4 * 128 + wc * 64 + n * 16 + 4 * fq;
                    f32x4 o;
#pragma unroll
                    for (int e = 0; e < 4; ++e) {
                        const float z = -(w0[col + e] + acc[m][n][e]);
                        const float sp = fmaxf(z, 0.f) + __logf(1.0f + __expf(-fabsf(z)));
                        o[e] = __expf(-__expf(-sp - 0.5f));
                    }
                    *(f32x4*)(WD + (size_t)row * 512 + col) = o;
                }
        } else if (type == 1) {
            const int head = c4 * 2 + wc;
#pragma unroll
            for (int m = 0; m < 4; ++m) {
                const int row = rt * 128 + wr * 64 + m * 16 + fr;
                f32x4 av[4], kv[4], kr[4];
                float ss = 0.f, bs = 0.f;
#pragma unroll
                for (int n = 0; n < 4; ++n) {
                    const int col = head * 64 + n * 16 + 4 * fq;
                    const f32x4 kk_ = cvt4f(*(const f16x4*)(PS + (size_t)row * 1792 + 512 + col));
                    const f32x4 rr = cvt4f(*(const f16x4*)(PS + (size_t)row * 1792 + col));
#pragma unroll
                    for (int e = 0; e < 4; ++e) {
                        const float a = sigmoid_(a0[col + e] + acc[m][n][e]);
                        const float kraw = kk_[e] * k_k[col + e];
                        const float kp = kk_[e] * (1.0f + (a - 1.0f) * k_a[col + e]);
                        av[n][e] = a; kr[n][e] = kraw; kv[n][e] = kp;
                        ss += kraw * kraw; bs += rr[e] * kp * r_k[col + e];
                    }
                }
                ss += __shfl_xor(ss, 16); ss += __shfl_xor(ss, 32);
                bs += __shfl_xor(bs, 16); bs += __shfl_xor(bs, 32);
                const float inv = 1.0f / fmaxf(sqrtf(ss), 1e-12f);
#pragma unroll
                for (int n = 0; n < 4; ++n) {
                    const int col = head * 64 + n * 16 + 4 * fq;
                    f32x4 nk_, bb_;
#pragma unroll
                    for (int e = 0; e < 4; ++e) { const float kkn = kr[n][e] * inv; nk_[e] = -kkn; bb_[e] = kkn * av[n][e]; }
                    *(f16x4*)(NKK + (size_t)row * 512 + col) = cvt4(nk_);
                    *(f16x4*)(BB + (size_t)row * 512 + col) = cvt4(bb_);
                    *(f16x4*)(KP + (size_t)row * 512 + col) = cvt4(kv[n]);
                }
                if (fq == 0) BSUM[(size_t)row * 8 + head] = bs;
            }
        } else {
#pragma unroll
            for (int m = 0; m < 4; ++m)
#pragma unroll
                for (int n = 0; n < 4; ++n)
                    *(f16x4*)(G16 + (size_t)(rt * 128 + wr * 64 + m * 16 + fr) * 512 + c4 * 128 + wc * 64 + n * 16 + 4 * fq) = cvt4(acc[m][n]);
        }
    });
}

#if FAST_REC
constexpr int NREC = 128;
constexpr int SEG_C0 = 76;
__device__ __forceinline__ void rwkv_rec(const Params& p, int bh, int q, int c0, int nc, int part, bool wr_end, char* smem) {
    const int tid = TID, lane = tid & 63, wid = tid >> 6;
    const int b = bh >> 3, h = bh & 7;
    const int rl = lane >> 4, ks = lane & 15, vrow = wid * 4 + rl;
    const float* WD = (const float*)(WS + S_WD32); const f16* NKK = (const f16*)(WS + S_NKK); const f16* BB = (const f16*)(WS + S_BB);
    const f16* KP = (const f16*)(WS + S_KP); const f16* PS = (const f16*)(WS + S_PS16); float* Y = (float*)(WS + (part == 2 ? S_YT : S_Y32));
    float* sW = (float*)smem; float* sN = sW + 32 * 64; float* sB = sN + 32 * 64; float* sK = sB + 32 * 64; float* sWR = sK + 32 * 64;
    float* sV = sWR + 32 * 64; float* sS = sV + 32 * 16; float* sY = sS + 32 * 2;
    const size_t tb = (size_t)b * SEQ + (size_t)c0 * 32;
    f32x4 pw0, pw1; f16x8 pn, pb, pk, pr, pv;
    const int pst = tid >> 3, pc8 = tid & 7;
    auto prefetch = [&](int c) {
        const size_t t0 = tb + c * 32;
        const size_t o = (t0 + pst) * 512 + h * 64 + pc8 * 8;
        pw0 = *(const f32x4*)(WD + o); pw1 = *(const f32x4*)(WD + o + 4);
        pn = *(const f16x8*)(NKK + o); pb = *(const f16x8*)(BB + o); pk = *(const f16x8*)(KP + o); pr = *(const f16x8*)(PS + (t0 + pst) * 1792 + h * 64 + pc8 * 8);
        if (tid < 64) { const int st = tid >> 1, hf = tid & 1; pv = *(const f16x8*)(PS + (t0 + st) * 1792 + 1024 + h * 64 + q * 16 + hf * 8); }
    };
    f32x4 S = {0.f, 0.f, 0.f, 0.f};
    if (part == 2) {
#pragma unroll
        for (int e = 0; e < 4; ++e) S[e] = (4 * ks + e == q * 16 + vrow) ? 1.0f : 0.0f;
    }
    BSYNC();
    prefetch(0);
    for (int c = 0; c < nc; ++c) {
        BSYNC();
        if (c > 0) {
#pragma unroll
            for (int i = 0; i < 2; ++i) { const int e = tid + 256 * i, st = e >> 4, r = e & 15; Y[(tb + (c - 1) * 32 + st) * 512 + h * 64 + q * 16 + r] = sY[e]; }
        }
        {
            const int o = tid * 8;
            float br = 0.f, kr = 0.f;
            f32x4 wr0, wr1, n0, n1, b0, b1, k0, k1;
#pragma unroll
            for (int e = 0; e < 4; ++e) {
                const float r0 = (float)pr[e], r1 = (float)pr[4 + e];
                n0[e] = (float)pn[e]; n1[e] = (float)pn[4 + e]; b0[e] = (float)pb[e]; b1[e] = (float)pb[4 + e]; k0[e] = (float)pk[e]; k1[e] = (float)pk[4 + e];
                wr0[e] = pw0[e] * r0; wr1[e] = pw1[e] * r1;
                br += b0[e] * r0 + b1[e] * r1; kr += k0[e] * r0 + k1[e] * r1;
            }
            *(f32x4*)(sW + o) = pw0; *(f32x4*)(sW + o + 4) = pw1; *(f32x4*)(sN + o) = n0; *(f32x4*)(sN + o + 4) = n1;
            *(f32x4*)(sB + o) = b0; *(f32x4*)(sB + o + 4) = b1; *(f32x4*)(sK + o) = k0; *(f32x4*)(sK + o + 4) = k1;
            *(f32x4*)(sWR + o) = wr0; *(f32x4*)(sWR + o + 4) = wr1;
            br += __shfl_xor(br, 1); br += __shfl_xor(br, 2); br += __shfl_xor(br, 4);
            kr += __shfl_xor(kr, 1); kr += __shfl_xor(kr, 2); kr += __shfl_xor(kr, 4);
            if (pc8 == 0) { sS[pst * 2] = br; sS[pst * 2 + 1] = kr; }
            if (tid < 64) {
#pragma unroll
                for (int e = 0; e < 8; ++e) sV[tid * 8 + e] = (part == 2) ? 0.0f : (float)pv[e];
            }
        }
        BSYNC();
        if (c + 1 < nc) prefetch(c + 1);
        float y0 = 0.f, y1 = 0.f;
        f32x4 w4 = *(const f32x4*)(sW + ks * 4), n4 = *(const f32x4*)(sN + ks * 4), b4 = *(const f32x4*)(sB + ks * 4);
        f32x4 k4 = *(const f32x4*)(sK + ks * 4), q4 = *(const f32x4*)(sWR + ks * 4);
        float vv = sV[vrow]; f32x2 sc = *(const f32x2*)(sS);
#pragma unroll
        for (int s = 0; s < 32; ++s) {
            f32x4 w4n = w4, n4n = n4, b4n = b4, k4n = k4, q4n = q4; float vvn = vv; f32x2 scn = sc;
            if (s + 1 < 32) {
                w4n = *(const f32x4*)(sW + (s + 1) * 64 + ks * 4); n4n = *(const f32x4*)(sN + (s + 1) * 64 + ks * 4); b4n = *(const f32x4*)(sB + (s + 1) * 64 + ks * 4);
                k4n = *(const f32x4*)(sK + (s + 1) * 64 + ks * 4); q4n = *(const f32x4*)(sWR + (s + 1) * 64 + ks * 4);
                vvn = sV[(s + 1) * 16 + vrow]; scn = *(const f32x2*)(sS + (s + 1) * 2);
            }
            __builtin_amdgcn_sched_barrier(0);
            float d1 = fmaf(S[3], n4[3], fmaf(S[2], n4[2], fmaf(S[1], n4[1], S[0] * n4[0])));
            float d2 = fmaf(S[3], q4[3], fmaf(S[2], q4[2], fmaf(S[1], q4[1], S[0] * q4[0])));
            d1 = row16_sum(d1); d2 = row16_sum(d2);
            const float y = d2 + d1 * sc[0] + vv * sc[1];
            S = S * w4 + (b4 * d1 + k4 * vv);
            if (s < 16) y0 = (ks == s) ? y : y0; else y1 = (ks == s - 16) ? y : y1;
            __builtin_amdgcn_sched_barrier(0);
            w4 = w4n; n4 = n4n; b4 = b4n; k4 = k4n; q4 = q4n; vv = vvn; sc = scn;
        }
        sY[ks * 16 + vrow] = y0; sY[(16 + ks) * 16 + vrow] = y1;
    }
    BSYNC();
#pragma unroll
    for (int i = 0; i < 2; ++i) { const int e = tid + 256 * i, st = e >> 4, r = e & 15; Y[(tb + (size_t)(nc - 1) * 32 + st) * 512 + h * 64 + q * 16 + r] = sY[e]; }
    if (wr_end) *(f32x4*)((float*)(WS + S_SMID) + ((size_t)bh * 64 + q * 16 + vrow) * 64 + ks * 4) = S;
}
#else
constexpr int NREC = 8;
__device__ __forceinline__ void rwkv_rec(const Params& p, int rb, char*) {
    const int gt = rb * 256 + TID, bh = gt >> 6, v = gt & 63, b = bh >> 3, h = bh & 7;
    const float* WD = (const float*)(WS + S_WD32); const f16* NKK = (const f16*)(WS + S_NKK); const f16* BB = (const f16*)(WS + S_BB);
    const f16* KP = (const f16*)(WS + S_KP); const f16* PS = (const f16*)(WS + S_PS16); float* Y = (float*)(WS + S_Y32);
    float S[64];
#pragma unroll
    for (int k = 0; k < 64; ++k) S[k] = 0.f;
    for (int s = 0; s < SEQ; ++s) {
        const size_t t = (size_t)b * SEQ + s, o = t * 512 + h * 64;
        const float vv = (float)PS[t * 1792 + 1024 + h * 64 + v];
        float sa = 0.f;
#pragma unroll
        for (int k8 = 0; k8 < 8; ++k8) { const f16x8 n8 = *(const f16x8*)(NKK + o + k8 * 8);
#pragma unroll
            for (int e = 0; e < 8; ++e) sa += S[k8 * 8 + e] * (float)n8[e]; }
        float y = 0.f;
#pragma unroll
        for (int k8 = 0; k8 < 8; ++k8) {
            const f16x8 b8 = *(const f16x8*)(BB + o + k8 * 8), kp8 = *(const f16x8*)(KP + o + k8 * 8), r8 = *(const f16x8*)(PS + t * 1792 + h * 64 + k8 * 8);
            const f32x4 wa = *(const f32x4*)(WD + o + k8 * 8), wb = *(const f32x4*)(WD + o + k8 * 8 + 4);
#pragma unroll
            for (int e = 0; e < 8; ++e) {
                const float w = e < 4 ? wa[e & 3] : wb[e & 3];
                const float sn = S[k8 * 8 + e] * w + (sa * (float)b8[e] + vv * (float)kp8[e]);
                S[k8 * 8 + e] = sn; y += sn * (float)r8[e];
            }
        }
        Y[t * 512 + h * 64 + v] = y;
    }
}
#endif

__device__ __forceinline__ void sg_item(const Params& p, int j, int item, char* smem) {
    WAVE_IDS
    const int g = item & 3, bc = item >> 2;
    const f16* P = (const f16*)(WS + S_P16);
    f16* ZT = (f16*)(WS + S_ZT) + (size_t)item * 128 * 128;
    const float* lg = IN(14) + (j * 4 + g) * 128; const float* lb = IN(15) + (j * 4 + g) * 128;
    {
        const int sub = tid & 15, rloc = tid >> 4;
        for (int it = 0; it < 8; ++it) {
            const int s = it * 16 + rloc;
            const f16x8 x = *(const f16x8*)(P + (size_t)(bc * 128 + s) * 2816 + 2304 + g * 128 + sub * 8);
            float z[8], sum = 0.f;
#pragma unroll
            for (int e = 0; e < 8; ++e) { z[e] = gelu_((float)x[e]); sum += z[e]; }
            const float mean = row16_sum(sum) * (1.0f / 128.0f);
            float qq = 0.f;
#pragma unroll
            for (int e = 0; e < 8; ++e) { const float d = z[e] - mean; qq += d * d; }
            const float rstd = rsqrtf(row16_sum(qq) * (1.0f / 128.0f) + 1e-5f);
#pragma unroll
            for (int e = 0; e < 8; ++e) { const int d = sub * 8 + e; ZT[(size_t)d * 128 + s] = (f16)((z[e] - mean) * rstd * lg[d] + lb[d]); }
        }
    }
    asm volatile("s_waitcnt vmcnt(0)" ::: "memory");
    BSYNC();
    const f16* Wm = (const f16*)(WS + W_SGW) + (size_t)(j * 4 + g) * 128 * 128;
    f32x4 acc[4][4];
    gemm_core<true>(acc, [&](int r) { return Wm + (size_t)r * 128; }, [&](int r) { return (const f16*)ZT + (size_t)r * 128; }, 2, smem);
    const float* bs = IN(17) + (j * 4 + g) * 128;
    f16* MIX = (f16*)(WS + S_MIX16);
#pragma unroll
    for (int m = 0; m < 4; ++m)
#pragma unroll
        for (int n = 0; n < 4; ++n) {
            const int tl = wr * 64 + m * 16 + fr, d = wc * 64 + n * 16 + 4 * fq;
            const size_t t = (size_t)bc * 128 + tl;
            const f32x4 u = cvt4f(*(const f16x4*)(P + t * 2816 + 1792 + g * 128 + d));
            f32x4 o;
#pragma unroll
            for (int e = 0; e < 4; ++e) o[e] = gelu_(u[e]) * (acc[m][n][e] + bs[tl]);
            *(f16x4*)(MIX + t * 1024 + 512 + g * 128 + d) = cvt4(o);
        }
}

__device__ __forceinline__ void phase_rec_sg(const Params& p, int j, bool pre, bool segmode, char* smem) {
#if FAST_REC
    const int bid = BID, nb = NBLK;
    if (!segmode) {
        const bool isrec = (bid < 256) && (((bid >> 3) & 1) == 0);
        if (isrec) { const int u = ((bid >> 4) << 3) | (bid & 7); rwkv_rec(p, u >> 2, u & 3, 0, 128, 0, false, smem); }
        else {
            const int sgi = (bid < 256) ? (((bid >> 4) << 3) | (bid & 7)) : (bid - 128);
            for (int item = sgi; item < 512; item += nb - 128) sg_item(p, j, item, smem);
            if (pre) {
                for (int item = sgi; item < 2048; item += nb - 128) xa_pre_item(p, item, smem);
                BSYNC();
                convert_moe(p, smem, sgi, nb - 128);
            }
        }
    } else {
        const int nrec = (nb * 3) >> 2;
        if (bid < nrec) {
            for (int v = bid; v < 384; v += nrec) {
                int bh, q, part;
                if (v >= 128 && v < 256) { const int u = v - 128; bh = u >> 2; q = u & 3; part = 0; }
                else { const int u = (v < 128) ? v : v - 128; bh = u >> 3; q = u & 3; part = 1 + ((u >> 2) & 1); }
                rwkv_rec(p, bh, q, part == 0 ? 0 : SEG_C0, part == 0 ? SEG_C0 : 128 - SEG_C0, part == 2 ? 2 : 0, part == 0, smem);
            }
        } else {
            for (int item = bid - nrec; item < 512; item += nb - nrec) sg_item(p, j, item, smem);
        }
    }
#else
    if (BID < NREC) rwkv_rec(p, BID, smem);
    else {
        for (int item = BID - NREC; item < 512; item += NBLK - NREC) sg_item(p, j, item, smem);
        if (pre) { for (int item = BID - NREC; item < 2048; item += NBLK - NREC) xa_pre_item(p, item, smem); BSYNC(); convert_moe(p, smem, BID - NREC, NBLK - NREC); }
    }
#endif
}

__device__ __forceinline__ void phase_rw_fin_seg(const Params& p, int j, char* smem) {
    const int tid = TID, tl = tid >> 2, vq = tid & 3;
    const float* Y = (const float*)(WS + S_Y32); const float* YT = (const float*)(WS + S_YT); const float* SM = (const float*)(WS + S_SMID);
    const f16* PS = (const f16*)(WS + S_PS16); const f16* G16 = (const f16*)(WS + S_G16);
    const float* BSUM = (const float*)(WS + S_BSUM); f16* MIX = (f16*)(WS + S_MIX16);
    const float* gg = IN(12) + j * 512; const float* gb = IN(13) + j * 512;
    float* sST = (float*)smem;
    float* sYT = sST + 64 * 64;
    for (int item = BID; item < 2048; item += NBLK) {
        const int bh = item >> 6, tile = item & 63, b = bh >> 3, h = bh & 7;
        const size_t t = (size_t)b * SEQ + tile * 64 + tl;
        const int c = h * 64 + vq * 16;
        float y[16];
#pragma unroll
        for (int i4 = 0; i4 < 4; ++i4) { const f32x4 v4 = *(const f32x4*)(Y + t * 512 + c + i4 * 4); y[i4 * 4] = v4[0]; y[i4 * 4 + 1] = v4[1]; y[i4 * 4 + 2] = v4[2]; y[i4 * 4 + 3] = v4[3]; }
        if (tile >= SEG_C0 / 2) {
            BSYNC();
            {
                const int v = tid >> 2, i0 = (tid & 3) * 16;
#pragma unroll
                for (int i4 = 0; i4 < 4; ++i4) { const f32x4 v4 = *(const f32x4*)(SM + ((size_t)bh * 64 + v) * 64 + i0 + i4 * 4);
#pragma unroll
                    for (int e = 0; e < 4; ++e) sST[(i0 + i4 * 4 + e) * 64 + v] = v4[e]; }
#pragma unroll
                for (int i4 = 0; i4 < 4; ++i4) { const f32x4 v4 = *(const f32x4*)(YT + t * 512 + c + i4 * 4);
#pragma unroll
                    for (int e = 0; e < 4; ++e) sYT[tl * 65 + vq * 16 + i4 * 4 + e] = v4[e]; }
            }
            BSYNC();
            for (int i = 0; i < 64; ++i) {
                const float a = sYT[tl * 65 + i];
#pragma unroll
                for (int i4 = 0; i4 < 4; ++i4) { const f32x4 s4 = *(const f32x4*)(sST + i * 64 + vq * 16 + i4 * 4);
                    y[i4 * 4] += a * s4[0]; y[i4 * 4 + 1] += a * s4[1]; y[i4 * 4 + 2] += a * s4[2]; y[i4 * 4 + 3] += a * s4[3]; }
            }
        }
        float sum = 0.f;
#pragma unroll
        for (int e = 0; e < 16; ++e) sum += y[e];
        sum += __shfl_xor(sum, 1); sum += __shfl_xor(sum, 2);
        const float mean = sum * (1.0f / 64.0f);
        float qq = 0.f;
#pragma unroll
        for (int e = 0; e < 16; ++e) { const float d = y[e] - mean; qq += d * d; }
        qq += __shfl_xor(qq, 1); qq += __shfl_xor(qq, 2);
        const float rstd = rsqrtf(qq * (1.0f / 64.0f) + 64e-5f);
        const float bsum = BSUM[t * 8 + h];
#pragma unroll
        for (int hf = 0; hf < 2; ++hf) {
            const f16x8 v8 = *(const f16x8*)(PS + t * 1792 + 1024 + c + hf * 8), g8 = *(const f16x8*)(G16 + t * 512 + c + hf * 8);
            f16x8 o;
#pragma unroll
            for (int e = 0; e < 8; ++e) {
                const float r = ((y[hf * 8 + e] - mean) * rstd * gg[c + hf * 8 + e] + gb[c + hf * 8 + e] + bsum * (float)v8[e]) * (float)g8[e];
                o[e] = (f16)r;
            }
            *(f16x8*)(MIX + t * 1024 + c + hf * 8) = o;
        }
    }
}

__device__ __forceinline__ void phase_rw_fin(const Params& p, int j) {
    const int lane = TID & 63, gw = BID * 4 + (TID >> 6), nw = NBLK * 4;
    const float* Y = (const float*)(WS + S_Y32); const f16* PS = (const f16*)(WS + S_PS16); const f16* G16 = (const f16*)(WS + S_G16);
    const float* BSUM = (const float*)(WS + S_BSUM); f16* MIX = (f16*)(WS + S_MIX16);
    const float* gg = IN(12) + j * 512; const float* gb = IN(13) + j * 512;
    for (int t = gw; t < T; t += nw) {
        const int c = lane * 8, head = lane >> 3;
        const f32x4 y0 = *(const f32x4*)(Y + (size_t)t * 512 + c), y1 = *(const f32x4*)(Y + (size_t)t * 512 + c + 4);
        float s = (y0[0] + y0[1]) + (y0[2] + y0[3]) + (y1[0] + y1[1]) + (y1[2] + y1[3]);
        s += __shfl_xor(s, 1); s += __shfl_xor(s, 2); s += __shfl_xor(s, 4);
        const float mean = s * (1.0f / 64.0f);
        float qq = 0.f;
#pragma unroll
        for (int e = 0; e < 4; ++e) { const float d0 = y0[e] - mean, d1 = y1[e] - mean; qq += d0 * d0 + d1 * d1; }
        qq += __shfl_xor(qq, 1); qq += __shfl_xor(qq, 2); qq += __shfl_xor(qq, 4);
        const float rstd = rsqrtf(qq * (1.0f / 64.0f) + 64e-5f);
        const float bsum = BSUM[(size_t)t * 8 + head];
        const f16x8 v8 = *(const f16x8*)(PS + (size_t)t * 1792 + 1024 + c), g8 = *(const f16x8*)(G16 + (size_t)t * 512 + c);
        f16x8 o;
#pragma unroll
        for (int e = 0; e < 8; ++e) {
            const float yv = e < 4 ? y0[e & 3] : y1[e & 3];
            const float r = ((yv - mean) * rstd * gg[c + e] + gb[c + e] + bsum * (float)v8[e]) * (float)g8[e];
            o[e] = (f16)r;
        }
        *(f16x8*)(MIX + (size_t)t * 1024 + c) = o;
    }
}

__device__ __forceinline__ void phase_mla_in(const Params& p, int j, char* smem) {
    WAVE_IDS
    const f16* X = (const f16*)(WS + OFF_H16);
    const f16* Wt = (const f16*)(WS + W_MLAIN) + (size_t)j * 640 * 1024;
    f16* CQKV = (f16*)(WS + S_CQKV); f16* KPE = (f16*)(WS + S_KPE); float* SSQ = (float*)(WS + S_SSQ);
    const f32x2* rope = (const f32x2*)(WS + OFF_ROPE);
    GPipe gp{0, 0};
    tile_loop2(128, 5, [&](int rt, int ct, bool hn, int nrt, int nct) {
        f32x4 acc[4][4];
        gemm_core_pf<true>(acc, [&](int a, int, int r) { return X + (size_t)(a * 128 + r) * 1024; }, [&](int, int c, int r) { return Wt + (size_t)(c * 128 + r) * 1024; },
                           rt, ct, 16, hn, nrt, nct, gp, smem);
        if (ct < 4) {
#pragma unroll
            for (int m = 0; m < 4; ++m) {
                const int row = rt * 128 + wr * 64 + m * 16 + fr;
                float ss = 0.f;
#pragma unroll
                for (int n = 0; n < 4; ++n) {
                    *(f16x4*)(CQKV + (size_t)row * 512 + ct * 128 + wc * 64 + n * 16 + 4 * fq) = cvt4(acc[m][n]);
                    const f32x4 a = acc[m][n]; ss += (a[0] * a[0] + a[1] * a[1]) + (a[2] * a[2] + a[3] * a[3]);
                }
                ss += __shfl_xor(ss, 16); ss += __shfl_xor(ss, 32);
                if (fq == 0) SSQ[(size_t)row * 8 + ct * 2 + wc] = ss;
            }
        } else if (wc == 0) {
#pragma unroll
            for (int m = 0; m < 4; ++m) {
                const int row = rt * 128 + wr * 64 + m * 16 + fr, pos = row & (SEQ - 1);
                f32x4 o1, o2;
#pragma unroll
                for (int e = 0; e < 4; ++e) {
                    const f32x2 cs = rope[pos * 16 + 4 * fq + e];
                    const float x1 = acc[m][0][e], x2 = acc[m][1][e];
                    o1[e] = x1 * cs[0] - x2 * cs[1]; o2[e] = x1 * cs[1] + x2 * cs[0];
                }
                *(f16x4*)(KPE + (size_t)row * 32 + 4 * fq) = cvt4(o1);
                *(f16x4*)(KPE + (size_t)row * 32 + 16 + 4 * fq) = cvt4(o2);
            }
        }
    });
}

__device__ __forceinline__ void phase_mla_qkv(const Params& p, int j, char* smem) {
    WAVE_IDS
    const f16* CQKV = (const f16*)(WS + S_CQKV);
    f16* Q16 = (f16*)(WS + S_Q16); f16* KN = (f16*)(WS + S_KN16); f16* VT = (f16*)(WS + S_VT16);
    const f32x2* rope = (const f32x2*)(WS + OFF_ROPE);
    const float* SSQ = (const float*)(WS + S_SSQ);
    GPipe gp{0, 0};
    const f16* Wqb = (const f16*)(WS + W_Q) + (size_t)j * 1536 * 256; const f16* Wkvb = (const f16*)(WS + W_KV) + (size_t)j * 2048 * 256;
    auto xpf = [&](int a, int c, int r) { return CQKV + (size_t)(a * 128 + r) * 512 + (c < 12 ? 0 : 256); };
    auto wpf = [&](int, int c, int r) { return c < 12 ? Wqb + (size_t)(c * 128 + r) * 256 : Wkvb + (size_t)((c - 12) * 128 + r) * 256; };
    tile_loop2(128, 28, [&](int rt, int ct, bool hn, int nrt, int nct) {
        const bool isq = ct < 12;
        auto rrow = [&](int rl) { const f32x4 q4 = *(const f32x4*)(SSQ + (size_t)(rt * 128 + rl) * 8 + (isq ? 0 : 4)); return rsqrtf(((q4[0] + q4[1]) + (q4[2] + q4[3])) * (1.0f / 256.0f) + 1e-6f); };
        f32x4 acc[4][4];
        if (isq) {
            gemm_core_pf<true>(acc, xpf, wpf, rt, ct, 4, hn, nrt, nct, gp, smem);
            const int cb = ct * 128 + wc * 64;
#pragma unroll
            for (int m = 0; m < 4; ++m) {
                const int rl = wr * 64 + m * 16 + fr, row = rt * 128 + rl, pos = row & (SEQ - 1);
                const float sc = rrow(rl);
#pragma unroll
                for (int n = 0; n < 4; ++n) acc[m][n] = acc[m][n] * sc;
#pragma unroll
                for (int n = 0; n < 4; n += 2) {
                    if (((cb + n * 16) % 96) == 64) {
#pragma unroll
                        for (int e = 0; e < 4; ++e) {
                            const f32x2 cs = rope[pos * 16 + 4 * fq + e];
                            const float x1 = acc[m][n][e], x2 = acc[m][n + 1][e];
                            acc[m][n][e] = x1 * cs[0] - x2 * cs[1]; acc[m][n + 1][e] = x1 * cs[1] + x2 * cs[0];
                        }
                    }
                }
#pragma unroll
                for (int n = 0; n < 4; ++n) *(f16x4*)(Q16 + (size_t)row * 1536 + cb + n * 16 + 4 * fq) = cvt4(acc[m][n]);
            }
        } else {
            const int c2 = ct - 12;
            if (c2 < 8) {
                gemm_core_pf<true>(acc, xpf, wpf, rt, ct, 4, hn, nrt, nct, gp, smem);
#pragma unroll
                for (int m = 0; m < 4; ++m) {
                    const int rl = wr * 64 + m * 16 + fr; const float sc = rrow(rl);
#pragma unroll
                    for (int n = 0; n < 4; ++n) *(f16x4*)(KN + (size_t)(rt * 128 + rl) * 1024 + c2 * 128 + wc * 64 + n * 16 + 4 * fq) = cvt4(acc[m][n] * sc);
                }
            } else {
                gemm_core_pf<false>(acc, xpf, wpf, rt, ct, 4, hn, nrt, nct, gp, smem);
#pragma unroll
                for (int m = 0; m < 4; ++m) {
                    const int rl = wr * 64 + m * 16 + 4 * fq, row = rt * 128 + rl, b = row >> 12, s = row & (SEQ - 1);
                    f32x4 sc; sc[0] = rrow(rl); sc[1] = rrow(rl + 1); sc[2] = rrow(rl + 2); sc[3] = rrow(rl + 3);
#pragma unroll
                    for (int n = 0; n < 4; ++n) {
                        const int col = (c2 - 8) * 128 + wc * 64 + n * 16 + fr, h = col >> 6, d = col & 63;
                        *(f16x4*)(VT + ((size_t)((b * 16 + h) * 64 + d)) * SEQ + s) = cvt4(acc[m][n] * sc);
                    }
                }
            }
        }
    });
}

__device__ __forceinline__ f32x4 mfma16(f16x8 a, f16x8 b, f32x4 c) { return __builtin_amdgcn_mfma_f32_16x16x32_f16(a, b, c, 0, 0, 0); }
__device__ __forceinline__ f16x8 cat4(f16x4 lo, f16x4 hi) { return __builtin_shufflevector(lo, hi, 0, 1, 2, 3, 4, 5, 6, 7); }

__device__ __forceinline__ void phase_mla_attn(const Params& p, char* smem) {
    const int tid = TID, lane = tid & 63, wid = tid >> 6, li = lane & 15, g = lane >> 4;
    const f16* Q16 = (const f16*)(WS + S_Q16); const f16* KN = (const f16*)(WS + S_KN16); const f16* KPE = (const f16*)(WS + S_KPE);
    const f16* VT = (const f16*)(WS + S_VT16); f16* O = (f16*)(WS + S_MIX16);
    constexpr int BUF = 20480;
    const int sc8 = ((tid & 7) ^ ((tid >> 4) & 7)) * 8;
    const int scp = ((tid & 3) ^ ((0x78 >> (2 * ((tid >> 4) & 3))) & 3)) * 8;
    const int kn_rd0 = ((0 + g) ^ (li >> 1)) * 16, kn_rd1 = ((4 + g) ^ (li >> 1)) * 16;
    const int kp_rd = (g ^ ((0x78 >> (2 * ((li >> 2) & 3))) & 3)) * 16;
    const int v_rd[4] = {(((0 + (g >> 1)) ^ (li >> 1)) * 16) + (g & 1) * 8, (((2 + (g >> 1)) ^ (li >> 1)) * 16) + (g & 1) * 8,
                         (((4 + (g >> 1)) ^ (li >> 1)) * 16) + (g & 1) * 8, (((6 + (g >> 1)) ^ (li >> 1)) * 16) + (g & 1) * 8};
    const int nb_ = NBLK, xcd_ = BID & 7, lb_ = BID >> 3, nlb_ = nb_ >> 3;
    for (int j_ = lb_; j_ < 128; j_ += nlb_) {
        const int bh = xcd_ * 8 + (j_ >> 4), pr = j_ & 15, b = bh >> 4, h = bh & 15;
        const size_t tb = (size_t)b * SEQ;
        for (int half = 0; half < 2; ++half) {
            const int qb = half ? pr : 31 - pr;
            const int qw = qb * 128 + wid * 32;
            const int nch = 2 * qb + 2, lastw = (qw + 31) >> 6;
            f16x8 Qf[2][3];
#pragma unroll
            for (int jq = 0; jq < 2; ++jq)
#pragma unroll
                for (int ks = 0; ks < 3; ++ks) Qf[jq][ks] = *(const f16x8*)(Q16 + (tb + qw + jq * 16 + li) * 1536 + h * 96 + ks * 32 + 8 * g);
            asm volatile("s_waitcnt vmcnt(0)" ::: "memory");
#pragma unroll
            for (int jq = 0; jq < 2; ++jq)
#pragma unroll
                for (int ks = 0; ks < 3; ++ks) asm volatile("" : "+v"(Qf[jq][ks]));
            f32x4 Oa[5][2];
#pragma unroll
            for (int vb = 0; vb < 5; ++vb) { Oa[vb][0] = (f32x4){0.f, 0.f, 0.f, 0.f}; Oa[vb][1] = (f32x4){0.f, 0.f, 0.f, 0.f}; }
            f16x8 ones;
#pragma unroll
            for (int e = 0; e < 8; ++e) ones[e] = (f16)1.0f;
            const f16* kn_src = KN + (tb + (tid >> 3)) * 1024 + h * 64 + sc8;
            const f16* kp_src = KPE + (tb + (tid >> 2)) * 32 + scp;
            const f16* v_src = VT + ((size_t)((b * 16 + h) * 64 + (tid >> 3))) * SEQ + sc8;
            auto stage = [&](int kc, int s) {
                char* base = smem + s * BUF + tid * 16;
                __builtin_amdgcn_global_load_lds((const void*)(kn_src + (size_t)kc * 64 * 1024), (LAS void*)(base), 16, 0, 0);
                __builtin_amdgcn_global_load_lds((const void*)(kn_src + (size_t)(kc * 64 + 32) * 1024), (LAS void*)(base + 4096), 16, 0, 0);
                __builtin_amdgcn_global_load_lds((const void*)(v_src + kc * 64), (LAS void*)(base + 8192), 16, 0, 0);
                __builtin_amdgcn_global_load_lds((const void*)(v_src + (size_t)32 * SEQ + kc * 64), (LAS void*)(base + 8192 + 4096), 16, 0, 0);
                __builtin_amdgcn_global_load_lds((const void*)(kp_src + (size_t)kc * 64 * 32), (LAS void*)(base + 16384), 16, 0, 0);
            };
            BSYNC();
            stage(0, 0);
            if (nch > 1) stage(1, 1);
            for (int kc = 0; kc < nch; ++kc) {
                const int s = kc % 3;
                if (kc + 1 < nch) asm volatile("s_waitcnt vmcnt(5) lgkmcnt(0)" ::: "memory"); else asm volatile("s_waitcnt vmcnt(0) lgkmcnt(0)" ::: "memory");
                __builtin_amdgcn_s_barrier();
                asm volatile("" ::: "memory");
                if (kc + 2 < nch) stage(kc + 2, (kc + 2) % 3);
                if (kc > lastw) continue;
                const char* bK = smem + s * BUF; const char* bV = bK + 8192; const char* bP = bK + 16384;
                f32x4 Sx[4][2];
#pragma unroll
                for (int kb = 0; kb < 4; ++kb) { Sx[kb][0] = (f32x4){-8.f, -8.f, -8.f, -8.f}; Sx[kb][1] = (f32x4){-8.f, -8.f, -8.f, -8.f}; }
#pragma unroll
                for (int kb = 0; kb < 4; ++kb) {
                    const f16x8 K0 = *(const f16x8*)(bK + (kb * 16 + li) * 128 + kn_rd0);
                    const f16x8 K1 = *(const f16x8*)(bK + (kb * 16 + li) * 128 + kn_rd1);
                    const f16x8 K2 = *(const f16x8*)(bP + (kb * 16 + li) * 64 + kp_rd);
                    Sx[kb][0] = mfma16(K0, Qf[0][0], Sx[kb][0]); Sx[kb][1] = mfma16(K0, Qf[1][0], Sx[kb][1]);
                    Sx[kb][0] = mfma16(K1, Qf[0][1], Sx[kb][0]); Sx[kb][1] = mfma16(K1, Qf[1][1], Sx[kb][1]);
                    Sx[kb][0] = mfma16(K2, Qf[0][2], Sx[kb][0]); Sx[kb][1] = mfma16(K2, Qf[1][2], Sx[kb][1]);
                }
                if (kc * 64 + 63 > qw) {
#pragma unroll
                    for (int jq = 0; jq < 2; ++jq) {
                        const int qpos = qw + jq * 16 + li;
#pragma unroll
                        for (int kb = 0; kb < 4; ++kb)
#pragma unroll
                            for (int r = 0; r < 4; ++r)
                                if (kc * 64 + kb * 16 + 4 * g + r > qpos) Sx[kb][jq][r] = -1e4f;
                    }
                }
                f16x8 Pf[2][2];
#pragma unroll
                for (int jq = 0; jq < 2; ++jq) {
#pragma unroll
                    for (int kb = 0; kb < 4; ++kb)
#pragma unroll
                        for (int r = 0; r < 4; ++r) Sx[kb][jq][r] = __builtin_amdgcn_exp2f(Sx[kb][jq][r]);
                    Pf[jq][0] = cat4(cvt4(Sx[0][jq]), cvt4(Sx[1][jq]));
                    Pf[jq][1] = cat4(cvt4(Sx[2][jq]), cvt4(Sx[3][jq]));
                }
#pragma unroll
                for (int kp = 0; kp < 2; ++kp) {
#pragma unroll
                    for (int vb = 0; vb < 4; ++vb) {
                        const char* vp = bV + (vb * 16 + li) * 128;
                        const f16x8 Vf = cat4(*(const f16x4*)(vp + v_rd[kp * 2]), *(const f16x4*)(vp + v_rd[kp * 2 + 1]));
                        Oa[vb][0] = mfma16(Vf, Pf[0][kp], Oa[vb][0]);
                        Oa[vb][1] = mfma16(Vf, Pf[1][kp], Oa[vb][1]);
                    }
                    Oa[4][0] = mfma16(ones, Pf[0][kp], Oa[4][0]);
                    Oa[4][1] = mfma16(ones, Pf[1][kp], Oa[4][1]);
                }
            }
#pragma unroll
            for (int jq = 0; jq < 2; ++jq) {
                const float inv = 1.0f / Oa[4][jq][0];
#pragma unroll
                for (int vb = 0; vb < 4; ++vb)
                    *(f16x4*)(O + (tb + qw + jq * 16 + li) * 1024 + h * 64 + vb * 16 + 4 * g) = cvt4(Oa[vb][jq] * inv);
            }
        }
    }
}

__device__ __forceinline__ void phase_xa_scores(const Params& p, int L, char* smem) {
    WAVE_IDS
    const f16* X = (const f16*)(WS + S_Y32R); const float* PST = (const float*)(WS + S_PST1);
    const float* XU = (const float*)(WS + OFF_XU) + (size_t)(L * 4) * 1024; const float* XC = (const float*)(WS + OFF_XC) + (size_t)(L * 4) * 1024;
    f16* XP = (f16*)(WS + S_XP16); float* LP = (float*)(WS + S_XLP);
    float* srow = (float*)(smem + SMEM_MAIN + 1024);
    GPipe gp{0, 0};
    const f16* XMb = (const f16*)(WS + OFF_XM) + (size_t)(L * 4) * 1024 * 1024;
    tile_loop2(128, 8, [&](int rt, int ct, bool hn, int nrt, int nct) {
        row_stats_table(PST, [&](int r) { return rt * 128 + r; }, srow);
        f32x4 acc[4][4];
        gemm_core_pf<true>(acc, [&](int a, int, int r) { return X + (size_t)(a * 128 + r) * 1024; },
                           [&](int a, int c, int r) { return XMb + (size_t)(a >> 5) * 1024 * 1024 + (size_t)(c * 128 + r) * 1024; }, rt, ct, 16, hn, nrt, nct, gp, smem);
        f32x4 u4[4], c4[4];
#pragma unroll
        for (int n = 0; n < 4; ++n) { const int col = (rt >> 5) * 1024 + ct * 128 + wc * 64 + n * 16 + 4 * fq; u4[n] = *(const f32x4*)(XU + col); c4[n] = *(const f32x4*)(XC + col); }
#pragma unroll
        for (int m = 0; m < 4; ++m) {
            const int row = rt * 128 + wr * 64 + m * 16 + fr;
            const f32x2 st = *(const f32x2*)(srow + (wr * 64 + m * 16 + fr) * 2);
            float ps = 0.f;
#pragma unroll
            for (int n = 0; n < 4; ++n) {
                const f32x4 sc = (acc[m][n] - u4[n] * st[0]) * st[1] + c4[n];
                f32x4 e;
#pragma unroll
                for (int q = 0; q < 4; ++q) e[q] = __builtin_amdgcn_exp2f(sc[q] - 8.0f);
                const f16x4 e16 = cvt4(e);
                const f32x4 er = cvt4f(e16);
                ps += (er[0] + er[1]) + (er[2] + er[3]);
                *(f16x4*)(XP + (size_t)row * 1024 + ct * 128 + wc * 64 + n * 16 + 4 * fq) = e16;
            }
            ps += __shfl_xor(ps, 16); ps += __shfl_xor(ps, 32);
            if (fq == 0) LP[(size_t)row * 16 + ct * 2 + wc] = ps;
        }
    });
}

__device__ __forceinline__ void phase_router(const Params& p, int L, char* smem) {
    WAVE_IDS
    const f16* X = (const f16*)(WS + S_Y32R);
    const float* PST = (const float*)(WS + S_PST2); const float* ruc = (const float*)(WS + OFF_RUC) + L * 128;
    float* srow = (float*)(smem + SMEM_MAIN + 1024);
    const f16* Wt = (const f16*)(WS + W_ROUTER) + (size_t)L * 128 * 1024;
    unsigned* cnt = (unsigned*)(WS + OFF_CNT) + L * 32;
    unsigned* list = (unsigned*)(WS + S_LIST); float* gates = (float*)(WS + S_GATES);
    const float* bg = IN(33) + L * 4; const float* be = IN(35) + L * 32;
    float* lg = (float*)smem;
    int* hist = (int*)(smem + 128 * 40 * 4); int* base = hist + 32;
    for (int rt = BID; rt < 128; rt += NBLK) {
        row_stats_table(PST, [&](int r) { return rt * 128 + r; }, srow);
        f32x4 acc[4][4];
        gemm_core<true>(acc, [&](int r) { return X + (size_t)(rt * 128 + r) * 1024; }, [&](int r) { return Wt + (size_t)r * 1024; }, 16, smem);
        BSYNC();
        if (wc == 0) {
#pragma unroll
            for (int m = 0; m < 4; ++m) {
                const int row = wr * 64 + m * 16 + fr;
                const f32x2 st = *(const f32x2*)(srow + row * 2);
#pragma unroll
                for (int n = 0; n < 3; ++n) {
                    const int col = n * 16 + 4 * fq;
                    if (col < 40) *(f32x4*)(lg + row * 40 + col) = (acc[m][n] - *(const f32x4*)(ruc + col) * st[0]) * st[1] + *(const f32x4*)(ruc + 64 + col);
                }
            }
        }
        if (tid < 32) hist[tid] = 0;
        BSYNC();
        int e0 = 0, e1 = 0, p0 = 0, p1 = 0; float g0 = 0.f, g1 = 0.f;
        if (tid < 128) {
            const float* l = lg + tid * 40;
            int grp = 0; float gm = l[0] + bg[0];
            for (int i = 1; i < 4; ++i) { const float v = l[i] + bg[i]; if (v > gm) { gm = v; grp = i; } }
            float den = 0.f;
            for (int i = 0; i < 4; ++i) den += __expf(l[i] + bg[i] - gm);
            const float pg = 1.0f / den;
            int i1 = 0; float v1 = l[4 + grp * 8] + be[grp * 8];
            for (int i = 1; i < 8; ++i) { const float v = l[4 + grp * 8 + i] + be[grp * 8 + i]; if (v > v1) { v1 = v; i1 = i; } }
            int i2 = -1; float v2 = -3.0e38f;
            for (int i = 0; i < 8; ++i) { const float v = l[4 + grp * 8 + i] + be[grp * 8 + i]; if (i != i1 && v > v2) { v2 = v; i2 = i; } }
            const float ex = __expf(v2 - v1);
            g0 = pg / (1.0f + ex); g1 = pg * ex / (1.0f + ex);
            e0 = grp * 8 + i1; e1 = grp * 8 + i2;
            p0 = atomicAdd(&hist[e0], 1); p1 = atomicAdd(&hist[e1], 1);
        }
        BSYNC();
        if (tid < 32) base[tid] = hist[tid] ? (int)atomicAdd(&cnt[tid], (unsigned)hist[tid]) : 0;
        BSYNC();
        if (tid < 128) {
            const int t = rt * 128 + tid;
            list[(size_t)e0 * 16384 + base[e0] + p0] = (unsigned)(t * 2);
            list[(size_t)e1 * 16384 + base[e1] + p1] = (unsigned)(t * 2 + 1);
            gates[t * 2] = g0; gates[t * 2 + 1] = g1;
        }
    }
}

__device__ __forceinline__ void moe_blocks(const Params& p, int L, char* smem, int* bs) {
    const unsigned* cnt = (const unsigned*)(WS + OFF_CNT) + L * 32;
    BSYNC();
    if (TID == 0) { int a = 0; for (int e = 0; e < 32; ++e) { bs[e] = a; a += ((int)cnt[e] + 127) >> 7; } bs[32] = a; }
    BSYNC();
}

__device__ __forceinline__ void phase_moe_up(const Params& p, int L, char* smem) {
    WAVE_IDS
    int* bs = (int*)(smem + SMEM_MAIN + 64); int* rowtok = bs + 40;
    moe_blocks(p, L, smem, bs);
    const unsigned* cnt = (const unsigned*)(WS + OFF_CNT) + L * 32; const unsigned* list = (const unsigned*)(WS + S_LIST);
    const f16* X = (const f16*)(WS + S_Y32R); f16* HB = (f16*)(WS + S_HBUF);
    const float* PST = (const float*)(WS + S_PST2); float* srow = (float*)(smem + SMEM_MAIN + 1024);
    const int nitems = bs[32] * 8;
    for (int item = BID; item < nitems; item += NBLK) {
        const int rbg = item >> 3, nt = item & 7;
        int e = 0; for (int i = 1; i < 32; ++i) if (bs[i] <= rbg) e = i;
        const int rb = rbg - bs[e], nrow = (int)cnt[e] - rb * 128;
        BSYNC();
        if (tid < 128) rowtok[tid] = (tid < nrow) ? (int)(list[(size_t)e * 16384 + rb * 128 + tid] >> 1) : 0;
        BSYNC();
        row_stats_table(PST, [&](int r) { return rowtok[r]; }, srow);
        const f16* Wt = (const f16*)(WS + W_GU) + ((size_t)(L * 32 + e) * 1024 + nt * 128) * 1024;
        f32x4 acc[4][4];
        gemm_core<true>(acc, [&](int r) { return X + (size_t)rowtok[r] * 1024; }, [&](int r) { return Wt + (size_t)r * 1024; }, 16, smem);
        f32x4 u4[4], c4[4];
#pragma unroll
        for (int n = 0; n < 4; ++n) {
            const size_t o = (size_t)(L * 32 + e) * 1024 + nt * 128 + wc * 64 + n * 16 + 4 * fq;
            u4[n] = *(const f32x4*)((const float*)(WS + OFF_MU) + o); c4[n] = *(const f32x4*)((const float*)(WS + OFF_MC) + o);
        }
#pragma unroll
        for (int m = 0; m < 4; ++m) {
            const f32x2 st = *(const f32x2*)(srow + (wr * 64 + m * 16 + fr) * 2);
#pragma unroll
            for (int n = 0; n < 2; ++n) {
                const f32x4 gt = (acc[m][n] - u4[n] * st[0]) * st[1] + c4[n], up = (acc[m][n + 2] - u4[n + 2] * st[0]) * st[1] + c4[n + 2];
                f32x4 o;
#pragma unroll
                for (int q = 0; q < 4; ++q) { const float gv = gt[q]; o[q] = gv * sigmoid_(gv) * up[q]; }
                *(f16x4*)(HB + (size_t)(rbg * 128 + wr * 64 + m * 16 + fr) * 512 + nt * 64 + wc * 32 + n * 16 + 4 * fq) = cvt4(o);
            }
        }
    }
}

__device__ __forceinline__ void phase_moe_down(const Params& p, int L, char* smem) {
    WAVE_IDS
    int* bs = (int*)(smem + SMEM_MAIN + 64); int* rowent = bs + 40;
    moe_blocks(p, L, smem, bs);
    const unsigned* cnt = (const unsigned*)(WS + OFF_CNT) + L * 32; const unsigned* list = (const unsigned*)(WS + S_LIST);
    const float* gates = (const float*)(WS + S_GATES);
    const f16* HB = (const f16*)(WS + S_HBUF); f16* FF = (f16*)(WS + S_FF16);
    const int nitems = bs[32] * 8;
    for (int item = BID; item < nitems; item += NBLK) {
        const int rbg = item >> 3, nt = item & 7;
        int e = 0; for (int i = 1; i < 32; ++i) if (bs[i] <= rbg) e = i;
        const int rb = rbg - bs[e], nrow = (int)cnt[e] - rb * 128;
        BSYNC();
        if (tid < 128) rowent[tid] = (tid < nrow) ? (int)list[(size_t)e * 16384 + rb * 128 + tid] : -1;
        BSYNC();
        const f16* Wt = (const f16*)(WS + W_D) + ((size_t)(L * 32 + e) * 1024 + nt * 128) * 512;
        f32x4 acc[4][4];
        gemm_core<true>(acc, [&](int r) { return HB + (size_t)(rbg * 128 + r) * 512; }, [&](int r) { return Wt + (size_t)r * 512; }, 8, smem);
#pragma unroll
        for (int m = 0; m < 4; ++m) {
            const int ent = rowent[wr * 64 + m * 16 + fr];
            if (ent >= 0) {
                const float gt = gates[ent];
                f16* dst = FF + ((size_t)(ent & 1) * T + (ent >> 1)) * 1024 + nt * 128 + wc * 64 + 4 * fq;
#pragma unroll
                for (int n = 0; n < 4; ++n) *(f16x4*)(dst + n * 16) = cvt4(acc[m][n] * gt);
            }
        }
    }
}

constexpr int NPHASES = 1 + 2 * 12 + 2 * 10;

__global__ void __launch_bounds__(256, 2) trunk_kernel(Params p) {
    __shared__ __attribute__((aligned(16))) char smem[SMEM_BYTES];
    volatile LAS unsigned* st = (volatile LAS unsigned*)(smem + SMEM_MAIN);
#if MEGA
    if (threadIdx.x == 0) { st[0] = 0u; st[1] = 0u; }
    BSYNC();
    const XcdBarrier xb = xcd_barrier_post((unsigned*)(WS + OFF_BAR), st);
#endif
    int ph = 0;
    char* ws = p.ws;
    f16* y16 = (f16*)(ws + S_Y32R); f16* h16 = (f16*)(ws + OFF_H16);
#ifndef ENMASK
#define ENMASK 0xFFFFFFFFu
#endif
#define EN(k) (((ENMASK) >> (k)) & 1u)
#ifndef REPMASK
#define REPMASK 0u
#endif
#ifndef REPN
#define REPN 2
#endif
#define NREP(k) ((((REPMASK) >> (k)) & 1u) ? (1 + REPN) : 1)
#if MEGA
#define STEP(k, ...) do { if (ph >= p.ph_begin && ph < p.ph_end) { if (EN(k)) { for (int rep_ = 0; rep_ < NREP(k); ++rep_) { __VA_ARGS__; } } if (ph + 1 < p.ph_end) xcd_barrier(xb); } ++ph; } while (0)
#else
#define STEP(k, ...) do { if (ph >= p.ph_begin && ph < p.ph_end) { if (EN(k)) { for (int rep_ = 0; rep_ < NREP(k); ++rep_) { __VA_ARGS__; } } } ++ph; } while (0)
#endif
    STEP(0, phase_convert(p, smem));
    for (int L = 0; L < 4; ++L) {
        const int j = L >> 1;
        const float* res32 = (L == 0) ? IN(0) : (const float*)nullptr;
        if ((L & 1) == 0) {
            STEP(1, phase_ab_in(p, j, smem); if (L == 0) phase_memkv(p, smem));
            STEP(2, phase_shift(p, j));
            STEP(3, phase_lora(p, j, smem));
            STEP(4, phase_rec_sg(p, j, L == 0, L != 0, smem));
            STEP(5, if (L != 0) phase_rw_fin_seg(p, j, smem); else { phase_rw_fin(p, j); xa_uc_reduce(p); moe_uc_reduce(p); });
            STEP(6, phase_gemm_res((const f16*)(ws + S_MIX16), (const f16*)(ws + W_ABOUT) + (size_t)j * 1024 * 1024, res32, h16, y16, (float*)(ws + S_PST1), smem));
        } else {
            STEP(7, phase_mla_in(p, j, smem));
            STEP(8, phase_mla_qkv(p, j, smem));
            STEP(9, phase_mla_attn(p, smem));
            STEP(6, phase_gemm_res((const f16*)(ws + S_MIX16), (const f16*)(ws + W_MLAOUT) + (size_t)j * 1024 * 1024, res32, h16, y16, (float*)(ws + S_PST1), smem));
        }
        STEP(11, phase_xa_scores(p, L, smem));
        STEP(12, phase_xa_out(p, L, y16, smem));
        STEP(13, phase_router(p, L, smem));
        STEP(14, phase_moe_up(p, L, smem));
        STEP(15, phase_moe_down(p, L, smem));
        STEP(10, phase_ln<1>(y16, (const f16*)(ws + S_FF16), (const f16*)(ws + S_FF16) + (size_t)T * 1024, IN(30) + L * 1024, IN(31) + L * 1024, IN(39) + L * 1024, IN(40) + L * 1024,
                         (L == 3) ? p.out : (float*)nullptr, (L == 3) ? (f16*)nullptr : h16, nullptr));
    }
}

}

extern "C" void kernel_launch(void* const* d_in, const int* in_sizes, int n_in, void* d_out, int out_size, void* d_ws, size_t ws_size, hipStream_t stream) {
    (void)in_sizes; (void)n_in; (void)out_size; (void)ws_size;
    static int grid_blocks = 0;
    if (!grid_blocks) {
        int dev = 0, cus = 0, per_cu = 0;
        hipGetDevice(&dev);
        hipDeviceGetAttribute(&cus, hipDeviceAttributeMultiprocessorCount, dev);
        hipOccupancyMaxActiveBlocksPerMultiprocessor(&per_cu, trunk_kernel, 256, 0);
        if (per_cu > 2) per_cu = 2;
        if (per_cu < 1) per_cu = 1;
        grid_blocks = cus * per_cu;
        grid_blocks &= ~7;
    }
    Params p{};
    for (int i = 0; i < 41; ++i) p.in[i] = (const float*)d_in[i];
    p.out = (float*)d_out;
    p.ws = (char*)d_ws;
    hipMemsetAsync((char*)d_ws + OFF_BAR, 0, XCD_BAR_WORDS * 4, stream);
#if MEGA
    p.ph_begin = 0; p.ph_end = NPHASES;
    void* args[] = {&p};
    hipError_t e = hipLaunchCooperativeKernel((const void*)trunk_kernel, dim3(grid_blocks), dim3(256), args, 0, stream);
    if (e != hipSuccess) fprintf(stderr, "cooperative launch failed: %s (grid %d)\n", hipGetErrorString(e), grid_blocks);
#else
    for (int ph = 0; ph < NPHASES; ++ph) {
        p.ph_begin = ph; p.ph_end = ph + 1;
        hipLaunchKernelGGL(trunk_kernel, dim3(grid_blocks), dim3(256), 0, stream, p);
    }
#endif
}
```

```cpp
#include <hip/hip_runtime.h>
#include <stdint.h>
#include <stdio.h>

#ifndef MEGA
#define MEGA 1
#endif
#ifndef FAST_GEMM
#define FAST_GEMM 1
#endif
#ifndef FAST_REC
#define FAST_REC 1
#endif

typedef _Float16 f16;
typedef f16 f16x8 __attribute__((ext_vector_type(8)));
typedef f16 f16x4 __attribute__((ext_vector_type(4)));
typedef float f32x4 __attribute__((ext_vector_type(4)));
typedef float f32x2 __attribute__((ext_vector_type(2)));
#define LAS __attribute__((address_space(3)))

namespace {

constexpr int T = 16384, SEQ = 4096, D = 1024;
constexpr float DN_ALPHA = 1.681792830507429f;
constexpr float LOG2E = 1.4426950408889634f;

constexpr size_t al(size_t x) { return (x + 255) & ~(size_t)255; }
constexpr size_t OFF_BAR   = 0;
constexpr size_t OFF_CNT   = 16384;
constexpr size_t OFF_ROPE  = 32768;
constexpr size_t OFF_H32   = OFF_ROPE + al((size_t)SEQ * 16 * 8);
constexpr size_t OFF_H16   = OFF_H32 + al((size_t)T * D * 4);
constexpr size_t OFF_MEM16 = OFF_H16 + al((size_t)T * D * 2);
constexpr size_t OFF_KVMEM = OFF_MEM16 + al((size_t)1024 * 1024 * 2);
constexpr size_t OFF_XM    = OFF_KVMEM + al((size_t)4 * 1024 * 2048 * 2);
constexpr size_t OFF_XN    = OFF_XM + al((size_t)16 * 1024 * 1024 * 2);
constexpr size_t OFF_XUP   = OFF_XN + al((size_t)16 * 1024 * 1024 * 2);
constexpr size_t OFF_XCP   = OFF_XUP + al((size_t)16 * 1024 * 16 * 4);
constexpr size_t OFF_XU    = OFF_XCP + al((size_t)16 * 1024 * 16 * 4);
constexpr size_t OFF_XC    = OFF_XU + al((size_t)16 * 1024 * 4);
constexpr size_t W_ABIN    = OFF_XC + al((size_t)16 * 1024 * 4);
constexpr size_t W_W2T     = W_ABIN + al((size_t)2 * 2816 * 1024 * 2);
constexpr size_t W_A2T     = W_W2T + al((size_t)2 * 512 * 64 * 2);
constexpr size_t W_G2T     = W_A2T + al((size_t)2 * 512 * 64 * 2);
constexpr size_t W_SGW     = W_G2T + al((size_t)2 * 512 * 128 * 2);
constexpr size_t W_ABOUT   = W_SGW + al((size_t)2 * 4 * 128 * 128 * 2);
constexpr size_t W_MLAIN   = W_ABOUT + al((size_t)2 * 1024 * 1024 * 2);
constexpr size_t W_Q       = W_MLAIN + al((size_t)2 * 640 * 1024 * 2);
constexpr size_t W_KV      = W_Q + al((size_t)2 * 1536 * 256 * 2);
constexpr size_t W_MLAOUT  = W_KV + al((size_t)2 * 2048 * 256 * 2);
constexpr size_t W_XAQ     = W_MLAOUT + al((size_t)2 * 1024 * 1024 * 2);
constexpr size_t W_XAKV    = W_XAQ + al((size_t)4 * 1024 * 1024 * 2);
constexpr size_t W_XAO     = W_XAKV + al((size_t)4 * 2048 * 1024 * 2);
constexpr size_t W_ROUTER  = W_XAO + al((size_t)4 * 1024 * 1024 * 2);
constexpr size_t W_GU      = W_ROUTER + al((size_t)4 * 128 * 1024 * 2);
constexpr size_t W_D       = W_GU + al((size_t)4 * 32 * 1024 * 1024 * 2);
constexpr size_t OFF_SCR   = W_D + al((size_t)4 * 32 * 1024 * 512 * 2);
constexpr size_t S_P16   = OFF_SCR;
constexpr size_t S_PS16  = S_P16 + al((size_t)T * 2816 * 2);
constexpr size_t S_WD32  = S_PS16 + al((size_t)T * 1792 * 2);
constexpr size_t S_NKK   = S_WD32 + al((size_t)T * 512 * 4);
constexpr size_t S_BB    = S_NKK + al((size_t)T * 512 * 2);
constexpr size_t S_KP    = S_BB + al((size_t)T * 512 * 2);
constexpr size_t S_G16   = S_KP + al((size_t)T * 512 * 2);
constexpr size_t S_BSUM  = S_G16 + al((size_t)T * 512 * 2);
constexpr size_t S_Y32   = S_BSUM + al((size_t)T * 8 * 4);
constexpr size_t S_ZT    = S_Y32 + al((size_t)T * 512 * 4);
constexpr size_t S_MIX16 = S_ZT + al((size_t)512 * 128 * 128 * 2);
constexpr size_t S_YT    = S_MIX16 + al((size_t)T * 1024 * 2);
constexpr size_t S_SMID  = S_YT + al((size_t)T * 512 * 4);
constexpr size_t S_END_EVEN = S_SMID + al((size_t)32 * 64 * 64 * 4);
constexpr size_t S_CQKV  = OFF_SCR;
constexpr size_t S_KPE   = S_CQKV + al((size_t)T * 512 * 2);
constexpr size_t S_Q16   = S_KPE + al((size_t)T * 32 * 2);
constexpr size_t S_KN16  = S_Q16 + al((size_t)T * 1536 * 2);
constexpr size_t S_VT16  = S_KN16 + al((size_t)T * 1024 * 2);
constexpr size_t S_SSQ   = S_VT16 + al((size_t)T * 1024 * 2);
constexpr size_t S_END_ODD = S_SSQ + al((size_t)T * 8 * 4);
constexpr size_t S_XP16  = OFF_SCR;
constexpr size_t S_XLP   = S_XP16 + al((size_t)T * 1024 * 2);
constexpr size_t S_XSTAT = S_XLP + al((size_t)T * 16 * 4);
constexpr size_t S_PST1  = S_XSTAT + al((size_t)T * 2 * 4);
constexpr size_t S_LIST  = OFF_SCR;
constexpr size_t S_GATES = S_LIST + al((size_t)32 * 16384 * 4);
constexpr size_t S_HBUF  = S_GATES + al((size_t)T * 2 * 4);
constexpr size_t S_FF16  = S_HBUF + al((size_t)36864 * 512 * 2);
constexpr size_t S_END_MOE = S_FF16 + al((size_t)2 * T * 1024 * 2);
constexpr size_t S_Y32R  = OFF_SCR + (size_t)128 * 1024 * 1024;
static_assert(S_Y32R + (size_t)T * 1024 * 4 <= S_MIX16, "y32 overlay");
static_assert(S_END_ODD <= S_MIX16, "odd overlay");
static_assert(S_END_MOE <= S_MIX16, "moe overlay");
static_assert(S_END_EVEN <= (size_t)1024 * 1024 * 1024, "workspace");

constexpr int SMEM_MAIN = 65536;
constexpr int SMEM_BYTES = SMEM_MAIN + 2048;

struct Params {
    const float* in[41];
    float* out;
    char* ws;
    int ph_begin, ph_end;
};

__device__ __forceinline__ int opq_s(int x) { asm volatile("" : "+v"(x)); return __builtin_amdgcn_readfirstlane(x); }
__device__ __forceinline__ int opq_v(int x) { asm volatile("" : "+v"(x)); return x; }
#define TID opq_v((int)threadIdx.x)
#define BID opq_s((int)blockIdx.x)
#define NBLK opq_s((int)gridDim.x)
__device__ __forceinline__ const float* opq_p(const float* q) {
    const uint64_t u = (uint64_t)q; uint32_t lo = (uint32_t)u, hi = (uint32_t)(u >> 32);
    asm volatile("" : "+v"(lo), "+v"(hi));
    lo = __builtin_amdgcn_readfirstlane(lo); hi = __builtin_amdgcn_readfirstlane(hi);
    return (const float*)(((uint64_t)hi << 32) | lo);
}
typedef const __attribute__((address_space(4))) Params* KargPtr;
__device__ __forceinline__ KargPtr kparams() {
    const uint64_t u = (uint64_t)__builtin_amdgcn_kernarg_segment_ptr(); uint32_t lo = (uint32_t)u, hi = (uint32_t)(u >> 32);
    asm volatile("" : "+v"(lo), "+v"(hi));
    lo = __builtin_amdgcn_readfirstlane(lo); hi = __builtin_amdgcn_readfirstlane(hi);
    return (KargPtr)(((uint64_t)hi << 32) | lo);
}
#define IN(k) (kparams()->in[k])
#define WS (kparams()->ws)

__device__ __forceinline__ float sigmoid_(float x) { return 1.0f / (1.0f + __expf(-x)); }
__device__ __forceinline__ float tanh_(float x) { return 1.0f - 2.0f / (1.0f + __expf(2.0f * x)); }
__device__ __forceinline__ float gelu_(float x) { const float u = 0.7978845608028654f * (x + 0.044715f * x * x * x); return 0.5f * x * (1.0f + tanh_(u)); }
__device__ __forceinline__ float dpp_ror(float x, int) { return x; }
__device__ __forceinline__ float row16_sum(float x) {
    x += __builtin_bit_cast(float, __builtin_amdgcn_update_dpp(0, __builtin_bit_cast(int, x), 0x128, 0xf, 0xf, false));
    x += __builtin_bit_cast(float, __builtin_amdgcn_update_dpp(0, __builtin_bit_cast(int, x), 0x124, 0xf, 0xf, false));
    x += __builtin_bit_cast(float, __builtin_amdgcn_update_dpp(0, __builtin_bit_cast(int, x), 0x122, 0xf, 0xf, false));
    x += __builtin_bit_cast(float, __builtin_amdgcn_update_dpp(0, __builtin_bit_cast(int, x), 0x121, 0xf, 0xf, false));
    return x;
}
__device__ __forceinline__ float wave_sum(float x) {
    x += __shfl_xor(x, 32); x += __shfl_xor(x, 16); x += __shfl_xor(x, 8); x += __shfl_xor(x, 4); x += __shfl_xor(x, 2); x += __shfl_xor(x, 1);
    return x;
}
__device__ __forceinline__ f16x4 cvt4(f32x4 v) { return __builtin_convertvector(v, f16x4); }
__device__ __forceinline__ f32x4 cvt4f(f16x4 v) { return __builtin_convertvector(v, f32x4); }

#define BSYNC() do { asm volatile("s_waitcnt lgkmcnt(0)" ::: "memory"); __syncthreads(); } while (0)

#define XB_TMO      128
#define XB_XCNT(j)  (256  + 64 * (j))
#define XB_XSUB(j)  (1280 + 64 * (j))
#define XB_XGEN(j)  (2304 + 64 * (j))
#define XB_TOP      3328
#define XB_TOPGEN   3392
#define XCD_BAR_WORDS 3456
#define XB_SPIN_CAP (1u << 22)
__device__ __forceinline__ unsigned xb_ld(unsigned* p) { return __hip_atomic_load(p, __ATOMIC_RELAXED, __HIP_MEMORY_SCOPE_AGENT); }
__device__ __forceinline__ unsigned xb_add(unsigned* p, unsigned v) { return __hip_atomic_fetch_add(p, v, __ATOMIC_RELAXED, __HIP_MEMORY_SCOPE_AGENT); }
__device__ __forceinline__ unsigned xb_xcc_id() { return (unsigned)__builtin_amdgcn_s_getreg((3 << 11) | 20) & 0xFu; }
#define XB_SPIN(cond, bar) do { unsigned _sp = 0; while (cond) { __builtin_amdgcn_s_sleep(1); \
    if ((++_sp & 255u) == 0u) { if (xb_ld(&(bar)[XB_TMO])) break; if (_sp > XB_SPIN_CAP) { atomicAdd(&(bar)[XB_TMO], 1u); break; } } } } while (0)
struct XcdBarrier { unsigned* bar; unsigned x; volatile LAS unsigned* st; };
__device__ __forceinline__ XcdBarrier xcd_barrier_post(unsigned* bar, volatile LAS unsigned* st) {
    XcdBarrier b; b.bar = bar; b.x = xb_xcc_id(); b.st = st;
    if (threadIdx.x == 0) (void)xb_add(&bar[XB_XCNT(b.x)], 1u);
    return b;
}
__device__ __forceinline__ void xcd_barrier_complete(unsigned* bar, unsigned x, unsigned& nloc, unsigned& nx) {
    const unsigned G = gridDim.x;
    unsigned sum, cnt, mine, sp = 0u;
    for (;;) {
        sum = 0u; cnt = 0u; mine = 0u;
#pragma unroll
        for (unsigned j = 0; j < 16; ++j) { const unsigned c = xb_ld(&bar[XB_XCNT(j)]); sum += c; cnt += (c > 0u) ? 1u : 0u; mine = (j == x) ? c : mine; }
        if (sum == G) break;
        __builtin_amdgcn_s_sleep(1);
        if ((++sp & 255u) == 0u) { if (xb_ld(&bar[XB_TMO])) break; if (sp > XB_SPIN_CAP) { atomicAdd(&bar[XB_TMO], 1u); break; } }
    }
    nloc = mine > 0u ? mine : 1u; nx = cnt > 0u ? cnt : 1u;
}
__device__ __forceinline__ void xcd_barrier(const XcdBarrier& b) {
    asm volatile("s_waitcnt vmcnt(0)" ::: "memory");
    __syncthreads();
    if (threadIdx.x == 0) {
        unsigned* bar = b.bar;
        __builtin_amdgcn_s_waitcnt(0);
        unsigned nloc = b.st[0], nx = b.st[1];
        if (nloc == 0u) { xcd_barrier_complete(bar, b.x, nloc, nx); b.st[0] = nloc; b.st[1] = nx; }
        const unsigned old = xb_add(&bar[XB_XSUB(b.x)], 1u);
        const unsigned gen = old / nloc;
        if (old + 1u == (gen + 1u) * nloc) {
            __builtin_amdgcn_fence(__ATOMIC_RELEASE, "agent");
            asm volatile("s_waitcnt vmcnt(0)" ::: "memory");
            const unsigned og = xb_add(&bar[XB_TOP], 1u);
            const unsigned tg = og / nx;
            if (og + 1u == (tg + 1u) * nx) xb_add(&bar[XB_TOPGEN], 1u);
            else XB_SPIN(xb_ld(&bar[XB_TOPGEN]) == tg, bar);
            __builtin_amdgcn_fence(__ATOMIC_ACQUIRE, "agent");
            xb_add(&bar[XB_XGEN(b.x)], 1u);
            asm volatile("s_waitcnt vmcnt(0)" ::: "memory");
        } else {
            XB_SPIN(xb_ld(&bar[XB_XGEN(b.x)]) == gen, bar);
            __builtin_amdgcn_fence(__ATOMIC_ACQUIRE, "agent");
            asm volatile("s_waitcnt vmcnt(0)" ::: "memory");
        }
    }
    __syncthreads();
}

struct NoSeg { __device__ __forceinline__ void operator()(int, f32x4 (&)[4][4]) const {} };
template <bool TRANS, class XR, class WR, class SEG = NoSeg>
__device__ __forceinline__ void gemm_core(f32x4 (&acc)[4][4], XR xrow, WR wrow, const int nk, char* smem, SEG seg = SEG()) {
    const int tid = TID, lane = tid & 63, wid = tid >> 6, wr = wid >> 1, wc = wid & 1, fr = lane & 15, fq = lane >> 4;
#pragma unroll
    for (int m = 0; m < 4; ++m)
#pragma unroll
        for (int n = 0; n < 4; ++n) acc[m][n] = (f32x4){0.f, 0.f, 0.f, 0.f};
#if FAST_GEMM
    const int sc = ((tid & 7) ^ ((tid >> 4) & 7)) * 8;
    const f16* px[4]; const f16* pw[4];
#pragma unroll
    for (int i = 0; i < 4; ++i) { px[i] = xrow((tid >> 3) + 32 * i) + sc; pw[i] = wrow((tid >> 3) + 32 * i) + sc; }
    const int rd0 = ((0 * 4 + fq) ^ (fr >> 1)) * 16, rd1 = ((1 * 4 + fq) ^ (fr >> 1)) * 16;
    const int xoff = (wr * 64 + fr) * 128, woff = 16384 + (wc * 64 + fr) * 128;
    BSYNC();
    auto stage = [&](int kt, int s) {
        char* base = smem + s * 32768 + tid * 16;
#pragma unroll
        for (int i = 0; i < 4; ++i) {
            __builtin_amdgcn_global_load_lds((const void*)(px[i] + kt * 64), (LAS void*)(base + i * 4096), 16, 0, 0);
            __builtin_amdgcn_global_load_lds((const void*)(pw[i] + kt * 64), (LAS void*)(base + 16384 + i * 4096), 16, 0, 0);
        }
    };
    stage(0, 0);
    for (int kt = 0; kt < nk; ++kt) {
        const int s = kt & 1;
        asm volatile("s_waitcnt vmcnt(0)" ::: "memory");
        BSYNC();
        if (kt + 1 < nk) stage(kt + 1, s ^ 1);
        seg(kt, acc);
        const char* bs = smem + s * 32768;
#pragma unroll
        for (int kk = 0; kk < 2; ++kk) {
            const int rd = kk ? rd1 : rd0;
            f16x8 xf[4], wf[4];
#pragma unroll
            for (int m = 0; m < 4; ++m) xf[m] = *(const f16x8*)(bs + xoff + m * 2048 + rd);
#pragma unroll
            for (int n = 0; n < 4; ++n) wf[n] = *(const f16x8*)(bs + woff + n * 2048 + rd);
#pragma unroll
            for (int m = 0; m < 4; ++m)
#pragma unroll
                for (int n = 0; n < 4; ++n)
                    acc[m][n] = TRANS ? __builtin_amdgcn_mfma_f32_16x16x32_f16(wf[n], xf[m], acc[m][n], 0, 0, 0)
                                      : __builtin_amdgcn_mfma_f32_16x16x32_f16(xf[m], wf[n], acc[m][n], 0, 0, 0);
        }
    }
#else
    float* ctile = (float*)smem;
    BSYNC();
    for (int i = 0; i < 64; ++i) {
        const int idx = tid + 256 * i, r = idx >> 7, c = idx & 127;
        const f16* xp = xrow(r); const f16* wp = wrow(c);
        float s = 0.f;
        for (int k = 0; k < nk * 64; k += 8) {
            const f16x8 a = *(const f16x8*)(xp + k), b = *(const f16x8*)(wp + k);
#pragma unroll
            for (int e = 0; e < 8; ++e) s += (float)a[e] * (float)b[e];
        }
        ctile[idx] = s;
    }
    BSYNC();
#pragma unroll
    for (int m = 0; m < 4; ++m)
#pragma unroll
        for (int n = 0; n < 4; ++n)
#pragma unroll
            for (int j = 0; j < 4; ++j)
                acc[m][n][j] = TRANS ? ctile[(wr * 64 + m * 16 + fr) * 128 + wc * 64 + n * 16 + 4 * fq + j] : ctile[(wr * 64 + m * 16 + 4 * fq + j) * 128 + wc * 64 + n * 16 + fr];
    BSYNC();
#endif
}

template <class TR> __device__ __forceinline__ void row_stats_table(const float* pst, TR tokrow, float* srow) {
    const int tid = TID;
    float su = 0.f, sq = 0.f;
    if (tid < 128) {
        const float* ps = pst + (size_t)tokrow(tid) * 32;
#pragma unroll
        for (int i = 0; i < 8; ++i) { const f32x4 v = *(const f32x4*)(ps + i * 4); su += v[0] + v[2]; sq += v[1] + v[3]; }
    }
    BSYNC();
    if (tid < 128) {
        const float mean = su * (1.0f / 1024.0f), var = fmaxf(sq * (1.0f / 1024.0f) - mean * mean, 0.f);
        srow[tid * 2] = mean; srow[tid * 2 + 1] = rsqrtf(var + 1e-5f);
    }
}

struct GPipe { int staged, b0; };
template <bool TRANS, class XP, class WP, class SEG = NoSeg>
__device__ __forceinline__ void gemm_core_pf(f32x4 (&acc)[4][4], XP xp, WP wp, int rt, int ct, const int nk, bool has_next, int nrt, int nct, GPipe& gp,
                                             char* smem, SEG seg = SEG()) {
    const int tid = TID, lane = tid & 63, wid = tid >> 6, wr = wid >> 1, wc = wid & 1, fr = lane & 15, fq = lane >> 4;
#pragma unroll
    for (int m = 0; m < 4; ++m)
#pragma unroll
        for (int n = 0; n < 4; ++n) acc[m][n] = (f32x4){0.f, 0.f, 0.f, 0.f};
    const int sc = ((tid & 7) ^ ((tid >> 4) & 7)) * 8;
    const f16* px[4]; const f16* pw[4];
#pragma unroll
    for (int i = 0; i < 4; ++i) { px[i] = xp(rt, ct, (tid >> 3) + 32 * i) + sc; pw[i] = wp(rt, ct, (tid >> 3) + 32 * i) + sc; }
    const int rd0 = ((0 * 4 + fq) ^ (fr >> 1)) * 16, rd1 = ((1 * 4 + fq) ^ (fr >> 1)) * 16;
    const int xoff = (wr * 64 + fr) * 128, woff = 16384 + (wc * 64 + fr) * 128;
    auto stage = [&](int kt, int s) {
        char* base = smem + s * 32768 + tid * 16;
#pragma unroll
        for (int i = 0; i < 4; ++i) {
            __builtin_amdgcn_global_load_lds((const void*)(px[i] + kt * 64), (LAS void*)(base + i * 4096), 16, 0, 0);
            __builtin_amdgcn_global_load_lds((const void*)(pw[i] + kt * 64), (LAS void*)(base + 16384 + i * 4096), 16, 0, 0);
        }
    };
    if (!gp.staged) { BSYNC(); gp.b0 = 0; stage(0, 0); }
    const int b0 = gp.b0;
    for (int kt = 0; kt < nk; ++kt) {
        const int s = (kt + b0) & 1;
        asm volatile("s_waitcnt vmcnt(0)" ::: "memory");
        BSYNC();
        if (kt + 1 < nk) stage(kt + 1, s ^ 1);
        else if (has_next) {
            char* base = smem + (s ^ 1) * 32768 + tid * 16;
#pragma unroll
            for (int i = 0; i < 4; ++i) {
                __builtin_amdgcn_global_load_lds((const void*)(xp(nrt, nct, (tid >> 3) + 32 * i) + sc), (LAS void*)(base + i * 4096), 16, 0, 0);
                __builtin_amdgcn_global_load_lds((const void*)(wp(nrt, nct, (tid >> 3) + 32 * i) + sc), (LAS void*)(base + 16384 + i * 4096), 16, 0, 0);
            }
        }
        seg(kt, acc);
        const char* bs = smem + s * 32768;
#pragma unroll
        for (int kk = 0; kk < 2; ++kk) {
            const int rd = kk ? rd1 : rd0;
            f16x8 xf[4], wf[4];
#pragma unroll
            for (int m = 0; m < 4; ++m) xf[m] = *(const f16x8*)(bs + xoff + m * 2048 + rd);
#pragma unroll
            for (int n = 0; n < 4; ++n) wf[n] = *(const f16x8*)(bs + woff + n * 2048 + rd);
#pragma unroll
            for (int m = 0; m < 4; ++m)
#pragma unroll
                for (int n = 0; n < 4; ++n)
                    acc[m][n] = TRANS ? __builtin_amdgcn_mfma_f32_16x16x32_f16(wf[n], xf[m], acc[m][n], 0, 0, 0)
                                      : __builtin_amdgcn_mfma_f32_16x16x32_f16(xf[m], wf[n], acc[m][n], 0, 0, 0);
        }
    }
    gp.staged = has_next ? 1 : 0; gp.b0 = ((nk - 1 + b0) & 1) ^ 1;
}

template <class F> __device__ __forceinline__ void tile_loop2(int nrt, int nct, F f) {
    const int xcd = BID & 7, lb = BID >> 3, nlb = NBLK >> 3;
    const int per = (nrt >> 3) * nct;
    for (int j = lb; j < per; j += nlb) {
        const int jn = j + nlb; const bool hn = jn < per; const int je = hn ? jn : j;
        f(((j / nct) << 3) + xcd, j % nct, hn, ((je / nct) << 3) + xcd, je % nct);
    }
}

template <class F> __device__ __forceinline__ void tile_loop(int nrt, int nct, F f) {
    const int xcd = BID & 7, lb = BID >> 3, nlb = NBLK >> 3;
    const int per = (nrt >> 3) * nct;
    for (int j = lb; j < per; j += nlb) f(((j / nct) << 3) + xcd, j % nct);
}

#define WAVE_IDS const int tid = TID, lane = tid & 63, wid = tid >> 6, wr = wid >> 1, wc = wid & 1, fr = lane & 15, fq = lane >> 4; (void)lane; (void)wid; (void)wr; (void)wc; (void)fr; (void)fq;

template <class RowMap, class KScale>
__device__ __forceinline__ void conv_T(const float* src, f16* dst, int nbatch, int K, int N, size_t src_bs, size_t dst_bs, int ldd, RowMap rowmap, KScale kscale, int& off, float* tile, int myid, int G) {
    const int tk = K / 64, tn = (N + 63) / 64, total = nbatch * tk * tn, t = TID;
    int start = (myid - off) % G; if (start < 0) start += G;
    auto load = [&](int i, f32x4 (&v)[4]) {
        const int bi = i / (tk * tn), r = i % (tk * tn), k0 = (r / tn) * 64, n0 = (r % tn) * 64;
#pragma unroll
        for (int j = 0; j < 4; ++j) {
            const int k = (t >> 4) + 16 * j, c = (t & 15) * 4;
            v[j] = (f32x4){0.f, 0.f, 0.f, 0.f};
            if (i < total && n0 + c < N) v[j] = *(const f32x4*)(src + (size_t)bi * src_bs + (size_t)(k0 + k) * N + n0 + c);
        }
    };
    f32x4 va[4], vb[4];
    load(start, va); load(start + G, vb);
    for (int i = start; i < total; i += G) {
        const int bi = i / (tk * tn), r = i % (tk * tn), k0 = (r / tn) * 64, n0 = (r % tn) * 64;
        BSYNC();
#pragma unroll
        for (int j = 0; j < 4; ++j) {
            const int k = (t >> 4) + 16 * j, c = (t & 15) * 4;
            const float s = kscale(k0 + k);
            tile[k * 65 + c + 0] = va[j][0] * s; tile[k * 65 + c + 1] = va[j][1] * s; tile[k * 65 + c + 2] = va[j][2] * s; tile[k * 65 + c + 3] = va[j][3] * s;
        }
#pragma unroll
        for (int j = 0; j < 4; ++j) va[j] = vb[j];
        load(i + 2 * G, vb);
        BSYNC();
        const int n = t >> 2, kc = (t & 3) * 16;
        if (n0 + n < N) {
            f16x8 o0, o1;
#pragma unroll
            for (int j = 0; j < 8; ++j) { o0[j] = (f16)tile[(kc + j) * 65 + n]; o1[j] = (f16)tile[(kc + 8 + j) * 65 + n]; }
            f16* dp = dst + (size_t)bi * dst_bs + (size_t)rowmap(n0 + n) * ldd + k0 + kc;
            *(f16x8*)dp = o0; *(f16x8*)(dp + 8) = o1;
        }
    }
    off = (off + total) % G;
}

__device__ __forceinline__ void phase_convert(const Params& p, char* smem) {
    char* ws = WS;
    float* tile = (float*)smem;
    const int gtid = BID * 256 + TID, gsz = NBLK * 256;
    int off = 0;
    const int cb = BID, cn = NBLK;
    auto ident = [](int n) { return n; };
    auto one = [](int) { return 1.0f; };
    {
        const float* x = IN(0); f16* h16 = (f16*)(ws + OFF_H16);
        for (size_t i = gtid; i < (size_t)T * D / 4; i += gsz) *(f16x4*)(h16 + i * 4) = cvt4(*(const f32x4*)(x + i * 4));
        const float* mem = IN(1); f16* m16 = (f16*)(ws + OFF_MEM16);
        for (size_t i = gtid; i < (size_t)1024 * 1024 / 4; i += gsz) *(f16x4*)(m16 + i * 4) = cvt4(*(const f32x4*)(mem + i * 4));
    }
    {
        const float* w = IN(16); f16* o = (f16*)(ws + W_SGW);
        for (int i = gtid; i < 2 * 4 * 128 * 128; i += gsz) { const int s = i & 127, tt = (i >> 7) & 127; o[i] = (s <= tt) ? (f16)w[i] : (f16)0.f; }
    }
    {
        f32x2* rt = (f32x2*)(ws + OFF_ROPE);
        for (int i = gtid; i < SEQ * 16; i += gsz) {
            const int pos = i >> 4, fi = i & 15;
            const double inv = exp2(-(double)fi * (13.287712379549449 / 16.0));
            double rev = (double)pos * inv * 0.15915494309189535;
            rev -= floor(rev);
            const float fr_ = (float)rev;
            rt[i] = (f32x2){__builtin_amdgcn_cosf(fr_), __builtin_amdgcn_sinf(fr_)};
        }
    }
    {
        unsigned* cnt = (unsigned*)(ws + OFF_CNT);
        if (gtid < 128) cnt[gtid] = 0u;
        f16* wr_ = (f16*)(ws + W_ROUTER);
        for (int i = gtid; i < 4 * 92 * 1024; i += gsz) { const int l = i / (92 * 1024), r = i % (92 * 1024); wr_[(size_t)l * 128 * 1024 + 36 * 1024 + r] = (f16)0.f; }
        f16* wm = (f16*)(ws + W_MLAIN);
        for (int i = gtid; i < 2 * 96 * 1024; i += gsz) { const int l = i / (96 * 1024), r = i % (96 * 1024); wm[(size_t)l * 640 * 1024 + 544 * 1024 + r] = (f16)0.f; }
    }
    conv_T(IN(2), (f16*)(ws + W_ABIN), 2, 1024, 2816, (size_t)1024 * 2816, (size_t)2816 * 1024, 1024, ident, one, off, tile, cb, cn);
    conv_T(IN(5), (f16*)(ws + W_W2T), 2, 64, 512, (size_t)64 * 512, (size_t)512 * 64, 64, ident, one, off, tile, cb, cn);
    conv_T(IN(7), (f16*)(ws + W_A2T), 2, 64, 512, (size_t)64 * 512, (size_t)512 * 64, 64, ident, one, off, tile, cb, cn);
    conv_T(IN(8), (f16*)(ws + W_G2T), 2, 128, 512, (size_t)128 * 512, (size_t)512 * 128, 128, ident, one, off, tile, cb, cn);
    conv_T(IN(18), (f16*)(ws + W_ABOUT), 2, 1024, 1024, (size_t)1024 * 1024, (size_t)1024 * 1024, 1024, ident, one, off, tile, cb, cn);
    conv_T(IN(19), (f16*)(ws + W_MLAIN), 2, 1024, 544, (size_t)1024 * 544, (size_t)640 * 1024, 1024, ident, one, off, tile, cb, cn);
    for (int l = 0; l < 2; ++l) {
        const float* qn = IN(20) + l * 256; const float* kvn = IN(21) + l * 256;
        const float qs = 0.10206207261596577f * LOG2E;
        conv_T(IN(22) + (size_t)l * 256 * 1536, (f16*)(ws + W_Q) + (size_t)l * 1536 * 256, 1, 256, 1536, 0, 0, 256, ident, [=](int k) { return qn[k] * qs; }, off, tile, cb, cn);
        conv_T(IN(23) + (size_t)l * 256 * 2048, (f16*)(ws + W_KV) + (size_t)l * 2048 * 256, 1, 256, 2048, 0, 0, 256,
               [](int n) { const int h = n >> 7, j = n & 127; return j < 64 ? h * 64 + j : 1024 + h * 64 + (j - 64); }, [=](int k) { return kvn[k]; }, off, tile, cb, cn);
    }
    conv_T(IN(24), (f16*)(ws + W_MLAOUT), 2, 1024, 1024, (size_t)1024 * 1024, (size_t)1024 * 1024, 1024, ident, one, off, tile, cb, cn);
    {
        const float* w = IN(27); f16* o = (f16*)(ws + W_XAQ); const float sc = 0.0625f * LOG2E;
        for (size_t i = gtid; i < (size_t)4 * 1024 * 1024 / 4; i += gsz) *(f16x4*)(o + i * 4) = cvt4(*(const f32x4*)(w + i * 4) * sc);
    }
    conv_T(IN(28), (f16*)(ws + W_XAKV), 4, 1024, 2048, (size_t)1024 * 2048, (size_t)2048 * 1024, 1024, ident, one, off, tile, cb, cn);
    conv_T(IN(29), (f16*)(ws + W_XAO), 4, 1024, 1024, (size_t)1024 * 1024, (size_t)1024 * 1024, 1024, ident, one, off, tile, cb, cn);
    conv_T(IN(32), (f16*)(ws + W_ROUTER), 4, 1024, 4, (size_t)1024 * 4, (size_t)128 * 1024, 1024, ident, one, off, tile, cb, cn);
    conv_T(IN(34), (f16*)(ws + W_ROUTER), 4, 1024, 32, (size_t)1024 * 32, (size_t)128 * 1024, 1024, [](int n) { return n + 4; }, one, off, tile, cb, cn);
}

__device__ __forceinline__ void convert_moe(const Params& p, char* smem, int cb, int cn) {
    char* ws = WS;
    float* tile = (float*)smem;
    int off = 0;
    auto ident = [](int n) { return n; };
    auto one = [](int) { return 1.0f; };
    conv_T(IN(36), (f16*)(ws + W_GU), 128, 1024, 512, (size_t)1024 * 512, (size_t)1024 * 1024, 1024,
           [](int n) { return (n >> 6) * 128 + ((n >> 5) & 1) * 64 + (n & 31); }, one, off, tile, cb, cn);
    conv_T(IN(37), (f16*)(ws + W_GU), 128, 1024, 512, (size_t)1024 * 512, (size_t)1024 * 1024, 1024,
           [](int n) { return (n >> 6) * 128 + ((n >> 5) & 1) * 64 + 32 + (n & 31); }, one, off, tile, cb, cn);
    conv_T(IN(38), (f16*)(ws + W_D), 128, 512, 1024, (size_t)512 * 1024, (size_t)1024 * 512, 512, ident, one, off, tile, cb, cn);
}

template <int MODE>
__device__ __forceinline__ void phase_ln(const f16* src, const f16* ff0, const f16* ff1, const float* gp, const float* bp, const float* g, const float* b,
                                         float* dst32, f16* dst16, float* stat) {
    const int lane = TID & 63, gw = BID * 4 + (TID >> 6), nw = NBLK * 4;
    for (int row = gw; row < T; row += nw) {
        f32x4 v[4]; float s = 0.f;
#pragma unroll
        for (int i = 0; i < 4; ++i) {
            v[i] = cvt4f(*(const f16x4*)(src + (size_t)row * D + i * 256 + lane * 4));
            s += (v[i][0] + v[i][1]) + (v[i][2] + v[i][3]);
        }
        float mean = wave_sum(s) * (1.0f / 1024.0f);
        float q = 0.f;
#pragma unroll
        for (int i = 0; i < 4; ++i) { const f32x4 d = v[i] - mean; q += (d[0] * d[0] + d[1] * d[1]) + (d[2] * d[2] + d[3] * d[3]); }
        float rstd = rsqrtf(wave_sum(q) * (1.0f / 1024.0f) + 1e-5f);
        if (MODE == 1) {
            s = 0.f;
#pragma unroll
            for (int i = 0; i < 4; ++i) {
                const int c = i * 256 + lane * 4; const size_t o = (size_t)row * D + c;
                const f32x4 h2 = (v[i] - mean) * rstd * *(const f32x4*)(gp + c) + *(const f32x4*)(bp + c);
                v[i] = h2 * DN_ALPHA + cvt4f(*(const f16x4*)(ff0 + o)) + cvt4f(*(const f16x4*)(ff1 + o));
                s += (v[i][0] + v[i][1]) + (v[i][2] + v[i][3]);
            }
            mean = wave_sum(s) * (1.0f / 1024.0f);
            q = 0.f;
#pragma unroll
            for (int i = 0; i < 4; ++i) { const f32x4 d = v[i] - mean; q += (d[0] * d[0] + d[1] * d[1]) + (d[2] * d[2] + d[3] * d[3]); }
            rstd = rsqrtf(wave_sum(q) * (1.0f / 1024.0f) + 1e-5f);
        }
        if (MODE == 0 && lane == 0) *(f32x2*)(stat + (size_t)row * 2) = (f32x2){mean, rstd};
#pragma unroll
        for (int i = 0; i < 4; ++i) {
            const int c = i * 256 + lane * 4; const size_t o = (size_t)row * D + c;
            const f32x4 y = (v[i] - mean) * rstd * *(const f32x4*)(g + c) + *(const f32x4*)(b + c);
            if (MODE == 1 && dst32) *(f32x4*)(dst32 + o) = y;
            if (dst16) *(f16x4*)(dst16 + o) = cvt4(y);
        }
    }
}

__device__ __forceinline__ void phase_gemm_res(const f16* X, const f16* Wt, const float* res32, const f16* res16, f16* y16, float* pst, char* smem) {
    WAVE_IDS
    GPipe gp{0, 0};
    tile_loop2(128, 8, [&](int rt, int ct, bool hn, int nrt, int nct) {
        float su[4] = {0.f, 0.f, 0.f, 0.f}, sq[4] = {0.f, 0.f, 0.f, 0.f};
        f32x4 acc[4][4];
        gemm_core_pf<true>(acc, [&](int a, int, int r) { return X + (size_t)(a * 128 + r) * 1024; }, [&](int, int c, int r) { return Wt + (size_t)(c * 128 + r) * 1024; },
                           rt, ct, 16, hn, nrt, nct, gp, smem);
#pragma unroll
        for (int m = 0; m < 4; ++m)
#pragma unroll
            for (int n = 0; n < 4; ++n) {
                const size_t o = (size_t)(rt * 128 + wr * 64 + m * 16 + fr) * 1024 + ct * 128 + wc * 64 + n * 16 + 4 * fq;
                const f32x4 r4 = res32 ? *(const f32x4*)(res32 + o) : cvt4f(*(const f16x4*)(res16 + o));
                const f16x4 y4 = cvt4(r4 * DN_ALPHA + acc[m][n]);
                *(f16x4*)(y16 + o) = y4;
                const f32x4 yr = cvt4f(y4);
                su[m] += (yr[0] + yr[1]) + (yr[2] + yr[3]); sq[m] += (yr[0] * yr[0] + yr[1] * yr[1]) + (yr[2] * yr[2] + yr[3] * yr[3]);
            }
#pragma unroll
        for (int m = 0; m < 4; ++m) {
            float a = su[m], q = sq[m];
            a += __shfl_xor(a, 16); a += __shfl_xor(a, 32); q += __shfl_xor(q, 16); q += __shfl_xor(q, 32);
            if (fq == 0) *(f32x2*)(pst + ((size_t)(rt * 128 + wr * 64 + m * 16 + fr) * 16 + ct * 2 + wc) * 2) = (f32x2){a, q};
        }
    });
}

__device__ __forceinline__ void phase_xa_out(const Params& p, int L, f16* y16, char* smem) {
    WAVE_IDS
    const f16* XP = (const f16*)(WS + S_XP16); const float* LP = (const float*)(WS + S_XLP); const float* PST = (const float*)(WS + S_PST1);
    const float* g1 = IN(25) + L * 1024; const float* b1 = IN(26) + L * 1024;
    float* srow = (float*)(smem + SMEM_MAIN + 1024);
    GPipe gp{0, 0};
    const f16* XNb = (const f16*)(WS + OFF_XN) + (size_t)(L * 4) * 1024 * 1024;
    tile_loop2(128, 8, [&](int rt, int ct, bool hn, int nrt, int nct) {
        row_stats_table(PST, [&](int r) { return rt * 128 + r; }, srow);
        float ratio[4][4];
#pragma unroll
        for (int m = 0; m < 4; ++m) {
            const float* lp = LP + (size_t)(rt * 128 + wr * 64 + m * 16 + fr) * 16;
            float l[4];
#pragma unroll
            for (int h = 0; h < 4; ++h) { const f32x4 v = *(const f32x4*)(lp + 4 * h); l[h] = (v[0] + v[1]) + (v[2] + v[3]); }
            ratio[m][0] = l[1] / l[0]; ratio[m][1] = l[2] / l[1]; ratio[m][2] = l[3] / l[2]; ratio[m][3] = 1.0f / l[3];
        }
        f32x4 acc[4][4];
        gemm_core_pf<true>(acc, [&](int a, int, int r) { return XP + (size_t)(a * 128 + r) * 1024; },
            [&](int a, int c, int r) { return XNb + (size_t)(a >> 5) * 1024 * 1024 + (size_t)(c * 128 + r) * 1024; }, rt, ct, 16, hn, nrt, nct, gp, smem,
            [&](int kt, f32x4 (&a)[4][4]) {
                if (kt == 4 || kt == 8 || kt == 12) {
#pragma unroll
                    for (int m = 0; m < 4; ++m) {
                        const float sc = kt == 4 ? ratio[m][0] : (kt == 8 ? ratio[m][1] : ratio[m][2]);
#pragma unroll
                        for (int n = 0; n < 4; ++n) a[m][n] = a[m][n] * sc;
                    }
                }
            });
        f32x4 gv[4], bv[4];
#pragma unroll
        for (int n = 0; n < 4; ++n) { const int c = ct * 128 + wc * 64 + n * 16 + 4 * fq; gv[n] = *(const f32x4*)(g1 + c); bv[n] = *(const f32x4*)(b1 + c); }
#pragma unroll
        for (int m = 0; m < 4; ++m) {
            const int row = rt * 128 + wr * 64 + m * 16 + fr;
            const f32x2 st = *(const f32x2*)(srow + (wr * 64 + m * 16 + fr) * 2);
#pragma unroll
            for (int n = 0; n < 4; ++n) {
                const size_t o = (size_t)row * 1024 + ct * 128 + wc * 64 + n * 16 + 4 * fq;
                const f32x4 hres = (cvt4f(*(const f16x4*)(y16 + o)) - st[0]) * st[1] * gv[n] + bv[n];
                *(f16x4*)(y16 + o) = cvt4(hres * DN_ALPHA + acc[m][n] * ratio[m][3]);
            }
        }
    });
}

__device__ __forceinline__ void phase_memkv(const Params& p, char* smem) {
    WAVE_IDS
    const f16* mem16 = (const f16*)(WS + OFF_MEM16);
    for (int item = BID; item < 4 * 8 * 16; item += NBLK) {
        const int L = item >> 7, rt = (item >> 4) & 7, ct = item & 15;
        const f16* Wt = (const f16*)(WS + W_XAKV) + (size_t)L * 2048 * 1024;
        f16* kv = (f16*)(WS + OFF_KVMEM) + (size_t)L * 1024 * 2048;
        f32x4 acc[4][4];
        gemm_core<true>(acc, [&](int r) { return mem16 + (size_t)(rt * 128 + r) * 1024; }, [&](int r) { return Wt + (size_t)(ct * 128 + r) * 1024; }, 16, smem);
#pragma unroll
        for (int m = 0; m < 4; ++m)
#pragma unroll
            for (int n = 0; n < 4; ++n)
                *(f16x4*)(kv + (size_t)(rt * 128 + wr * 64 + m * 16 + fr) * 2048 + ct * 128 + wc * 64 + n * 16 + 4 * fq) = cvt4(acc[m][n]);
    }
}

__device__ __forceinline__ void xa_pre_item(const Params& p, int item, char* smem) {
    WAVE_IDS
    const int ct = item & 7, rt = (item >> 3) & 7, which = (item >> 6) & 1, b = (item >> 7) & 3, L = item >> 9;
    const f16* kv = (const f16*)(WS + OFF_KVMEM) + (size_t)L * 1024 * 2048;
    f32x4 acc[4][4];
    f16* out;
    if (which == 0) {
        const int hd = rt >> 1, key0 = (rt & 1) * 128;
        const f16* wq = (const f16*)(WS + W_XAQ) + (size_t)L * 1024 * 1024;
        gemm_core<true>(acc, [&](int r) { return kv + (size_t)(b * 256 + key0 + r) * 2048 + hd * 256; }, [&](int r) { return wq + (size_t)(ct * 128 + r) * 1024 + hd * 256; }, 4, smem);
        out = (f16*)(WS + OFF_XM) + (size_t)(L * 4 + b) * 1024 * 1024;
    } else {
        const int hd = ct >> 1, key0 = (ct & 1) * 128;
        const f16* wo = (const f16*)(WS + W_XAO) + (size_t)L * 1024 * 1024;
        gemm_core<true>(acc, [&](int r) { return wo + (size_t)(rt * 128 + r) * 1024 + hd * 256; }, [&](int r) { return kv + (size_t)(b * 256 + key0 + r) * 2048 + 1024 + hd * 256; }, 4, smem);
        out = (f16*)(WS + OFF_XN) + (size_t)(L * 4 + b) * 1024 * 1024;
    }
    if (which == 0) {
        const float* g1 = IN(25) + L * 1024; const float* b1 = IN(26) + L * 1024;
        float* up = (float*)(WS + OFF_XUP) + (size_t)(L * 4 + b) * 1024 * 16; float* cp = (float*)(WS + OFF_XCP) + (size_t)(L * 4 + b) * 1024 * 16;
#pragma unroll
        for (int m = 0; m < 4; ++m) {
            const int row = rt * 128 + wr * 64 + m * 16 + fr;
            float us = 0.f, cs = 0.f;
#pragma unroll
            for (int n = 0; n < 4; ++n) {
                const int k = ct * 128 + wc * 64 + n * 16 + 4 * fq;
                const f16x4 xm = cvt4(acc[m][n] * *(const f32x4*)(g1 + k));
                *(f16x4*)(out + (size_t)row * 1024 + k) = xm;
                const f32x4 xr = cvt4f(xm), cb = acc[m][n] * *(const f32x4*)(b1 + k);
                us += (xr[0] + xr[1]) + (xr[2] + xr[3]); cs += (cb[0] + cb[1]) + (cb[2] + cb[3]);
            }
            us += __shfl_xor(us, 16); us += __shfl_xor(us, 32); cs += __shfl_xor(cs, 16); cs += __shfl_xor(cs, 32);
            if (fq == 0) { up[(size_t)row * 16 + ct * 2 + wc] = us; cp[(size_t)row * 16 + ct * 2 + wc] = cs; }
        }
        return;
    }
#pragma unroll
    for (int m = 0; m < 4; ++m)
#pragma unroll
        for (int n = 0; n < 4; ++n)
            *(f16x4*)(out + (size_t)(rt * 128 + wr * 64 + m * 16 + fr) * 1024 + ct * 128 + wc * 64 + n * 16 + 4 * fq) = cvt4(acc[m][n]);
}

__device__ __forceinline__ void xa_uc_reduce(const Params& p) {
    const float* up = (const float*)(WS + OFF_XUP); const float* cp = (const float*)(WS + OFF_XCP);
    float* xu = (float*)(WS + OFF_XU); float* xc = (float*)(WS + OFF_XC);
    for (int i = BID * 256 + TID; i < 16 * 1024; i += NBLK * 256) {
        float a = 0.f, c = 0.f;
#pragma unroll
        for (int q4 = 0; q4 < 4; ++q4) { const f32x4 v = *(const f32x4*)(up + (size_t)i * 16 + q4 * 4), w = *(const f32x4*)(cp + (size_t)i * 16 + q4 * 4); a += (v[0] + v[1]) + (v[2] + v[3]); c += (w[0] + w[1]) + (w[2] + w[3]); }
        xu[i] = a; xc[i] = c;
    }
}

__device__ __forceinline__ void phase_ab_in(const Params& p, int j, char* smem) {
    WAVE_IDS
    const f16* X = (const f16*)(WS + OFF_H16);
    const f16* Wt = (const f16*)(WS + W_ABIN) + (size_t)j * 2816 * 1024;
    f16* P = (f16*)(WS + S_P16);
    GPipe gp{0, 0};
    tile_loop2(128, 22, [&](int rt, int ct, bool hn, int nrt, int nct) {
        f32x4 acc[4][4];
        gemm_core_pf<true>(acc, [&](int a, int, int r) { return X + (size_t)(a * 128 + r) * 1024; }, [&](int, int c, int r) { return Wt + (size_t)(c * 128 + r) * 1024; },
                           rt, ct, 16, hn, nrt, nct, gp, smem);
#pragma unroll
        for (int m = 0; m < 4; ++m)
#pragma unroll
            for (int n = 0; n < 4; ++n)
                *(f16x4*)(P + (size_t)(rt * 128 + wr * 64 + m * 16 + fr) * 2816 + ct * 128 + wc * 64 + n * 16 + 4 * fq) = cvt4(acc[m][n]);
    });
}

__device__ __forceinline__ void phase_shift(const Params& p, int j) {
    const f16* P = (const f16*)(WS + S_P16); f16* PS = (f16*)(WS + S_PS16);
    const float* mu = IN(3) + j * 1792;
    const int total = T * 224;
    for (int i = BID * 256 + TID; i < total; i += NBLK * 256) {
        const int t = i / 224, c = (i % 224) * 8;
        const f16x8 cur = *(const f16x8*)(P + (size_t)t * 2816 + c);
        f16x8 prv; for (int e = 0; e < 8; ++e) prv[e] = (f16)0.f;
        if ((t & (SEQ - 1)) != 0) prv = *(const f16x8*)(P + (size_t)(t - 1) * 2816 + c);
        f16x8 o;
        const f32x4 mu0 = *(const f32x4*)(mu + c), mu1 = *(const f32x4*)(mu + c + 4);
#pragma unroll
        for (int e = 0; e < 8; ++e) {
            const float a = (float)cur[e]; float v = a + ((float)prv[e] - a) * (e < 4 ? mu0[e & 3] : mu1[e & 3]);
            if (c >= 1536 && c < 1600) v = tanh_(v);
            else if (c >= 1664) v = sigmoid_(v);
            o[e] = (f16)v;
        }
        *(f16x8*)(PS + (size_t)t * 1792 + c) = o;
    }
}

__device__ __forceinline__ void phase_lora(const Params& p, int j, char* smem) {
    WAVE_IDS
    const f16* PS = (const f16*)(WS + S_PS16);
    float* WD = (float*)(WS + S_WD32); f16* NKK = (f16*)(WS + S_NKK); f16* BB = (f16*)(WS + S_BB); f16* KP = (f16*)(WS + S_KP);
    f16* G16 = (f16*)(WS + S_G16); float* BSUM = (float*)(WS + S_BSUM);
    const float* w0 = IN(4) + j * 512; const float* a0 = IN(6) + j * 512; const float* k_k = IN(9) + j * 512; const float* k_a = IN(10) + j * 512; const float* r_k = IN(11) + j * 512;
    GPipe gp{0, 0};
    const f16* Wl0 = (const f16*)(WS + W_W2T) + (size_t)j * 512 * 64; const f16* Wl1 = (const f16*)(WS + W_A2T) + (size_t)j * 512 * 64;
    const f16* Wl2 = (const f16*)(WS + W_G2T) + (size_t)j * 512 * 128;
    tile_loop2(128, 12, [&](int rt, int ct, bool hn, int nrt, int nct) {
        const int type = ct >> 2, c4 = ct & 3;
        f32x4 acc[4][4];
        gemm_core_pf<true>(acc, [&](int a, int c, int r) { const int ty = c >> 2; return PS + (size_t)(a * 128 + r) * 1792 + (ty == 0 ? 1536 : (ty == 1 ? 1600 : 1664)); },
                           [&](int, int c, int r) { const int ty = c >> 2, cc = c & 3; return ty == 0 ? Wl0 + (size_t)(cc * 128 + r) * 64 : (ty == 1 ? Wl1 + (size_t)(cc * 128 + r) * 64 : Wl2 + (size_t)(cc * 128 + r) * 128); },
                           rt, ct, type == 2 ? 2 : 1, hn, nrt, nct, gp, smem);
        if (type == 0) {
#pragma unroll
            for (int m = 0; m < 4; ++m)
#pragma unroll
                for (int n = 0; n < 4; ++n) {
                    const int row = rt * 128 + wr * 64 + m * 16 + fr, col = c4 * 128 + wc * 64 + n * 16 + 4 * fq;
                    f32x4 o;
#pragma unroll
                    for (int e = 0; e < 4; ++e) {
                        const float z = -(w0[col + e] + acc[m][n][e]);
                        const float sp = fmaxf(z, 0.f) + __logf(1.0f + __expf(-fabsf(z)));
                        o[e] = __expf(-__expf(-sp - 0.5f));
                    }
                    *(f32x4*)(WD + (size_t)row * 512 + col) = o;
                }
        } else if (type == 1) {
            const int head = c4 * 2 + wc;
#pragma unroll
            for (int m = 0; m < 4; ++m) {
                const int row = rt * 128 + wr * 64 + m * 16 + fr;
                f32x4 av[4], kv[4], kr[4];
                float ss = 0.f, bs = 0.f;
#pragma unroll
                for (int n = 0; n < 4; ++n) {
                    const int col = head * 64 + n * 16 + 4 * fq;
                    const f32x4 kk_ = cvt4f(*(const f16x4*)(PS + (size_t)row * 1792 + 512 + col));
                    const f32x4 rr = cvt4f(*(const f16x4*)(PS + (size_t)row * 1792 + col));
#pragma unroll
                    for (int e = 0; e < 4; ++e) {
                        const float a = sigmoid_(a0[col + e] + acc[m][n][e]);
                        const float kraw = kk_[e] * k_k[col + e];
                        const float kp = kk_[e] * (1.0f + (a - 1.0f) * k_a[col + e]);
                        av[n][e] = a; kr[n][e] = kraw; kv[n][e] = kp;
                        ss += kraw * kraw; bs += rr[e] * kp * r_k[col + e];
                    }
                }
                ss += __shfl_xor(ss, 16); ss += __shfl_xor(ss, 32);
                bs += __shfl_xor(bs, 16); bs += __shfl_xor(bs, 32);
                const float inv = 1.0f / fmaxf(sqrtf(ss), 1e-12f);
#pragma unroll
                for (int n = 0; n < 4; ++n) {
                    const int col = head * 64 + n * 16 + 4 * fq;
                    f32x4 nk_, bb_;
#pragma unroll
                    for (int e = 0; e < 4; ++e) { const float kkn = kr[n][e] * inv; nk_[e] = -kkn; bb_[e] = kkn * av[n][e]; }
                    *(f16x4*)(NKK + (size_t)row * 512 + col) = cvt4(nk_);
                    *(f16x4*)(BB + (size_t)row * 512 + col) = cvt4(bb_);
                    *(f16x4*)(KP + (size_t)row * 512 + col) = cvt4(kv[n]);
                }
                if (fq == 0) BSUM[(size_t)row * 8 + head] = bs;
            }
        } else {
#pragma unroll
            for (int m = 0; m < 4; ++m)
#pragma unroll
                for (int n = 0; n < 4; ++n)
                    *(f16x4*)(G16 + (size_t)(rt * 128 + wr * 64 + m * 16 + fr) * 512 + c4 * 128 + wc * 64 + n * 16 + 4 * fq) = cvt4(acc[m][n]);
        }
    });
}

#if FAST_REC
constexpr int NREC = 128;
constexpr int SEG_C0 = 76;
__device__ __forceinline__ void rwkv_rec(const Params& p, int bh, int q, int c0, int nc, int part, bool wr_end, char* smem) {
    const int tid = TID, lane = tid & 63, wid = tid >> 6;
    const int b = bh >> 3, h = bh & 7;
    const int rl = lane >> 4, ks = lane & 15, vrow = wid * 4 + rl;
    const float* WD = (const float*)(WS + S_WD32); const f16* NKK = (const f16*)(WS + S_NKK); const f16* BB = (const f16*)(WS + S_BB);
    const f16* KP = (const f16*)(WS + S_KP); const f16* PS = (const f16*)(WS + S_PS16); float* Y = (float*)(WS + (part == 2 ? S_YT : S_Y32));
    float* sW = (float*)smem; float* sN = sW + 32 * 64; float* sB = sN + 32 * 64; float* sK = sB + 32 * 64; float* sWR = sK + 32 * 64;
    float* sV = sWR + 32 * 64; float* sS = sV + 32 * 16; float* sY = sS + 32 * 2;
    const size_t tb = (size_t)b * SEQ + (size_t)c0 * 32;
    f32x4 pw0, pw1; f16x8 pn, pb, pk, pr, pv;
    const int pst = tid >> 3, pc8 = tid & 7;
    auto prefetch = [&](int c) {
        const size_t t0 = tb + c * 32;
        const size_t o = (t0 + pst) * 512 + h * 64 + pc8 * 8;
        pw0 = *(const f32x4*)(WD + o); pw1 = *(const f32x4*)(WD + o + 4);
        pn = *(const f16x8*)(NKK + o); pb = *(const f16x8*)(BB + o); pk = *(const f16x8*)(KP + o); pr = *(const f16x8*)(PS + (t0 + pst) * 1792 + h * 64 + pc8 * 8);
        if (tid < 64) { const int st = tid >> 1, hf = tid & 1; pv = *(const f16x8*)(PS + (t0 + st) * 1792 + 1024 + h * 64 + q * 16 + hf * 8); }
    };
    f32x4 S = {0.f, 0.f, 0.f, 0.f};
    if (part == 2) {
#pragma unroll
        for (int e = 0; e < 4; ++e) S[e] = (4 * ks + e == q * 16 + vrow) ? 1.0f : 0.0f;
    }
    BSYNC();
    prefetch(0);
    for (int c = 0; c < nc; ++c) {
        BSYNC();
        if (c > 0) {
#pragma unroll
            for (int i = 0; i < 2; ++i) { const int e = tid + 256 * i, st = e >> 4, r = e & 15; Y[(tb + (c - 1) * 32 + st) * 512 + h * 64 + q * 16 + r] = sY[e]; }
        }
        {
            const int o = tid * 8;
            float br = 0.f, kr = 0.f;
            f32x4 wr0, wr1, n0, n1, b0, b1, k0, k1;
#pragma unroll
            for (int e = 0; e < 4; ++e) {
                const float r0 = (float)pr[e], r1 = (float)pr[4 + e];
                n0[e] = (float)pn[e]; n1[e] = (float)pn[4 + e]; b0[e] = (float)pb[e]; b1[e] = (float)pb[4 + e]; k0[e] = (float)pk[e]; k1[e] = (float)pk[4 + e];
                wr0[e] = pw0[e] * r0; wr1[e] = pw1[e] * r1;
                br += b0[e] * r0 + b1[e] * r1; kr += k0[e] * r0 + k1[e] * r1;
            }
            *(f32x4*)(sW + o) = pw0; *(f32x4*)(sW + o + 4) = pw1; *(f32x4*)(sN + o) = n0; *(f32x4*)(sN + o + 4) = n1;
            *(f32x4*)(sB + o) = b0; *(f32x4*)(sB + o + 4) = b1; *(f32x4*)(sK + o) = k0; *(f32x4*)(sK + o + 4) = k1;
            *(f32x4*)(sWR + o) = wr0; *(f32x4*)(sWR + o + 4) = wr1;
            br += __shfl_xor(br, 1); br += __shfl_xor(br, 2); br += __shfl_xor(br, 4);
            kr += __shfl_xor(kr, 1); kr += __shfl_xor(kr, 2); kr += __shfl_xor(kr, 4);
            if (pc8 == 0) { sS[pst * 2] = br; sS[pst * 2 + 1] = kr; }
            if (tid < 64) {
#pragma unroll
                for (int e = 0; e < 8; ++e) sV[tid * 8 + e] = (part == 2) ? 0.0f : (float)pv[e];
            }
        }
        BSYNC();
        if (c + 1 < nc) prefetch(c + 1);
        float y0 = 0.f, y1 = 0.f;
        f32x4 w4 = *(const f32x4*)(sW + ks * 4), n4 = *(const f32x4*)(sN + ks * 4), b4 = *(const f32x4*)(sB + ks * 4);
        f32x4 k4 = *(const f32x4*)(sK + ks * 4), q4 = *(const f32x4*)(sWR + ks * 4);
        float vv = sV[vrow]; f32x2 sc = *(const f32x2*)(sS);
#pragma unroll
        for (int s = 0; s < 32; ++s) {
            f32x4 w4n = w4, n4n = n4, b4n = b4, k4n = k4, q4n = q4; float vvn = vv; f32x2 scn = sc;
            if (s + 1 < 32) {
                w4n = *(const f32x4*)(sW + (s + 1) * 64 + ks * 4); n4n = *(const f32x4*)(sN + (s + 1) * 64 + ks * 4); b4n = *(const f32x4*)(sB + (s + 1) * 64 + ks * 4);
                k4n = *(const f32x4*)(sK + (s + 1) * 64 + ks * 4); q4n = *(const f32x4*)(sWR + (s + 1) * 64 + ks * 4);
                vvn = sV[(s + 1) * 16 + vrow]; scn = *(const f32x2*)(sS + (s + 1) * 2);
            }
            __builtin_amdgcn_sched_barrier(0);
            float d1 = fmaf(S[3], n4[3], fmaf(S[2], n4[2], fmaf(S[1], n4[1], S[0] * n4[0])));
            float d2 = fmaf(S[3], q4[3], fmaf(S[2], q4[2], fmaf(S[1], q4[1], S[0] * q4[0])));
            d1 = row16_sum(d1); d2 = row16_sum(d2);
            const float y = d2 + d1 * sc[0] + vv * sc[1];
            S = S * w4 + (b4 * d1 + k4 * vv);
            if (s < 16) y0 = (ks == s) ? y : y0; else y1 = (ks == s - 16) ? y : y1;
            __builtin_amdgcn_sched_barrier(0);
            w4 = w4n; n4 = n4n; b4 = b4n; k4 = k4n; q4 = q4n; vv = vvn; sc = scn;
        }
        sY[ks * 16 + vrow] = y0; sY[(16 + ks) * 16 + vrow] = y1;
    }
    BSYNC();
#pragma unroll
    for (int i = 0; i < 2; ++i) { const int e = tid + 256 * i, st = e >> 4, r = e & 15; Y[(tb + (size_t)(nc - 1) * 32 + st) * 512 + h * 64 + q * 16 + r] = sY[e]; }
    if (wr_end) *(f32x4*)((float*)(WS + S_SMID) + ((size_t)bh * 64 + q * 16 + vrow) * 64 + ks * 4) = S;
}
#else
constexpr int NREC = 8;
__device__ __forceinline__ void rwkv_rec(const Params& p, int rb, char*) {
    const int gt = rb * 256 + TID, bh = gt >> 6, v = gt & 63, b = bh >> 3, h = bh & 7;
    const float* WD = (const float*)(WS + S_WD32); const f16* NKK = (const f16*)(WS + S_NKK); const f16* BB = (const f16*)(WS + S_BB);
    const f16* KP = (const f16*)(WS + S_KP); const f16* PS = (const f16*)(WS + S_PS16); float* Y = (float*)(WS + S_Y32);
    float S[64];
#pragma unroll
    for (int k = 0; k < 64; ++k) S[k] = 0.f;
    for (int s = 0; s < SEQ; ++s) {
        const size_t t = (size_t)b * SEQ + s, o = t * 512 + h * 64;
        const float vv = (float)PS[t * 1792 + 1024 + h * 64 + v];
        float sa = 0.f;
#pragma unroll
        for (int k8 = 0; k8 < 8; ++k8) { const f16x8 n8 = *(const f16x8*)(NKK + o + k8 * 8);
#pragma unroll
            for (int e = 0; e < 8; ++e) sa += S[k8 * 8 + e] * (float)n8[e]; }
        float y = 0.f;
#pragma unroll
        for (int k8 = 0; k8 < 8; ++k8) {
            const f16x8 b8 = *(const f16x8*)(BB + o + k8 * 8), kp8 = *(const f16x8*)(KP + o + k8 * 8), r8 = *(const f16x8*)(PS + t * 1792 + h * 64 + k8 * 8);
            const f32x4 wa = *(const f32x4*)(WD + o + k8 * 8), wb = *(const f32x4*)(WD + o + k8 * 8 + 4);
#pragma unroll
            for (int e = 0; e < 8; ++e) {
                const float w = e < 4 ? wa[e & 3] : wb[e & 3];
                const float sn = S[k8 * 8 + e] * w + (sa * (float)b8[e] + vv * (float)kp8[e]);
                S[k8 * 8 + e] = sn; y += sn * (float)r8[e];
            }
        }
        Y[t * 512 + h * 64 + v] = y;
    }
}
#endif

__device__ __forceinline__ void sg_item(const Params& p, int j, int item, char* smem) {
    WAVE_IDS
    const int g = item & 3, bc = item >> 2;
    const f16* P = (const f16*)(WS + S_P16);
    f16* ZT = (f16*)(WS + S_ZT) + (size_t)item * 128 * 128;
    const float* lg = IN(14) + (j * 4 + g) * 128; const float* lb = IN(15) + (j * 4 + g) * 128;
    {
        const int sub = tid & 15, rloc = tid >> 4;
        for (int it = 0; it < 8; ++it) {
            const int s = it * 16 + rloc;
            const f16x8 x = *(const f16x8*)(P + (size_t)(bc * 128 + s) * 2816 + 2304 + g * 128 + sub * 8);
            float z[8], sum = 0.f;
#pragma unroll
            for (int e = 0; e < 8; ++e) { z[e] = gelu_((float)x[e]); sum += z[e]; }
            const float mean = row16_sum(sum) * (1.0f / 128.0f);
            float qq = 0.f;
#pragma unroll
            for (int e = 0; e < 8; ++e) { const float d = z[e] - mean; qq += d * d; }
            const float rstd = rsqrtf(row16_sum(qq) * (1.0f / 128.0f) + 1e-5f);
#pragma unroll
            for (int e = 0; e < 8; ++e) { const int d = sub * 8 + e; ZT[(size_t)d * 128 + s] = (f16)((z[e] - mean) * rstd * lg[d] + lb[d]); }
        }
    }
    asm volatile("s_waitcnt vmcnt(0)" ::: "memory");
    BSYNC();
    const f16* Wm = (const f16*)(WS + W_SGW) + (size_t)(j * 4 + g) * 128 * 128;
    f32x4 acc[4][4];
    gemm_core<true>(acc, [&](int r) { return Wm + (size_t)r * 128; }, [&](int r) { return (const f16*)ZT + (size_t)r * 128; }, 2, smem);
    const float* bs = IN(17) + (j * 4 + g) * 128;
    f16* MIX = (f16*)(WS + S_MIX16);
#pragma unroll
    for (int m = 0; m < 4; ++m)
#pragma unroll
        for (int n = 0; n < 4; ++n) {
            const int tl = wr * 64 + m * 16 + fr, d = wc * 64 + n * 16 + 4 * fq;
            const size_t t = (size_t)bc * 128 + tl;
            const f32x4 u = cvt4f(*(const f16x4*)(P + t * 2816 + 1792 + g * 128 + d));
            f32x4 o;
#pragma unroll
            for (int e = 0; e < 4; ++e) o[e] = gelu_(u[e]) * (acc[m][n][e] + bs[tl]);
            *(f16x4*)(MIX + t * 1024 + 512 + g * 128 + d) = cvt4(o);
        }
}

__device__ __forceinline__ void phase_rec_sg(const Params& p, int j, bool pre, bool segmode, char* smem) {
#if FAST_REC
    const int bid = BID, nb = NBLK;
    if (!segmode) {
        const bool isrec = (bid < 256) && (((bid >> 3) & 1) == 0);
        if (isrec) { const int u = ((bid >> 4) << 3) | (bid & 7); rwkv_rec(p, u >> 2, u & 3, 0, 128, 0, false, smem); }
        else {
            const int sgi = (bid < 256) ? (((bid >> 4) << 3) | (bid & 7)) : (bid - 128);
            for (int item = sgi; item < 512; item += nb - 128) sg_item(p, j, item, smem);
            if (pre) {
                for (int item = sgi; item < 2048; item += nb - 128) xa_pre_item(p, item, smem);
                BSYNC();
                convert_moe(p, smem, sgi, nb - 128);
            }
        }
    } else {
        const int nrec = (nb * 3) >> 2;
        if (bid < nrec) {
            for (int v = bid; v < 384; v += nrec) {
                int bh, q, part;
                if (v >= 128 && v < 256) { const int u = v - 128; bh = u >> 2; q = u & 3; part = 0; }
                else { const int u = (v < 128) ? v : v - 128; bh = u >> 3; q = u & 3; part = 1 + ((u >> 2) & 1); }
                rwkv_rec(p, bh, q, part == 0 ? 0 : SEG_C0, part == 0 ? SEG_C0 : 128 - SEG_C0, part == 2 ? 2 : 0, part == 0, smem);
            }
        } else {
            for (int item = bid - nrec; item < 512; item += nb - nrec) sg_item(p, j, item, smem);
        }
    }
#else
    if (BID < NREC) rwkv_rec(p, BID, smem);
    else {
        for (int item = BID - NREC; item < 512; item += NBLK - NREC) sg_item(p, j, item, smem);
        if (pre) { for (int item = BID - NREC; item < 2048; item += NBLK - NREC) xa_pre_item(p, item, smem); BSYNC(); convert_moe(p, smem, BID - NREC, NBLK - NREC); }
    }
#endif
}

__device__ __forceinline__ void phase_rw_fin_seg(const Params& p, int j, char* smem) {
    const int tid = TID, tl = tid >> 2, vq = tid & 3;
    const float* Y = (const float*)(WS + S_Y32); const float* YT = (const float*)(WS + S_YT); const float* SM = (const float*)(WS + S_SMID);
    const f16* PS = (const f16*)(WS + S_PS16); const f16* G16 = (const f16*)(WS + S_G16);
    const float* BSUM = (const float*)(WS + S_BSUM); f16* MIX = (f16*)(WS + S_MIX16);
    const float* gg = IN(12) + j * 512; const float* gb = IN(13) + j * 512;
    float* sST = (float*)smem;
    float* sYT = sST + 64 * 64;
    for (int item = BID; item < 2048; item += NBLK) {
        const int bh = item >> 6, tile = item & 63, b = bh >> 3, h = bh & 7;
        const size_t t = (size_t)b * SEQ + tile * 64 + tl;
        const int c = h * 64 + vq * 16;
        float y[16];
#pragma unroll
        for (int i4 = 0; i4 < 4; ++i4) { const f32x4 v4 = *(const f32x4*)(Y + t * 512 + c + i4 * 4); y[i4 * 4] = v4[0]; y[i4 * 4 + 1] = v4[1]; y[i4 * 4 + 2] = v4[2]; y[i4 * 4 + 3] = v4[3]; }
        if (tile >= SEG_C0 / 2) {
            BSYNC();
            {
                const int v = tid >> 2, i0 = (tid & 3) * 16;
#pragma unroll
                for (int i4 = 0; i4 < 4; ++i4) { const f32x4 v4 = *(const f32x4*)(SM + ((size_t)bh * 64 + v) * 64 + i0 + i4 * 4);
#pragma unroll
                    for (int e = 0; e < 4; ++e) sST[(i0 + i4 * 4 + e) * 64 + v] = v4[e]; }
#pragma unroll
                for (int i4 = 0; i4 < 4; ++i4) { const f32x4 v4 = *(const f32x4*)(YT + t * 512 + c + i4 * 4);
#pragma unroll
                    for (int e = 0; e < 4; ++e) sYT[tl * 65 + vq * 16 + i4 * 4 + e] = v4[e]; }
            }
            BSYNC();
            for (int i = 0; i < 64; ++i) {
                const float a = sYT[tl * 65 + i];
#pragma unroll
                for (int i4 = 0; i4 < 4; ++i4) { const f32x4 s4 = *(const f32x4*)(sST + i * 64 + vq * 16 + i4 * 4);
                    y[i4 * 4] += a * s4[0]; y[i4 * 4 + 1] += a * s4[1]; y[i4 * 4 + 2] += a * s4[2]; y[i4 * 4 + 3] += a * s4[3]; }
            }
        }
        float sum = 0.f;
#pragma unroll
        for (int e = 0; e < 16; ++e) sum += y[e];
        sum += __shfl_xor(sum, 1); sum += __shfl_xor(sum, 2);
        const float mean = sum * (1.0f / 64.0f);
        float qq = 0.f;
#pragma unroll
        for (int e = 0; e < 16; ++e) { const float d = y[e] - mean; qq += d * d; }
        qq += __shfl_xor(qq, 1); qq += __shfl_xor(qq, 2);
        const float rstd = rsqrtf(qq * (1.0f / 64.0f) + 64e-5f);
        const float bsum = BSUM[t * 8 + h];
#pragma unroll
        for (int hf = 0; hf < 2; ++hf) {
            const f16x8 v8 = *(const f16x8*)(PS + t * 1792 + 1024 + c + hf * 8), g8 = *(const f16x8*)(G16 + t * 512 + c + hf * 8);
            f16x8 o;
#pragma unroll
            for (int e = 0; e < 8; ++e) {
                const float r = ((y[hf * 8 + e] - mean) * rstd * gg[c + hf * 8 + e] + gb[c + hf * 8 + e] + bsum * (float)v8[e]) * (float)g8[e];
                o[e] = (f16)r;
            }
            *(f16x8*)(MIX + t * 1024 + c + hf * 8) = o;
        }
    }
}

__device__ __forceinline__ void phase_rw_fin(const Params& p, int j) {
    const int lane = TID & 63, gw = BID * 4 + (TID >> 6), nw = NBLK * 4;
    const float* Y = (const float*)(WS + S_Y32); const f16* PS = (const f16*)(WS + S_PS16); const f16* G16 = (const f16*)(WS + S_G16);
    const float* BSUM = (const float*)(WS + S_BSUM); f16* MIX = (f16*)(WS + S_MIX16);
    const float* gg = IN(12) + j * 512; const float* gb = IN(13) + j * 512;
    for (int t = gw; t < T; t += nw) {
        const int c = lane * 8, head = lane >> 3;
        const f32x4 y0 = *(const f32x4*)(Y + (size_t)t * 512 + c), y1 = *(const f32x4*)(Y + (size_t)t * 512 + c + 4);
        float s = (y0[0] + y0[1]) + (y0[2] + y0[3]) + (y1[0] + y1[1]) + (y1[2] + y1[3]);
        s += __shfl_xor(s, 1); s += __shfl_xor(s, 2); s += __shfl_xor(s, 4);
        const float mean = s * (1.0f / 64.0f);
        float qq = 0.f;
#pragma unroll
        for (int e = 0; e < 4; ++e) { const float d0 = y0[e] - mean, d1 = y1[e] - mean; qq += d0 * d0 + d1 * d1; }
        qq += __shfl_xor(qq, 1); qq += __shfl_xor(qq, 2); qq += __shfl_xor(qq, 4);
        const float rstd = rsqrtf(qq * (1.0f / 64.0f) + 64e-5f);
        const float bsum = BSUM[(size_t)t * 8 + head];
        const f16x8 v8 = *(const f16x8*)(PS + (size_t)t * 1792 + 1024 + c), g8 = *(const f16x8*)(G16 + (size_t)t * 512 + c);
        f16x8 o;
#pragma unroll
        for (int e = 0; e < 8; ++e) {
            const float yv = e < 4 ? y0[e & 3] : y1[e & 3];
            const float r = ((yv - mean) * rstd * gg[c + e] + gb[c + e] + bsum * (float)v8[e]) * (float)g8[e];
            o[e] = (f16)r;
        }
        *(f16x8*)(MIX + (size_t)t * 1024 + c) = o;
    }
}

__device__ __forceinline__ void phase_mla_in(const Params& p, int j, char* smem) {
    WAVE_IDS
    const f16* X = (const f16*)(WS + OFF_H16);
    const f16* Wt = (const f16*)(WS + W_MLAIN) + (size_t)j * 640 * 1024;
    f16* CQKV = (f16*)(WS + S_CQKV); f16* KPE = (f16*)(WS + S_KPE); float* SSQ = (float*)(WS + S_SSQ);
    const f32x2* rope = (const f32x2*)(WS + OFF_ROPE);
    GPipe gp{0, 0};
    tile_loop2(128, 5, [&](int rt, int ct, bool hn, int nrt, int nct) {
        f32x4 acc[4][4];
        gemm_core_pf<true>(acc, [&](int a, int, int r) { return X + (size_t)(a * 128 + r) * 1024; }, [&](int, int c, int r) { return Wt + (size_t)(c * 128 + r) * 1024; },
                           rt, ct, 16, hn, nrt, nct, gp, smem);
        if (ct < 4) {
#pragma unroll
            for (int m = 0; m < 4; ++m) {
                const int row = rt * 128 + wr * 64 + m * 16 + fr;
                float ss = 0.f;
#pragma unroll
                for (int n = 0; n < 4; ++n) {
                    *(f16x4*)(CQKV + (size_t)row * 512 + ct * 128 + wc * 64 + n * 16 + 4 * fq) = cvt4(acc[m][n]);
                    const f32x4 a = acc[m][n]; ss += (a[0] * a[0] + a[1] * a[1]) + (a[2] * a[2] + a[3] * a[3]);
                }
                ss += __shfl_xor(ss, 16); ss += __shfl_xor(ss, 32);
                if (fq == 0) SSQ[(size_t)row * 8 + ct * 2 + wc] = ss;
            }
        } else if (wc == 0) {
#pragma unroll
            for (int m = 0; m < 4; ++m) {
                const int row = rt * 128 + wr * 64 + m * 16 + fr, pos = row & (SEQ - 1);
                f32x4 o1, o2;
#pragma unroll
                for (int e = 0; e < 4; ++e) {
                    const f32x2 cs = rope[pos * 16 + 4 * fq + e];
                    const float x1 = acc[m][0][e], x2 = acc[m][1][e];
                    o1[e] = x1 * cs[0] - x2 * cs[1]; o2[e] = x1 * cs[1] + x2 * cs[0];
                }
                *(f16x4*)(KPE + (size_t)row * 32 + 4 * fq) = cvt4(o1);
                *(f16x4*)(KPE + (size_t)row * 32 + 16 + 4 * fq) = cvt4(o2);
            }
        }
    });
}

__device__ __forceinline__ void phase_mla_qkv(const Params& p, int j, char* smem) {
    WAVE_IDS
    const f16* CQKV = (const f16*)(WS + S_CQKV);
    f16* Q16 = (f16*)(WS + S_Q16); f16* KN = (f16*)(WS + S_KN16); f16* VT = (f16*)(WS + S_VT16);
    const f32x2* rope = (const f32x2*)(WS + OFF_ROPE);
    const float* SSQ = (const float*)(WS + S_SSQ);
    GPipe gp{0, 0};
    const f16* Wqb = (const f16*)(WS + W_Q) + (size_t)j * 1536 * 256; const f16* Wkvb = (const f16*)(WS + W_KV) + (size_t)j * 2048 * 256;
    auto xpf = [&](int a, int c, int r) { return CQKV + (size_t)(a * 128 + r) * 512 + (c < 12 ? 0 : 256); };
    auto wpf = [&](int, int c, int r) { return c < 12 ? Wqb + (size_t)(c * 128 + r) * 256 : Wkvb + (size_t)((c - 12) * 128 + r) * 256; };
    tile_loop2(128, 28, [&](int rt, int ct, bool hn, int nrt, int nct) {
        const bool isq = ct < 12;
        auto rrow = [&](int rl) { const f32x4 q4 = *(const f32x4*)(SSQ + (size_t)(rt * 128 + rl) * 8 + (isq ? 0 : 4)); return rsqrtf(((q4[0] + q4[1]) + (q4[2] + q4[3])) * (1.0f / 256.0f) + 1e-6f); };
        f32x4 acc[4][4];
        if (isq) {
            gemm_core_pf<true>(acc, xpf, wpf, rt, ct, 4, hn, nrt, nct, gp, smem);
            const int cb = ct * 128 + wc * 64;
#pragma unroll
            for (int m = 0; m < 4; ++m) {
                const int rl = wr * 64 + m * 16 + fr, row = rt * 128 + rl, pos = row & (SEQ - 1);
                const float sc = rrow(rl);
#pragma unroll
                for (int n = 0; n < 4; ++n) acc[m][n] = acc[m][n] * sc;
#pragma unroll
                for (int n = 0; n < 4; n += 2) {
                    if (((cb + n * 16) % 96) == 64) {
#pragma unroll
                        for (int e = 0; e < 4; ++e) {
                            const f32x2 cs = rope[pos * 16 + 4 * fq + e];
                            const float x1 = acc[m][n][e], x2 = acc[m][n + 1][e];
                            acc[m][n][e] = x1 * cs[0] - x2 * cs[1]; acc[m][n + 1][e] = x1 * cs[1] + x2 * cs[0];
                        }
                    }
                }
#pragma unroll
                for (int n = 0; n < 4; ++n) *(f16x4*)(Q16 + (size_t)row * 1536 + cb + n * 16 + 4 * fq) = cvt4(acc[m][n]);
            }
        } else {
            const int c2 = ct - 12;
            if (c2 < 8) {
                gemm_core_pf<true>(acc, xpf, wpf, rt, ct, 4, hn, nrt, nct, gp, smem);
#pragma unroll
                for (int m = 0; m < 4; ++m) {
                    const int rl = wr * 64 + m * 16 + fr; const float sc = rrow(rl);
#pragma unroll
                    for (int n = 0; n < 4; ++n) *(f16x4*)(KN + (size_t)(rt * 128 + rl) * 1024 + c2 * 128 + wc * 64 + n * 16 + 4 * fq) = cvt4(acc[m][n] * sc);
                }
            } else {
                gemm_core_pf<false>(acc, xpf, wpf, rt, ct, 4, hn, nrt, nct, gp, smem);
#pragma unroll
                for (int m = 0; m < 4; ++m) {
                    const int rl = wr * 64 + m * 16 + 4 * fq, row = rt * 128 + rl, b = row >> 12, s = row & (SEQ - 1);
                    f32x4 sc; sc[0] = rrow(rl); sc[1] = rrow(rl + 1); sc[2] = rrow(rl + 2); sc[3] = rrow(rl + 3);
#pragma unroll
                    for (int n = 0; n < 4; ++n) {
                        const int col = (c2 - 8) * 128 + wc * 64 + n * 16 + fr, h = col >> 6, d = col & 63;
                        *(f16x4*)(VT + ((size_t)((b * 16 + h) * 64 + d)) * SEQ + s) = cvt4(acc[m][n] * sc);
                    }
                }
            }
        }
    });
}

__device__ __forceinline__ f32x4 mfma16(f16x8 a, f16x8 b, f32x4 c) { return __builtin_amdgcn_mfma_f32_16x16x32_f16(a, b, c, 0, 0, 0); }
__device__ __forceinline__ f16x8 cat4(f16x4 lo, f16x4 hi) { return __builtin_shufflevector(lo, hi, 0, 1, 2, 3, 4, 5, 6, 7); }

__device__ __forceinline__ void phase_mla_attn(const Params& p, char* smem) {
    const int tid = TID, lane = tid & 63, wid = tid >> 6, li = lane & 15, g = lane >> 4;
    const f16* Q16 = (const f16*)(WS + S_Q16); const f16* KN = (const f16*)(WS + S_KN16); const f16* KPE = (const f16*)(WS + S_KPE);
    const f16* VT = (const f16*)(WS + S_VT16); f16* O = (f16*)(WS + S_MIX16);
    constexpr int BUF = 20480;
    const int sc8 = ((tid & 7) ^ ((tid >> 4) & 7)) * 8;
    const int scp = ((tid & 3) ^ ((0x78 >> (2 * ((tid >> 4) & 3))) & 3)) * 8;
    const int kn_rd0 = ((0 + g) ^ (li >> 1)) * 16, kn_rd1 = ((4 + g) ^ (li >> 1)) * 16;
    const int kp_rd = (g ^ ((0x78 >> (2 * ((li >> 2) & 3))) & 3)) * 16;
    const int v_rd[4] = {(((0 + (g >> 1)) ^ (li >> 1)) * 16) + (g & 1) * 8, (((2 + (g >> 1)) ^ (li >> 1)) * 16) + (g & 1) * 8,
                         (((4 + (g >> 1)) ^ (li >> 1)) * 16) + (g & 1) * 8, (((6 + (g >> 1)) ^ (li >> 1)) * 16) + (g & 1) * 8};
    const int nb_ = NBLK, xcd_ = BID & 7, lb_ = BID >> 3, nlb_ = nb_ >> 3;
    for (int j_ = lb_; j_ < 128; j_ += nlb_) {
        const int bh = xcd_ * 8 + (j_ >> 4), pr = j_ & 15, b = bh >> 4, h = bh & 15;
        const size_t tb = (size_t)b * SEQ;
        for (int half = 0; half < 2; ++half) {
            const int qb = half ? pr : 31 - pr;
            const int qw = qb * 128 + wid * 32;
            const int nch = 2 * qb + 2, lastw = (qw + 31) >> 6;
            f16x8 Qf[2][3];
#pragma unroll
            for (int jq = 0; jq < 2; ++jq)
#pragma unroll
                for (int ks = 0; ks < 3; ++ks) Qf[jq][ks] = *(const f16x8*)(Q16 + (tb + qw + jq * 16 + li) * 1536 + h * 96 + ks * 32 + 8 * g);
            asm volatile("s_waitcnt vmcnt(0)" ::: "memory");
#pragma unroll
            for (int jq = 0; jq < 2; ++jq)
#pragma unroll
                for (int ks = 0; ks < 3; ++ks) asm volatile("" : "+v"(Qf[jq][ks]));
            f32x4 Oa[5][2];
#pragma unroll
            for (int vb = 0; vb < 5; ++vb) { Oa[vb][0] = (f32x4){0.f, 0.f, 0.f, 0.f}; Oa[vb][1] = (f32x4){0.f, 0.f, 0.f, 0.f}; }
            f16x8 ones;
#pragma unroll
            for (int e = 0; e < 8; ++e) ones[e] = (f16)1.0f;
            const f16* kn_src = KN + (tb + (tid >> 3)) * 1024 + h * 64 + sc8;
            const f16* kp_src = KPE + (tb + (tid >> 2)) * 32 + scp;
            const f16* v_src = VT + ((size_t)((b * 16 + h) * 64 + (tid >> 3))) * SEQ + sc8;
            auto stage = [&](int kc, int s) {
                char* base = smem + s * BUF + tid * 16;
                __builtin_amdgcn_global_load_lds((const void*)(kn_src + (size_t)kc * 64 * 1024), (LAS void*)(base), 16, 0, 0);
                __builtin_amdgcn_global_load_lds((const void*)(kn_src + (size_t)(kc * 64 + 32) * 1024), (LAS void*)(base + 4096), 16, 0, 0);
                __builtin_amdgcn_global_load_lds((const void*)(v_src + kc * 64), (LAS void*)(base + 8192), 16, 0, 0);
                __builtin_amdgcn_global_load_lds((const void*)(v_src + (size_t)32 * SEQ + kc * 64), (LAS void*)(base + 8192 + 4096), 16, 0, 0);
                __builtin_amdgcn_global_load_lds((const void*)(kp_src + (size_t)kc * 64 * 32), (LAS void*)(base + 16384), 16, 0, 0);
            };
            BSYNC();
            stage(0, 0);
            if (nch > 1) stage(1, 1);
            for (int kc = 0; kc < nch; ++kc) {
                const int s = kc % 3;
                if (kc + 1 < nch) asm volatile("s_waitcnt vmcnt(5) lgkmcnt(0)" ::: "memory"); else asm volatile("s_waitcnt vmcnt(0) lgkmcnt(0)" ::: "memory");
                __builtin_amdgcn_s_barrier();
                asm volatile("" ::: "memory");
                if (kc + 2 < nch) stage(kc + 2, (kc + 2) % 3);
                if (kc > lastw) continue;
                const char* bK = smem + s * BUF; const char* bV = bK + 8192; const char* bP = bK + 16384;
                f32x4 Sx[4][2];
#pragma unroll
                for (int kb = 0; kb < 4; ++kb) { Sx[kb][0] = (f32x4){-8.f, -8.f, -8.f, -8.f}; Sx[kb][1] = (f32x4){-8.f, -8.f, -8.f, -8.f}; }
#pragma unroll
                for (int kb = 0; kb < 4; ++kb) {
                    const f16x8 K0 = *(const f16x8*)(bK + (kb * 16 + li) * 128 + kn_rd0);
                    const f16x8 K1 = *(const f16x8*)(bK + (kb * 16 + li) * 128 + kn_rd1);
                    const f16x8 K2 = *(const f16x8*)(bP + (kb * 16 + li) * 64 + kp_rd);
                    Sx[kb][0] = mfma16(K0, Qf[0][0], Sx[kb][0]); Sx[kb][1] = mfma16(K0, Qf[1][0], Sx[kb][1]);
                    Sx[kb][0] = mfma16(K1, Qf[0][1], Sx[kb][0]); Sx[kb][1] = mfma16(K1, Qf[1][1], Sx[kb][1]);
                    Sx[kb][0] = mfma16(K2, Qf[0][2], Sx[kb][0]); Sx[kb][1] = mfma16(K2, Qf[1][2], Sx[kb][1]);
                }
                if (kc * 64 + 63 > qw) {
#pragma unroll
                    for (int jq = 0; jq < 2; ++jq) {
                        const int qpos = qw + jq * 16 + li;
#pragma unroll
                        for (int kb = 0; kb < 4; ++kb)
#pragma unroll
                            for (int r = 0; r < 4; ++r)
                                if (kc * 64 + kb * 16 + 4 * g + r > qpos) Sx[kb][jq][r] = -1e4f;
                    }
                }
                f16x8 Pf[2][2];
#pragma unroll
                for (int jq = 0; jq < 2; ++jq) {
#pragma unroll
                    for (int kb = 0; kb < 4; ++kb)
#pragma unroll
                        for (int r = 0; r < 4; ++r) Sx[kb][jq][r] = __builtin_amdgcn_exp2f(Sx[kb][jq][r]);
                    Pf[jq][0] = cat4(cvt4(Sx[0][jq]), cvt4(Sx[1][jq]));
                    Pf[jq][1] = cat4(cvt4(Sx[2][jq]), cvt4(Sx[3][jq]));
                }
#pragma unroll
                for (int kp = 0; kp < 2; ++kp) {
#pragma unroll
                    for (int vb = 0; vb < 4; ++vb) {
                        const char* vp = bV + (vb * 16 + li) * 128;
                        const f16x8 Vf = cat4(*(const f16x4*)(vp + v_rd[kp * 2]), *(const f16x4*)(vp + v_rd[kp * 2 + 1]));
                        Oa[vb][0] = mfma16(Vf, Pf[0][kp], Oa[vb][0]);
                        Oa[vb][1] = mfma16(Vf, Pf[1][kp], Oa[vb][1]);
                    }
                    Oa[4][0] = mfma16(ones, Pf[0][kp], Oa[4][0]);
                    Oa[4][1] = mfma16(ones, Pf[1][kp], Oa[4][1]);
                }
            }
#pragma unroll
            for (int jq = 0; jq < 2; ++jq) {
                const float inv = 1.0f / Oa[4][jq][0];
#pragma unroll
                for (int vb = 0; vb < 4; ++vb)
                    *(f16x4*)(O + (tb + qw + jq * 16 + li) * 1024 + h * 64 + vb * 16 + 4 * g) = cvt4(Oa[vb][jq] * inv);
            }
        }
    }
}

__device__ __forceinline__ void phase_xa_scores(const Params& p, int L, char* smem) {
    WAVE_IDS
    const f16* X = (const f16*)(WS + S_Y32R); const float* PST = (const float*)(WS + S_PST1);
    const float* XU = (const float*)(WS + OFF_XU) + (size_t)(L * 4) * 1024; const float* XC = (const float*)(WS + OFF_XC) + (size_t)(L * 4) * 1024;
    f16* XP = (f16*)(WS + S_XP16); float* LP = (float*)(WS + S_XLP);
    float* srow = (float*)(smem + SMEM_MAIN + 1024);
    GPipe gp{0, 0};
    const f16* XMb = (const f16*)(WS + OFF_XM) + (size_t)(L * 4) * 1024 * 1024;
    tile_loop2(128, 8, [&](int rt, int ct, bool hn, int nrt, int nct) {
        row_stats_table(PST, [&](int r) { return rt * 128 + r; }, srow);
        f32x4 acc[4][4];
        gemm_core_pf<true>(acc, [&](int a, int, int r) { return X + (size_t)(a * 128 + r) * 1024; },
                           [&](int a, int c, int r) { return XMb + (size_t)(a >> 5) * 1024 * 1024 + (size_t)(c * 128 + r) * 1024; }, rt, ct, 16, hn, nrt, nct, gp, smem);
        f32x4 u4[4], c4[4];
#pragma unroll
        for (int n = 0; n < 4; ++n) { const int col = (rt >> 5) * 1024 + ct * 128 + wc * 64 + n * 16 + 4 * fq; u4[n] = *(const f32x4*)(XU + col); c4[n] = *(const f32x4*)(XC + col); }
#pragma unroll
        for (int m = 0; m < 4; ++m) {
            const int row = rt * 128 + wr * 64 + m * 16 + fr;
            const f32x2 st = *(const f32x2*)(srow + (wr * 64 + m * 16 + fr) * 2);
            float ps = 0.f;
#pragma unroll
            for (int n = 0; n < 4; ++n) {
                const f32x4 sc = (acc[m][n] - u4[n] * st[0]) * st[1] + c4[n];
                f32x4 e;
#pragma unroll
                for (int q = 0; q < 4; ++q) e[q] = __builtin_amdgcn_exp2f(sc[q] - 8.0f);
                const f16x4 e16 = cvt4(e);
                const f32x4 er = cvt4f(e16);
                ps += (er[0] + er[1]) + (er[2] + er[3]);
                *(f16x4*)(XP + (size_t)row * 1024 + ct * 128 + wc * 64 + n * 16 + 4 * fq) = e16;
            }
            ps += __shfl_xor(ps, 16); ps += __shfl_xor(ps, 32);
            if (fq == 0) LP[(size_t)row * 16 + ct * 2 + wc] = ps;
        }
    });
}

__device__ __forceinline__ void phase_router(const Params& p, int L, char* smem) {
    WAVE_IDS
    const f16* X = (const f16*)(WS + OFF_H16);
    const f16* Wt = (const f16*)(WS + W_ROUTER) + (size_t)L * 128 * 1024;
    unsigned* cnt = (unsigned*)(WS + OFF_CNT) + L * 32;
    unsigned* list = (unsigned*)(WS + S_LIST); float* gates = (float*)(WS + S_GATES);
    const float* bg = IN(33) + L * 4; const float* be = IN(35) + L * 32;
    float* lg = (float*)smem;
    int* hist = (int*)(smem + 128 * 40 * 4); int* base = hist + 32;
    for (int rt = BID; rt < 128; rt += NBLK) {
        f32x4 acc[4][4];
        gemm_core<true>(acc, [&](int r) { return X + (size_t)(rt * 128 + r) * 1024; }, [&](int r) { return Wt + (size_t)r * 1024; }, 16, smem);
        BSYNC();
        if (wc == 0) {
#pragma unroll
            for (int m = 0; m < 4; ++m)
#pragma unroll
                for (int n = 0; n < 3; ++n) {
                    const int row = wr * 64 + m * 16 + fr, col = n * 16 + 4 * fq;
                    if (col < 40) *(f32x4*)(lg + row * 40 + col) = acc[m][n];
                }
        }
        if (tid < 32) hist[tid] = 0;
        BSYNC();
        int e0 = 0, e1 = 0, p0 = 0, p1 = 0; float g0 = 0.f, g1 = 0.f;
        if (tid < 128) {
            const float* l = lg + tid * 40;
            int grp = 0; float gm = l[0] + bg[0];
            for (int i = 1; i < 4; ++i) { const float v = l[i] + bg[i]; if (v > gm) { gm = v; grp = i; } }
            float den = 0.f;
            for (int i = 0; i < 4; ++i) den += __expf(l[i] + bg[i] - gm);
            const float pg = 1.0f / den;
            int i1 = 0; float v1 = l[4 + grp * 8] + be[grp * 8];
            for (int i = 1; i < 8; ++i) { const float v = l[4 + grp * 8 + i] + be[grp * 8 + i]; if (v > v1) { v1 = v; i1 = i; } }
            int i2 = -1; float v2 = -3.0e38f;
            for (int i = 0; i < 8; ++i) { const float v = l[4 + grp * 8 + i] + be[grp * 8 + i]; if (i != i1 && v > v2) { v2 = v; i2 = i; } }
            const float ex = __expf(v2 - v1);
            g0 = pg / (1.0f + ex); g1 = pg * ex / (1.0f + ex);
            e0 = grp * 8 + i1; e1 = grp * 8 + i2;
            p0 = atomicAdd(&hist[e0], 1); p1 = atomicAdd(&hist[e1], 1);
        }
        BSYNC();
        if (tid < 32) base[tid] = hist[tid] ? (int)atomicAdd(&cnt[tid], (unsigned)hist[tid]) : 0;
        BSYNC();
        if (tid < 128) {
            const int t = rt * 128 + tid;
            list[(size_t)e0 * 16384 + base[e0] + p0] = (unsigned)(t * 2);
            list[(size_t)e1 * 16384 + base[e1] + p1] = (unsigned)(t * 2 + 1);
            gates[t * 2] = g0; gates[t * 2 + 1] = g1;
        }
    }
}

__device__ __forceinline__ void moe_blocks(const Params& p, int L, char* smem, int* bs) {
    const unsigned* cnt = (const unsigned*)(WS + OFF_CNT) + L * 32;
    BSYNC();
    if (TID == 0) { int a = 0; for (int e = 0; e < 32; ++e) { bs[e] = a; a += ((int)cnt[e] + 127) >> 7; } bs[32] = a; }
    BSYNC();
}

__device__ __forceinline__ void phase_moe_up(const Params& p, int L, char* smem) {
    WAVE_IDS
    int* bs = (int*)(smem + SMEM_MAIN + 64); int* rowtok = bs + 40;
    moe_blocks(p, L, smem, bs);
    const unsigned* cnt = (const unsigned*)(WS + OFF_CNT) + L * 32; const unsigned* list = (const unsigned*)(WS + S_LIST);
    const f16* X = (const f16*)(WS + OFF_H16); f16* HB = (f16*)(WS + S_HBUF);
    const int nitems = bs[32] * 8;
    for (int item = BID; item < nitems; item += NBLK) {
        const int rbg = item >> 3, nt = item & 7;
        int e = 0; for (int i = 1; i < 32; ++i) if (bs[i] <= rbg) e = i;
        const int rb = rbg - bs[e], nrow = (int)cnt[e] - rb * 128;
        BSYNC();
        if (tid < 128) rowtok[tid] = (tid < nrow) ? (int)(list[(size_t)e * 16384 + rb * 128 + tid] >> 1) : 0;
        BSYNC();
        const f16* Wt = (const f16*)(WS + W_GU) + ((size_t)(L * 32 + e) * 1024 + nt * 128) * 1024;
        f32x4 acc[4][4];
        gemm_core<true>(acc, [&](int r) { return X + (size_t)rowtok[r] * 1024; }, [&](int r) { return Wt + (size_t)r * 1024; }, 16, smem);
#pragma unroll
        for (int m = 0; m < 4; ++m)
#pragma unroll
            for (int n = 0; n < 2; ++n) {
                f32x4 o;
#pragma unroll
                for (int q = 0; q < 4; ++q) { const float gv = acc[m][n][q]; o[q] = gv * sigmoid_(gv) * acc[m][n + 2][q]; }
                *(f16x4*)(HB + (size_t)(rbg * 128 + wr * 64 + m * 16 + fr) * 512 + nt * 64 + wc * 32 + n * 16 + 4 * fq) = cvt4(o);
            }
    }
}

__device__ __forceinline__ void phase_moe_down(const Params& p, int L, char* smem) {
    WAVE_IDS
    int* bs = (int*)(smem + SMEM_MAIN + 64); int* rowent = bs + 40;
    moe_blocks(p, L, smem, bs);
    const unsigned* cnt = (const unsigned*)(WS + OFF_CNT) + L * 32; const unsigned* list = (const unsigned*)(WS + S_LIST);
    const float* gates = (const float*)(WS + S_GATES);
    const f16* HB = (const f16*)(WS + S_HBUF); f16* FF = (f16*)(WS + S_FF16);
    const int nitems = bs[32] * 8;
    for (int item = BID; item < nitems; item += NBLK) {
        const int rbg = item >> 3, nt = item & 7;
        int e = 0; for (int i = 1; i < 32; ++i) if (bs[i] <= rbg) e = i;
        const int rb = rbg - bs[e], nrow = (int)cnt[e] - rb * 128;
        BSYNC();
        if (tid < 128) rowent[tid] = (tid < nrow) ? (int)list[(size_t)e * 16384 + rb * 128 + tid] : -1;
        BSYNC();
        const f16* Wt = (const f16*)(WS + W_D) + ((size_t)(L * 32 + e) * 1024 + nt * 128) * 512;
        f32x4 acc[4][4];
        gemm_core<true>(acc, [&](int r) { return HB + (size_t)(rbg * 128 + r) * 512; }, [&](int r) { return Wt + (size_t)r * 512; }, 8, smem);
#pragma unroll
        for (int m = 0; m < 4; ++m) {
            const int ent = rowent[wr * 64 + m * 16 + fr];
            if (ent >= 0) {
                const float gt = gates[ent];
                f16* dst = FF + ((size_t)(ent & 1) * T + (ent >> 1)) * 1024 + nt * 128 + wc * 64 + 4 * fq;
#pragma unroll
                for (int n = 0; n < 4; ++n) *(f16x4*)(dst + n * 16) = cvt4(acc[m][n] * gt);
            }
        }
    }
}

constexpr int NPHASES = 1 + 2 * 13 + 2 * 11;

__global__ void __launch_bounds__(256, 2) trunk_kernel(Params p) {
    __shared__ __attribute__((aligned(16))) char smem[SMEM_BYTES];
    volatile LAS unsigned* st = (volatile LAS unsigned*)(smem + SMEM_MAIN);
#if MEGA
    if (threadIdx.x == 0) { st[0] = 0u; st[1] = 0u; }
    BSYNC();
    const XcdBarrier xb = xcd_barrier_post((unsigned*)(WS + OFF_BAR), st);
#endif
    int ph = 0;
    char* ws = p.ws;
    f16* y16 = (f16*)(ws + S_Y32R); f16* h16 = (f16*)(ws + OFF_H16);
#ifndef ENMASK
#define ENMASK 0xFFFFFFFFu
#endif
#define EN(k) (((ENMASK) >> (k)) & 1u)
#ifndef REPMASK
#define REPMASK 0u
#endif
#ifndef REPN
#define REPN 2
#endif
#define NREP(k) ((((REPMASK) >> (k)) & 1u) ? (1 + REPN) : 1)
#if MEGA
#define STEP(k, ...) do { if (ph >= p.ph_begin && ph < p.ph_end) { if (EN(k)) { for (int rep_ = 0; rep_ < NREP(k); ++rep_) { __VA_ARGS__; } } if (ph + 1 < p.ph_end) xcd_barrier(xb); } ++ph; } while (0)
#else
#define STEP(k, ...) do { if (ph >= p.ph_begin && ph < p.ph_end) { if (EN(k)) { for (int rep_ = 0; rep_ < NREP(k); ++rep_) { __VA_ARGS__; } } } ++ph; } while (0)
#endif
    STEP(0, phase_convert(p, smem));
    for (int L = 0; L < 4; ++L) {
        const int j = L >> 1;
        const float* res32 = (L == 0) ? IN(0) : (const float*)nullptr;
        if ((L & 1) == 0) {
            STEP(1, phase_ab_in(p, j, smem); if (L == 0) phase_memkv(p, smem));
            STEP(2, phase_shift(p, j));
            STEP(3, phase_lora(p, j, smem));
            STEP(4, phase_rec_sg(p, j, L == 0, L != 0, smem));
            STEP(5, if (L != 0) phase_rw_fin_seg(p, j, smem); else { phase_rw_fin(p, j); xa_uc_reduce(p); });
            STEP(6, phase_gemm_res((const f16*)(ws + S_MIX16), (const f16*)(ws + W_ABOUT) + (size_t)j * 1024 * 1024, res32, h16, y16, (float*)(ws + S_PST1), smem));
        } else {
            STEP(7, phase_mla_in(p, j, smem));
            STEP(8, phase_mla_qkv(p, j, smem));
            STEP(9, phase_mla_attn(p, smem));
            STEP(6, phase_gemm_res((const f16*)(ws + S_MIX16), (const f16*)(ws + W_MLAOUT) + (size_t)j * 1024 * 1024, res32, h16, y16, (float*)(ws + S_PST1), smem));
        }
        STEP(11, phase_xa_scores(p, L, smem));
        STEP(12, phase_xa_out(p, L, y16, smem));
        STEP(10, phase_ln<2>(y16, nullptr, nullptr, nullptr, nullptr, IN(30) + L * 1024, IN(31) + L * 1024, nullptr, h16, nullptr));
        STEP(13, phase_router(p, L, smem));
        STEP(14, phase_moe_up(p, L, smem));
        STEP(15, phase_moe_down(p, L, smem));
        STEP(10, phase_ln<1>(y16, (const f16*)(ws + S_FF16), (const f16*)(ws + S_FF16) + (size_t)T * 1024, IN(30) + L * 1024, IN(31) + L * 1024, IN(39) + L * 1024, IN(40) + L * 1024,
                         (L == 3) ? p.out : (float*)nullptr, (L == 3) ? (f16*)nullptr : h16, nullptr));
    }
}

}

extern "C" void kernel_launch(void* const* d_in, const int* in_sizes, int n_in, void* d_out, int out_size, void* d_ws, size_t ws_size, hipStream_t stream) {
    (void)in_sizes; (void)n_in; (void)out_size; (void)ws_size;
    static int grid_blocks = 0;
    if (!grid_blocks) {
        int dev = 0, cus = 0, per_cu = 0;
        hipGetDevice(&dev);
        hipDeviceGetAttribute(&cus, hipDeviceAttributeMultiprocessorCount, dev);
        hipOccupancyMaxActiveBlocksPerMultiprocessor(&per_cu, trunk_kernel, 256, 0);
        if (per_cu > 2) per_cu = 2;
        if (per_cu < 1) per_cu = 1;
        grid_blocks = cus * per_cu;
        grid_blocks &= ~7;
    }
    Params p{};
    for (int i = 0; i < 41; ++i) p.in[i] = (const float*)d_in[i];
    p.out = (float*)d_out;
    p.ws = (char*)d_ws;
    hipMemsetAsync((char*)d_ws + OFF_BAR, 0, XCD_BAR_WORDS * 4, stream);
#if MEGA
    p.ph_begin = 0; p.ph_end = NPHASES;
    void* args[] = {&p};
    hipError_t e = hipLaunchCooperativeKernel((const void*)trunk_kernel, dim3(grid_blocks), dim3(256), args, 0, stream);
    if (e != hipSuccess) fprintf(stderr, "cooperative launch failed: %s (grid %d)\n", hipGetErrorString(e), grid_blocks);
#else
    for (int ph = 0; ph < NPHASES; ++ph) {
        p.ph_begin = ph; p.ph_end = ph + 1;
        hipLaunchKernelGGL(trunk_kernel, dim3(grid_blocks), dim3(256), 0, stream, p);
    }
#endif
}
```

```cpp
#include <hip/hip_runtime.h>
#include <stdint.h>
#include <stdio.h>

#ifndef MEGA
#define MEGA 1
#endif
#ifndef FAST_GEMM
#define FAST_GEMM 1
#endif
#ifndef FAST_REC
#define FAST_REC 1
#endif

typedef _Float16 f16;
typedef f16 f16x8 __attribute__((ext_vector_type(8)));
typedef f16 f16x4 __attribute__((ext_vector_type(4)));
typedef float f32x4 __attribute__((ext_vector_type(4)));
typedef float f32x2 __attribute__((ext_vector_type(2)));
#define LAS __attribute__((address_space(3)))

namespace {

constexpr int T = 16384, SEQ = 4096, D = 1024;
constexpr float DN_ALPHA = 1.681792830507429f;
constexpr float LOG2E = 1.4426950408889634f;

constexpr size_t al(size_t x) { return (x + 255) & ~(size_t)255; }
constexpr size_t OFF_BAR   = 0;
constexpr size_t OFF_CNT   = 16384;
constexpr size_t OFF_ROPE  = 32768;
constexpr size_t OFF_H32   = OFF_ROPE + al((size_t)SEQ * 16 * 8);
constexpr size_t OFF_H16   = OFF_H32 + al((size_t)T * D * 4);
constexpr size_t OFF_MEM16 = OFF_H16 + al((size_t)T * D * 2);
constexpr size_t OFF_KVMEM = OFF_MEM16 + al((size_t)1024 * 1024 * 2);
constexpr size_t OFF_XM    = OFF_KVMEM + al((size_t)4 * 1024 * 2048 * 2);
constexpr size_t OFF_XN    = OFF_XM + al((size_t)16 * 1024 * 1024 * 2);
constexpr size_t OFF_XUP   = OFF_XN + al((size_t)16 * 1024 * 1024 * 2);
constexpr size_t OFF_XCP   = OFF_XUP + al((size_t)16 * 1024 * 16 * 4);
constexpr size_t OFF_XU    = OFF_XCP + al((size_t)16 * 1024 * 16 * 4);
constexpr size_t OFF_XC    = OFF_XU + al((size_t)16 * 1024 * 4);
constexpr size_t W_ABIN    = OFF_XC + al((size_t)16 * 1024 * 4);
constexpr size_t W_W2T     = W_ABIN + al((size_t)2 * 2816 * 1024 * 2);
constexpr size_t W_A2T     = W_W2T + al((size_t)2 * 512 * 64 * 2);
constexpr size_t W_G2T     = W_A2T + al((size_t)2 * 512 * 64 * 2);
constexpr size_t W_SGW     = W_G2T + al((size_t)2 * 512 * 128 * 2);
constexpr size_t W_ABOUT   = W_SGW + al((size_t)2 * 4 * 128 * 128 * 2);
constexpr size_t W_MLAIN   = W_ABOUT + al((size_t)2 * 1024 * 1024 * 2);
constexpr size_t W_Q       = W_MLAIN + al((size_t)2 * 640 * 1024 * 2);
constexpr size_t W_KV      = W_Q + al((size_t)2 * 1536 * 256 * 2);
constexpr size_t W_MLAOUT  = W_KV + al((size_t)2 * 2048 * 256 * 2);
constexpr size_t W_XAQ     = W_MLAOUT + al((size_t)2 * 1024 * 1024 * 2);
constexpr size_t W_XAKV    = W_XAQ + al((size_t)4 * 1024 * 1024 * 2);
constexpr size_t W_XAO     = W_XAKV + al((size_t)4 * 2048 * 1024 * 2);
constexpr size_t W_ROUTER  = W_XAO + al((size_t)4 * 1024 * 1024 * 2);
constexpr size_t W_GU      = W_ROUTER + al((size_t)4 * 128 * 1024 * 2);
constexpr size_t W_D       = W_GU + al((size_t)4 * 32 * 1024 * 1024 * 2);
constexpr size_t OFF_SCR   = W_D + al((size_t)4 * 32 * 1024 * 512 * 2);
constexpr size_t S_P16   = OFF_SCR;
constexpr size_t S_PS16  = S_P16 + al((size_t)T * 2816 * 2);
constexpr size_t S_WD32  = S_PS16 + al((size_t)T * 1792 * 2);
constexpr size_t S_NKK   = S_WD32 + al((size_t)T * 512 * 4);
constexpr size_t S_BB    = S_NKK + al((size_t)T * 512 * 2);
constexpr size_t S_KP    = S_BB + al((size_t)T * 512 * 2);
constexpr size_t S_G16   = S_KP + al((size_t)T * 512 * 2);
constexpr size_t S_BSUM  = S_G16 + al((size_t)T * 512 * 2);
constexpr size_t S_Y32   = S_BSUM + al((size_t)T * 8 * 4);
constexpr size_t S_ZT    = S_Y32 + al((size_t)T * 512 * 4);
constexpr size_t S_MIX16 = S_ZT + al((size_t)512 * 128 * 128 * 2);
constexpr size_t S_YT    = S_MIX16 + al((size_t)T * 1024 * 2);
constexpr size_t S_SMID  = S_YT + al((size_t)T * 512 * 4);
constexpr size_t S_END_EVEN = S_SMID + al((size_t)32 * 64 * 64 * 4);
constexpr size_t S_CQKV  = OFF_SCR;
constexpr size_t S_KPE   = S_CQKV + al((size_t)T * 512 * 2);
constexpr size_t S_Q16   = S_KPE + al((size_t)T * 32 * 2);
constexpr size_t S_KN16  = S_Q16 + al((size_t)T * 1536 * 2);
constexpr size_t S_VT16  = S_KN16 + al((size_t)T * 1024 * 2);
constexpr size_t S_SSQ   = S_VT16 + al((size_t)T * 1024 * 2);
constexpr size_t S_END_ODD = S_SSQ + al((size_t)T * 8 * 4);
constexpr size_t S_XP16  = OFF_SCR;
constexpr size_t S_XLP   = S_XP16 + al((size_t)T * 1024 * 2);
constexpr size_t S_XSTAT = S_XLP + al((size_t)T * 16 * 4);
constexpr size_t S_PST1  = S_XSTAT + al((size_t)T * 2 * 4);
constexpr size_t S_LIST  = OFF_SCR;
constexpr size_t S_GATES = S_LIST + al((size_t)32 * 16384 * 4);
constexpr size_t S_HBUF  = S_GATES + al((size_t)T * 2 * 4);
constexpr size_t S_FF16  = S_HBUF + al((size_t)36864 * 512 * 2);
constexpr size_t S_END_MOE = S_FF16 + al((size_t)2 * T * 1024 * 2);
constexpr size_t S_Y32R  = OFF_SCR + (size_t)128 * 1024 * 1024;
static_assert(S_Y32R + (size_t)T * 1024 * 4 <= S_MIX16, "y32 overlay");
static_assert(S_END_ODD <= S_MIX16, "odd overlay");
static_assert(S_END_MOE <= S_MIX16, "moe overlay");
static_assert(S_END_EVEN <= (size_t)1024 * 1024 * 1024, "workspace");

constexpr int SMEM_MAIN = 65536;
constexpr int SMEM_BYTES = SMEM_MAIN + 2048;

struct Params {
    const float* in[41];
    float* out;
    char* ws;
    int ph_begin, ph_end;
};

__device__ __forceinline__ int opq_s(int x) { asm volatile("" : "+v"(x)); return __builtin_amdgcn_readfirstlane(x); }
__device__ __forceinline__ int opq_v(int x) { asm volatile("" : "+v"(x)); return x; }
#define TID opq_v((int)threadIdx.x)
#define BID opq_s((int)blockIdx.x)
#define NBLK opq_s((int)gridDim.x)
__device__ __forceinline__ const float* opq_p(const float* q) {
    const uint64_t u = (uint64_t)q; uint32_t lo = (uint32_t)u, hi = (uint32_t)(u >> 32);
    asm volatile("" : "+v"(lo), "+v"(hi));
    lo = __builtin_amdgcn_readfirstlane(lo); hi = __builtin_amdgcn_readfirstlane(hi);
    return (const float*)(((uint64_t)hi << 32) | lo);
}
typedef const __attribute__((address_space(4))) Params* KargPtr;
__device__ __forceinline__ KargPtr kparams() {
    const uint64_t u = (uint64_t)__builtin_amdgcn_kernarg_segment_ptr(); uint32_t lo = (uint32_t)u, hi = (uint32_t)(u >> 32);
    asm volatile("" : "+v"(lo), "+v"(hi));
    lo = __builtin_amdgcn_readfirstlane(lo); hi = __builtin_amdgcn_readfirstlane(hi);
    return (KargPtr)(((uint64_t)hi << 32) | lo);
}
#define IN(k) (kparams()->in[k])
#define WS (kparams()->ws)

__device__ __forceinline__ float sigmoid_(float x) { return 1.0f / (1.0f + __expf(-x)); }
__device__ __forceinline__ float tanh_(float x) { return 1.0f - 2.0f / (1.0f + __expf(2.0f * x)); }
__device__ __forceinline__ float gelu_(float x) { const float u = 0.7978845608028654f * (x + 0.044715f * x * x * x); return 0.5f * x * (1.0f + tanh_(u)); }
__device__ __forceinline__ float dpp_ror(float x, int) { return x; }
__device__ __forceinline__ float row16_sum(float x) {
    x += __builtin_bit_cast(float, __builtin_amdgcn_update_dpp(0, __builtin_bit_cast(int, x), 0x128, 0xf, 0xf, false));
    x += __builtin_bit_cast(float, __builtin_amdgcn_update_dpp(0, __builtin_bit_cast(int, x), 0x124, 0xf, 0xf, false));
    x += __builtin_bit_cast(float, __builtin_amdgcn_update_dpp(0, __builtin_bit_cast(int, x), 0x122, 0xf, 0xf, false));
    x += __builtin_bit_cast(float, __builtin_amdgcn_update_dpp(0, __builtin_bit_cast(int, x), 0x121, 0xf, 0xf, false));
    return x;
}
__device__ __forceinline__ float wave_sum(float x) {
    x += __shfl_xor(x, 32); x += __shfl_xor(x, 16); x += __shfl_xor(x, 8); x += __shfl_xor(x, 4); x += __shfl_xor(x, 2); x += __shfl_xor(x, 1);
    return x;
}
__device__ __forceinline__ f16x4 cvt4(f32x4 v) { return __builtin_convertvector(v, f16x4); }
__device__ __forceinline__ f32x4 cvt4f(f16x4 v) { return __builtin_convertvector(v, f32x4); }

#define BSYNC() do { asm volatile("s_waitcnt lgkmcnt(0)" ::: "memory"); __syncthreads(); } while (0)

#define XB_TMO      128
#define XB_XCNT(j)  (256  + 64 * (j))
#define XB_XSUB(j)  (1280 + 64 * (j))
#define XB_XGEN(j)  (2304 + 64 * (j))
#define XB_TOP      3328
#define XB_TOPGEN   3392
#define XCD_BAR_WORDS 3456
#define XB_SPIN_CAP (1u << 22)
__device__ __forceinline__ unsigned xb_ld(unsigned* p) { return __hip_atomic_load(p, __ATOMIC_RELAXED, __HIP_MEMORY_SCOPE_AGENT); }
__device__ __forceinline__ unsigned xb_add(unsigned* p, unsigned v) { return __hip_atomic_fetch_add(p, v, __ATOMIC_RELAXED, __HIP_MEMORY_SCOPE_AGENT); }
__device__ __forceinline__ unsigned xb_xcc_id() { return (unsigned)__builtin_amdgcn_s_getreg((3 << 11) | 20) & 0xFu; }
#define XB_SPIN(cond, bar) do { unsigned _sp = 0; while (cond) { __builtin_amdgcn_s_sleep(1); \
    if ((++_sp & 255u) == 0u) { if (xb_ld(&(bar)[XB_TMO])) break; if (_sp > XB_SPIN_CAP) { atomicAdd(&(bar)[XB_TMO], 1u); break; } } } } while (0)
struct XcdBarrier { unsigned* bar; unsigned x; volatile LAS unsigned* st; };
__device__ __forceinline__ XcdBarrier xcd_barrier_post(unsigned* bar, volatile LAS unsigned* st) {
    XcdBarrier b; b.bar = bar; b.x = xb_xcc_id(); b.st = st;
    if (threadIdx.x == 0) (void)xb_add(&bar[XB_XCNT(b.x)], 1u);
    return b;
}
__device__ __forceinline__ void xcd_barrier_complete(unsigned* bar, unsigned x, unsigned& nloc, unsigned& nx) {
    const unsigned G = gridDim.x;
    unsigned sum, cnt, mine, sp = 0u;
    for (;;) {
        sum = 0u; cnt = 0u; mine = 0u;
#pragma unroll
        for (unsigned j = 0; j < 16; ++j) { const unsigned c = xb_ld(&bar[XB_XCNT(j)]); sum += c; cnt += (c > 0u) ? 1u : 0u; mine = (j == x) ? c : mine; }
        if (sum == G) break;
        __builtin_amdgcn_s_sleep(1);
        if ((++sp & 255u) == 0u) { if (xb_ld(&bar[XB_TMO])) break; if (sp > XB_SPIN_CAP) { atomicAdd(&bar[XB_TMO], 1u); break; } }
    }
    nloc = mine > 0u ? mine : 1u; nx = cnt > 0u ? cnt : 1u;
}
__device__ __forceinline__ void xcd_barrier(const XcdBarrier& b) {
    asm volatile("s_waitcnt vmcnt(0)" ::: "memory");
    __syncthreads();
    if (threadIdx.x == 0) {
        unsigned* bar = b.bar;
        __builtin_amdgcn_s_waitcnt(0);
        unsigned nloc = b.st[0], nx = b.st[1];
        if (nloc == 0u) { xcd_barrier_complete(bar, b.x, nloc, nx); b.st[0] = nloc; b.st[1] = nx; }
        const unsigned old = xb_add(&bar[XB_XSUB(b.x)], 1u);
        const unsigned gen = old / nloc;
        if (old + 1u == (gen + 1u) * nloc) {
            __builtin_amdgcn_fence(__ATOMIC_RELEASE, "agent");
            asm volatile("s_waitcnt vmcnt(0)" ::: "memory");
            const unsigned og = xb_add(&bar[XB_TOP], 1u);
            const unsigned tg = og / nx;
            if (og + 1u == (tg + 1u) * nx) xb_add(&bar[XB_TOPGEN], 1u);
            else XB_SPIN(xb_ld(&bar[XB_TOPGEN]) == tg, bar);
            __builtin_amdgcn_fence(__ATOMIC_ACQUIRE, "agent");
            xb_add(&bar[XB_XGEN(b.x)], 1u);
            asm volatile("s_waitcnt vmcnt(0)" ::: "memory");
        } else {
            XB_SPIN(xb_ld(&bar[XB_XGEN(b.x)]) == gen, bar);
            __builtin_amdgcn_fence(__ATOMIC_ACQUIRE, "agent");
            asm volatile("s_waitcnt vmcnt(0)" ::: "memory");
        }
    }
    __syncthreads();
}

struct NoSeg { __device__ __forceinline__ void operator()(int, f32x4 (&)[4][4]) const {} };
template <bool TRANS, class XR, class WR, class SEG = NoSeg>
__device__ __forceinline__ void gemm_core(f32x4 (&acc)[4][4], XR xrow, WR wrow, const int nk, char* smem, SEG seg = SEG()) {
    const int tid = TID, lane = tid & 63, wid = tid >> 6, wr = wid >> 1, wc = wid & 1, fr = lane & 15, fq = lane >> 4;
#pragma unroll
    for (int m = 0; m < 4; ++m)
#pragma unroll
        for (int n = 0; n < 4; ++n) acc[m][n] = (f32x4){0.f, 0.f, 0.f, 0.f};
#if FAST_GEMM
    const int sc = ((tid & 7) ^ ((tid >> 4) & 7)) * 8;
    const f16* px[4]; const f16* pw[4];
#pragma unroll
    for (int i = 0; i < 4; ++i) { px[i] = xrow((tid >> 3) + 32 * i) + sc; pw[i] = wrow((tid >> 3) + 32 * i) + sc; }
    const int rd0 = ((0 * 4 + fq) ^ (fr >> 1)) * 16, rd1 = ((1 * 4 + fq) ^ (fr >> 1)) * 16;
    const int xoff = (wr * 64 + fr) * 128, woff = 16384 + (wc * 64 + fr) * 128;
    BSYNC();
    auto stage = [&](int kt, int s) {
        char* base = smem + s * 32768 + tid * 16;
#pragma unroll
        for (int i = 0; i < 4; ++i) {
            __builtin_amdgcn_global_load_lds((const void*)(px[i] + kt * 64), (LAS void*)(base + i * 4096), 16, 0, 0);
            __builtin_amdgcn_global_load_lds((const void*)(pw[i] + kt * 64), (LAS void*)(base + 16384 + i * 4096), 16, 0, 0);
        }
    };
    stage(0, 0);
    for (int kt = 0; kt < nk; ++kt) {
        const int s = kt & 1;
        asm volatile("s_waitcnt vmcnt(0)" ::: "memory");
        BSYNC();
        if (kt + 1 < nk) stage(kt + 1, s ^ 1);
        seg(kt, acc);
        const char* bs = smem + s * 32768;
#pragma unroll
        for (int kk = 0; kk < 2; ++kk) {
            const int rd = kk ? rd1 : rd0;
            f16x8 xf[4], wf[4];
#pragma unroll
            for (int m = 0; m < 4; ++m) xf[m] = *(const f16x8*)(bs + xoff + m * 2048 + rd);
#pragma unroll
            for (int n = 0; n < 4; ++n) wf[n] = *(const f16x8*)(bs + woff + n * 2048 + rd);
#pragma unroll
            for (int m = 0; m < 4; ++m)
#pragma unroll
                for (int n = 0; n < 4; ++n)
                    acc[m][n] = TRANS ? __builtin_amdgcn_mfma_f32_16x16x32_f16(wf[n], xf[m], acc[m][n], 0, 0, 0)
                                      : __builtin_amdgcn_mfma_f32_16x16x32_f16(xf[m], wf[n], acc[m][n], 0, 0, 0);
        }
    }
#else
    float* ctile = (float*)smem;
    BSYNC();
    for (int i = 0; i < 64; ++i) {
        const int idx = tid + 256 * i, r = idx >> 7, c = idx & 127;
        const f16* xp = xrow(r); const f16* wp = wrow(c);
        float s = 0.f;
        for (int k = 0; k < nk * 64; k += 8) {
            const f16x8 a = *(const f16x8*)(xp + k), b = *(const f16x8*)(wp + k);
#pragma unroll
            for (int e = 0; e < 8; ++e) s += (float)a[e] * (float)b[e];
        }
        ctile[idx] = s;
    }
    BSYNC();
#pragma unroll
    for (int m = 0; m < 4; ++m)
#pragma unroll
        for (int n = 0; n < 4; ++n)
#pragma unroll
            for (int j = 0; j < 4; ++j)
                acc[m][n][j] = TRANS ? ctile[(wr * 64 + m * 16 + fr) * 128 + wc * 64 + n * 16 + 4 * fq + j] : ctile[(wr * 64 + m * 16 + 4 * fq + j) * 128 + wc * 64 + n * 16 + fr];
    BSYNC();
#endif
}

template <class TR> __device__ __forceinline__ void row_stats_table(const float* pst, TR tokrow, float* srow) {
    const int tid = TID;
    float su = 0.f, sq = 0.f;
    if (tid < 128) {
        const float* ps = pst + (size_t)tokrow(tid) * 32;
#pragma unroll
        for (int i = 0; i < 8; ++i) { const f32x4 v = *(const f32x4*)(ps + i * 4); su += v[0] + v[2]; sq += v[1] + v[3]; }
    }
    BSYNC();
    if (tid < 128) {
        const float mean = su * (1.0f / 1024.0f), var = fmaxf(sq * (1.0f / 1024.0f) - mean * mean, 0.f);
        srow[tid * 2] = mean; srow[tid * 2 + 1] = rsqrtf(var + 1e-5f);
    }
}

struct GPipe { int staged, b0; };
template <bool TRANS, class XP, class WP, class SEG = NoSeg>
__device__ __forceinline__ void gemm_core_pf(f32x4 (&acc)[4][4], XP xp, WP wp, int rt, int ct, const int nk, bool has_next, int nrt, int nct, GPipe& gp,
                                             char* smem, SEG seg = SEG()) {
    const int tid = TID, lane = tid & 63, wid = tid >> 6, wr = wid >> 1, wc = wid & 1, fr = lane & 15, fq = lane >> 4;
#pragma unroll
    for (int m = 0; m < 4; ++m)
#pragma unroll
        for (int n = 0; n < 4; ++n) acc[m][n] = (f32x4){0.f, 0.f, 0.f, 0.f};
    const int sc = ((tid & 7) ^ ((tid >> 4) & 7)) * 8;
    const f16* px[4]; const f16* pw[4];
#pragma unroll
    for (int i = 0; i < 4; ++i) { px[i] = xp(rt, ct, (tid >> 3) + 32 * i) + sc; pw[i] = wp(rt, ct, (tid >> 3) + 32 * i) + sc; }
    const int rd0 = ((0 * 4 + fq) ^ (fr >> 1)) * 16, rd1 = ((1 * 4 + fq) ^ (fr >> 1)) * 16;
    const int xoff = (wr * 64 + fr) * 128, woff = 16384 + (wc * 64 + fr) * 128;
    auto stage = [&](int kt, int s) {
        char* base = smem + s * 32768 + tid * 16;
#pragma unroll
        for (int i = 0; i < 4; ++i) {
            __builtin_amdgcn_global_load_lds((const void*)(px[i] + kt * 64), (LAS void*)(base + i * 4096), 16, 0, 0);
            __builtin_amdgcn_global_load_lds((const void*)(pw[i] + kt * 64), (LAS void*)(base + 16384 + i * 4096), 16, 0, 0);
        }
    };
    if (!gp.staged) { BSYNC(); gp.b0 = 0; stage(0, 0); }
    const int b0 = gp.b0;
    for (int kt = 0; kt < nk; ++kt) {
        const int s = (kt + b0) & 1;
        asm volatile("s_waitcnt vmcnt(0)" ::: "memory");
        BSYNC();
        if (kt + 1 < nk) stage(kt + 1, s ^ 1);
        else if (has_next) {
            char* base = smem + (s ^ 1) * 32768 + tid * 16;
#pragma unroll
            for (int i = 0; i < 4; ++i) {
                __builtin_amdgcn_global_load_lds((const void*)(xp(nrt, nct, (tid >> 3) + 32 * i) + sc), (LAS void*)(base + i * 4096), 16, 0, 0);
                __builtin_amdgcn_global_load_lds((const void*)(wp(nrt, nct, (tid >> 3) + 32 * i) + sc), (LAS void*)(base + 16384 + i * 4096), 16, 0, 0);
            }
        }
        seg(kt, acc);
        const char* bs = smem + s * 32768;
#pragma unroll
        for (int kk = 0; kk < 2; ++kk) {
            const int rd = kk ? rd1 : rd0;
            f16x8 xf[4], wf[4];
#pragma unroll
            for (int m = 0; m < 4; ++m) xf[m] = *(const f16x8*)(bs + xoff + m * 2048 + rd);
#pragma unroll
            for (int n = 0; n < 4; ++n) wf[n] = *(const f16x8*)(bs + woff + n * 2048 + rd);
#pragma unroll
            for (int m = 0; m < 4; ++m)
#pragma unroll
                for (int n = 0; n < 4; ++n)
                    acc[m][n] = TRANS ? __builtin_amdgcn_mfma_f32_16x16x32_f16(wf[n], xf[m], acc[m][n], 0, 0, 0)
                                      : __builtin_amdgcn_mfma_f32_16x16x32_f16(xf[m], wf[n], acc[m][n], 0, 0, 0);
        }
    }
    gp.staged = has_next ? 1 : 0; gp.b0 = ((nk - 1 + b0) & 1) ^ 1;
}

template <class F> __device__ __forceinline__ void tile_loop2(int nrt, int nct, F f) {
    const int xcd = BID & 7, lb = BID >> 3, nlb = NBLK >> 3;
    const int per = (nrt >> 3) * nct;
    for (int j = lb; j < per; j += nlb) {
        const int jn = j + nlb; const bool hn = jn < per; const int je = hn ? jn : j;
        f(((j / nct) << 3) + xcd, j % nct, hn, ((je / nct) << 3) + xcd, je % nct);
    }
}

template <class F> __device__ __forceinline__ void tile_loop(int nrt, int nct, F f) {
    const int xcd = BID & 7, lb = BID >> 3, nlb = NBLK >> 3;
    const int per = (nrt >> 3) * nct;
    for (int j = lb; j < per; j += nlb) f(((j / nct) << 3) + xcd, j % nct);
}

#define WAVE_IDS const int tid = TID, lane = tid & 63, wid = tid >> 6, wr = wid >> 1, wc = wid & 1, fr = lane & 15, fq = lane >> 4; (void)lane; (void)wid; (void)wr; (void)wc; (void)fr; (void)fq;

template <class RowMap, class KScale>
__device__ __forceinline__ void conv_T(const float* src, f16* dst, int nbatch, int K, int N, size_t src_bs, size_t dst_bs, int ldd, RowMap rowmap, KScale kscale, int& off, float* tile, int myid, int G) {
    const int tk = K / 64, tn = (N + 63) / 64, total = nbatch * tk * tn, t = TID;
    int start = (myid - off) % G; if (start < 0) start += G;
    auto load = [&](int i, f32x4 (&v)[4]) {
        const int bi = i / (tk * tn), r = i % (tk * tn), k0 = (r / tn) * 64, n0 = (r % tn) * 64;
#pragma unroll
        for (int j = 0; j < 4; ++j) {
            const int k = (t >> 4) + 16 * j, c = (t & 15) * 4;
            v[j] = (f32x4){0.f, 0.f, 0.f, 0.f};
            if (i < total && n0 + c < N) v[j] = *(const f32x4*)(src + (size_t)bi * src_bs + (size_t)(k0 + k) * N + n0 + c);
        }
    };
    f32x4 va[4], vb[4];
    load(start, va); load(start + G, vb);
    for (int i = start; i < total; i += G) {
        const int bi = i / (tk * tn), r = i % (tk * tn), k0 = (r / tn) * 64, n0 = (r % tn) * 64;
        BSYNC();
#pragma unroll
        for (int j = 0; j < 4; ++j) {
            const int k = (t >> 4) + 16 * j, c = (t & 15) * 4;
            const float s = kscale(k0 + k);
            tile[k * 65 + c + 0] = va[j][0] * s; tile[k * 65 + c + 1] = va[j][1] * s; tile[k * 65 + c + 2] = va[j][2] * s; tile[k * 65 + c + 3] = va[j][3] * s;
        }
#pragma unroll
        for (int j = 0; j < 4; ++j) va[j] = vb[j];
        load(i + 2 * G, vb);
        BSYNC();
        const int n = t >> 2, kc = (t & 3) * 16;
        if (n0 + n < N) {
            f16x8 o0, o1;
#pragma unroll
            for (int j = 0; j < 8; ++j) { o0[j] = (f16)tile[(kc + j) * 65 + n]; o1[j] = (f16)tile[(kc + 8 + j) * 65 + n]; }
            f16* dp = dst + (size_t)bi * dst_bs + (size_t)rowmap(n0 + n) * ldd + k0 + kc;
            *(f16x8*)dp = o0; *(f16x8*)(dp + 8) = o1;
        }
    }
    off = (off + total) % G;
}

__device__ __forceinline__ void phase_convert(const Params& p, char* smem) {
    char* ws = WS;
    float* tile = (float*)smem;
    const int gtid = BID * 256 + TID, gsz = NBLK * 256;
    int off = 0;
    const int cb = BID, cn = NBLK;
    auto ident = [](int n) { return n; };
    auto one = [](int) { return 1.0f; };
    {
        const float* x = IN(0); f16* h16 = (f16*)(ws + OFF_H16);
        for (size_t i = gtid; i < (size_t)T * D / 4; i += gsz) *(f16x4*)(h16 + i * 4) = cvt4(*(const f32x4*)(x + i * 4));
        const float* mem = IN(1); f16* m16 = (f16*)(ws + OFF_MEM16);
        for (size_t i = gtid; i < (size_t)1024 * 1024 / 4; i += gsz) *(f16x4*)(m16 + i * 4) = cvt4(*(const f32x4*)(mem + i * 4));
    }
    {
        const float* w = IN(16); f16* o = (f16*)(ws + W_SGW);
        for (int i = gtid; i < 2 * 4 * 128 * 128; i += gsz) { const int s = i & 127, tt = (i >> 7) & 127; o[i] = (s <= tt) ? (f16)w[i] : (f16)0.f; }
    }
    {
        f32x2* rt = (f32x2*)(ws + OFF_ROPE);
        for (int i = gtid; i < SEQ * 16; i += gsz) {
            const int pos = i >> 4, fi = i & 15;
            const double inv = exp2(-(double)fi * (13.287712379549449 / 16.0));
            double rev = (double)pos * inv * 0.15915494309189535;
            rev -= floor(rev);
            const float fr_ = (float)rev;
            rt[i] = (f32x2){__builtin_amdgcn_cosf(fr_), __builtin_amdgcn_sinf(fr_)};
        }
    }
    {
        unsigned* cnt = (unsigned*)(ws + OFF_CNT);
        if (gtid < 128) cnt[gtid] = 0u;
        f16* wr_ = (f16*)(ws + W_ROUTER);
        for (int i = gtid; i < 4 * 92 * 1024; i += gsz) { const int l = i / (92 * 1024), r = i % (92 * 1024); wr_[(size_t)l * 128 * 1024 + 36 * 1024 + r] = (f16)0.f; }
        f16* wm = (f16*)(ws + W_MLAIN);
        for (int i = gtid; i < 2 * 96 * 1024; i += gsz) { const int l = i / (96 * 1024), r = i % (96 * 1024); wm[(size_t)l * 640 * 1024 + 544 * 1024 + r] = (f16)0.f; }
    }
    conv_T(IN(2), (f16*)(ws + W_ABIN), 2, 1024, 2816, (size_t)1024 * 2816, (size_t)2816 * 1024, 1024, ident, one, off, tile, cb, cn);
    conv_T(IN(5), (f16*)(ws + W_W2T), 2, 64, 512, (size_t)64 * 512, (size_t)512 * 64, 64, ident, one, off, tile, cb, cn);
    conv_T(IN(7), (f16*)(ws + W_A2T), 2, 64, 512, (size_t)64 * 512, (size_t)512 * 64, 64, ident, one, off, tile, cb, cn);
    conv_T(IN(8), (f16*)(ws + W_G2T), 2, 128, 512, (size_t)128 * 512, (size_t)512 * 128, 128, ident, one, off, tile, cb, cn);
    conv_T(IN(18), (f16*)(ws + W_ABOUT), 2, 1024, 1024, (size_t)1024 * 1024, (size_t)1024 * 1024, 1024, ident, one, off, tile, cb, cn);
    conv_T(IN(19), (f16*)(ws + W_MLAIN), 2, 1024, 544, (size_t)1024 * 544, (size_t)640 * 1024, 1024, ident, one, off, tile, cb, cn);
    for (int l = 0; l < 2; ++l) {
        const float* qn = IN(20) + l * 256; const float* kvn = IN(21) + l * 256;
        const float qs = 0.10206207261596577f * LOG2E;
        conv_T(IN(22) + (size_t)l * 256 * 1536, (f16*)(ws + W_Q) + (size_t)l * 1536 * 256, 1, 256, 1536, 0, 0, 256, ident, [=](int k) { return qn[k] * qs; }, off, tile, cb, cn);
        conv_T(IN(23) + (size_t)l * 256 * 2048, (f16*)(ws + W_KV) + (size_t)l * 2048 * 256, 1, 256, 2048, 0, 0, 256,
               [](int n) { const int h = n >> 7, j = n & 127; return j < 64 ? h * 64 + j : 1024 + h * 64 + (j - 64); }, [=](int k) { return kvn[k]; }, off, tile, cb, cn);
    }
    conv_T(IN(24), (f16*)(ws + W_MLAOUT), 2, 1024, 1024, (size_t)1024 * 1024, (size_t)1024 * 1024, 1024, ident, one, off, tile, cb, cn);
    {
        const float* w = IN(27); f16* o = (f16*)(ws + W_XAQ); const float sc = 0.0625f * LOG2E;
        for (size_t i = gtid; i < (size_t)4 * 1024 * 1024 / 4; i += gsz) *(f16x4*)(o + i * 4) = cvt4(*(const f32x4*)(w + i * 4) * sc);
    }
    conv_T(IN(28), (f16*)(ws + W_XAKV), 4, 1024, 2048, (size_t)1024 * 2048, (size_t)2048 * 1024, 1024, ident, one, off, tile, cb, cn);
    conv_T(IN(29), (f16*)(ws + W_XAO), 4, 1024, 1024, (size_t)1024 * 1024, (size_t)1024 * 1024, 1024, ident, one, off, tile, cb, cn);
    conv_T(IN(32), (f16*)(ws + W_ROUTER), 4, 1024, 4, (size_t)1024 * 4, (size_t)128 * 1024, 1024, ident, one, off, tile, cb, cn);
    conv_T(IN(34), (f16*)(ws + W_ROUTER), 4, 1024, 32, (size_t)1024 * 32, (size_t)128 * 1024, 1024, [](int n) { return n + 4; }, one, off, tile, cb, cn);
}

__device__ __forceinline__ void convert_moe(const Params& p, char* smem, int cb, int cn, int part) {
    char* ws = WS;
    float* tile = (float*)smem;
    int off = 0;
    auto ident = [](int n) { return n; };
    auto one = [](int) { return 1.0f; };
    const int b0 = part ? 96 : 0, nbt = part ? 32 : 96;
    conv_T(IN(36) + (size_t)b0 * 1024 * 512, (f16*)(ws + W_GU) + (size_t)b0 * 1024 * 1024, nbt, 1024, 512, (size_t)1024 * 512, (size_t)1024 * 1024, 1024,
           [](int n) { return (n >> 6) * 128 + ((n >> 5) & 1) * 64 + (n & 31); }, one, off, tile, cb, cn);
    conv_T(IN(37) + (size_t)b0 * 1024 * 512, (f16*)(ws + W_GU) + (size_t)b0 * 1024 * 1024, nbt, 1024, 512, (size_t)1024 * 512, (size_t)1024 * 1024, 1024,
           [](int n) { return (n >> 6) * 128 + ((n >> 5) & 1) * 64 + 32 + (n & 31); }, one, off, tile, cb, cn);
    if (part) return;
    conv_T(IN(38), (f16*)(ws + W_D), 128, 512, 1024, (size_t)512 * 1024, (size_t)1024 * 512, 512, ident, one, off, tile, cb, cn);
}

template <int MODE>
__device__ __forceinline__ void phase_ln(const f16* src, const f16* ff0, const f16* ff1, const float* gp, const float* bp, const float* g, const float* b,
                                         float* dst32, f16* dst16, float* stat) {
    const int lane = TID & 63, gw = BID * 4 + (TID >> 6), nw = NBLK * 4;
    for (int row = gw; row < T; row += nw) {
        f32x4 v[4]; float s = 0.f;
#pragma unroll
        for (int i = 0; i < 4; ++i) {
            v[i] = cvt4f(*(const f16x4*)(src + (size_t)row * D + i * 256 + lane * 4));
            s += (v[i][0] + v[i][1]) + (v[i][2] + v[i][3]);
        }
        float mean = wave_sum(s) * (1.0f / 1024.0f);
        float q = 0.f;
#pragma unroll
        for (int i = 0; i < 4; ++i) { const f32x4 d = v[i] - mean; q += (d[0] * d[0] + d[1] * d[1]) + (d[2] * d[2] + d[3] * d[3]); }
        float rstd = rsqrtf(wave_sum(q) * (1.0f / 1024.0f) + 1e-5f);
        if (MODE == 1) {
            s = 0.f;
#pragma unroll
            for (int i = 0; i < 4; ++i) {
                const int c = i * 256 + lane * 4; const size_t o = (size_t)row * D + c;
                const f32x4 h2 = (v[i] - mean) * rstd * *(const f32x4*)(gp + c) + *(const f32x4*)(bp + c);
                v[i] = h2 * DN_ALPHA + cvt4f(*(const f16x4*)(ff0 + o)) + cvt4f(*(const f16x4*)(ff1 + o));
                s += (v[i][0] + v[i][1]) + (v[i][2] + v[i][3]);
            }
            mean = wave_sum(s) * (1.0f / 1024.0f);
            q = 0.f;
#pragma unroll
            for (int i = 0; i < 4; ++i) { const f32x4 d = v[i] - mean; q += (d[0] * d[0] + d[1] * d[1]) + (d[2] * d[2] + d[3] * d[3]); }
            rstd = rsqrtf(wave_sum(q) * (1.0f / 1024.0f) + 1e-5f);
        }
        if (MODE == 0 && lane == 0) *(f32x2*)(stat + (size_t)row * 2) = (f32x2){mean, rstd};
#pragma unroll
        for (int i = 0; i < 4; ++i) {
            const int c = i * 256 + lane * 4; const size_t o = (size_t)row * D + c;
            const f32x4 y = (v[i] - mean) * rstd * *(const f32x4*)(g + c) + *(const f32x4*)(b + c);
            if (MODE == 1 && dst32) *(f32x4*)(dst32 + o) = y;
            if (dst16) *(f16x4*)(dst16 + o) = cvt4(y);
        }
    }
}

__device__ __forceinline__ void phase_gemm_res(const f16* X, const f16* Wt, const float* res32, const f16* res16, f16* y16, float* pst, char* smem) {
    WAVE_IDS
    GPipe gp{0, 0};
    tile_loop2(128, 8, [&](int rt, int ct, bool hn, int nrt, int nct) {
        float su[4] = {0.f, 0.f, 0.f, 0.f}, sq[4] = {0.f, 0.f, 0.f, 0.f};
        f32x4 acc[4][4];
        gemm_core_pf<true>(acc, [&](int a, int, int r) { return X + (size_t)(a * 128 + r) * 1024; }, [&](int, int c, int r) { return Wt + (size_t)(c * 128 + r) * 1024; },
                           rt, ct, 16, hn, nrt, nct, gp, smem);
#pragma unroll
        for (int m = 0; m < 4; ++m)
#pragma unroll
            for (int n = 0; n < 4; ++n) {
                const size_t o = (size_t)(rt * 128 + wr * 64 + m * 16 + fr) * 1024 + ct * 128 + wc * 64 + n * 16 + 4 * fq;
                const f32x4 r4 = res32 ? *(const f32x4*)(res32 + o) : cvt4f(*(const f16x4*)(res16 + o));
                const f16x4 y4 = cvt4(r4 * DN_ALPHA + acc[m][n]);
                *(f16x4*)(y16 + o) = y4;
                const f32x4 yr = cvt4f(y4);
                su[m] += (yr[0] + yr[1]) + (yr[2] + yr[3]); sq[m] += (yr[0] * yr[0] + yr[1] * yr[1]) + (yr[2] * yr[2] + yr[3] * yr[3]);
            }
#pragma unroll
        for (int m = 0; m < 4; ++m) {
            float a = su[m], q = sq[m];
            a += __shfl_xor(a, 16); a += __shfl_xor(a, 32); q += __shfl_xor(q, 16); q += __shfl_xor(q, 32);
            if (fq == 0) *(f32x2*)(pst + ((size_t)(rt * 128 + wr * 64 + m * 16 + fr) * 16 + ct * 2 + wc) * 2) = (f32x2){a, q};
        }
    });
}

__device__ __forceinline__ void phase_xa_out(const Params& p, int L, f16* y16, char* smem) {
    WAVE_IDS
    const f16* XP = (const f16*)(WS + S_XP16); const float* LP = (const float*)(WS + S_XLP); const float* PST = (const float*)(WS + S_PST1);
    const float* g1 = IN(25) + L * 1024; const float* b1 = IN(26) + L * 1024;
    float* srow = (float*)(smem + SMEM_MAIN + 1024);
    GPipe gp{0, 0};
    const f16* XNb = (const f16*)(WS + OFF_XN) + (size_t)(L * 4) * 1024 * 1024;
    tile_loop2(128, 8, [&](int rt, int ct, bool hn, int nrt, int nct) {
        row_stats_table(PST, [&](int r) { return rt * 128 + r; }, srow);
        float ratio[4][4];
#pragma unroll
        for (int m = 0; m < 4; ++m) {
            const float* lp = LP + (size_t)(rt * 128 + wr * 64 + m * 16 + fr) * 16;
            float l[4];
#pragma unroll
            for (int h = 0; h < 4; ++h) { const f32x4 v = *(const f32x4*)(lp + 4 * h); l[h] = (v[0] + v[1]) + (v[2] + v[3]); }
            ratio[m][0] = l[1] / l[0]; ratio[m][1] = l[2] / l[1]; ratio[m][2] = l[3] / l[2]; ratio[m][3] = 1.0f / l[3];
        }
        f32x4 acc[4][4];
        gemm_core_pf<true>(acc, [&](int a, int, int r) { return XP + (size_t)(a * 128 + r) * 1024; },
            [&](int a, int c, int r) { return XNb + (size_t)(a >> 5) * 1024 * 1024 + (size_t)(c * 128 + r) * 1024; }, rt, ct, 16, hn, nrt, nct, gp, smem,
            [&](int kt, f32x4 (&a)[4][4]) {
                if (kt == 4 || kt == 8 || kt == 12) {
#pragma unroll
                    for (int m = 0; m < 4; ++m) {
                        const float sc = kt == 4 ? ratio[m][0] : (kt == 8 ? ratio[m][1] : ratio[m][2]);
#pragma unroll
                        for (int n = 0; n < 4; ++n) a[m][n] = a[m][n] * sc;
                    }
                }
            });
        f32x4 gv[4], bv[4];
#pragma unroll
        for (int n = 0; n < 4; ++n) { const int c = ct * 128 + wc * 64 + n * 16 + 4 * fq; gv[n] = *(const f32x4*)(g1 + c); bv[n] = *(const f32x4*)(b1 + c); }
#pragma unroll
        for (int m = 0; m < 4; ++m) {
            const int row = rt * 128 + wr * 64 + m * 16 + fr;
            const f32x2 st = *(const f32x2*)(srow + (wr * 64 + m * 16 + fr) * 2);
#pragma unroll
            for (int n = 0; n < 4; ++n) {
                const size_t o = (size_t)row * 1024 + ct * 128 + wc * 64 + n * 16 + 4 * fq;
                const f32x4 hres = (cvt4f(*(const f16x4*)(y16 + o)) - st[0]) * st[1] * gv[n] + bv[n];
                *(f16x4*)(y16 + o) = cvt4(hres * DN_ALPHA + acc[m][n] * ratio[m][3]);
            }
        }
    });
}

__device__ __forceinline__ void phase_memkv(const Params& p, char* smem) {
    WAVE_IDS
    const f16* mem16 = (const f16*)(WS + OFF_MEM16);
    for (int item = BID; item < 4 * 8 * 16; item += NBLK) {
        const int L = item >> 7, rt = (item >> 4) & 7, ct = item & 15;
        const f16* Wt = (const f16*)(WS + W_XAKV) + (size_t)L * 2048 * 1024;
        f16* kv = (f16*)(WS + OFF_KVMEM) + (size_t)L * 1024 * 2048;
        f32x4 acc[4][4];
        gemm_core<true>(acc, [&](int r) { return mem16 + (size_t)(rt * 128 + r) * 1024; }, [&](int r) { return Wt + (size_t)(ct * 128 + r) * 1024; }, 16, smem);
#pragma unroll
        for (int m = 0; m < 4; ++m)
#pragma unroll
            for (int n = 0; n < 4; ++n)
                *(f16x4*)(kv + (size_t)(rt * 128 + wr * 64 + m * 16 + fr) * 2048 + ct * 128 + wc * 64 + n * 16 + 4 * fq) = cvt4(acc[m][n]);
    }
}

__device__ __forceinline__ void xa_pre_item(const Params& p, int item, char* smem) {
    WAVE_IDS
    const int ct = item & 7, rt = (item >> 3) & 7, which = (item >> 6) & 1, b = (item >> 7) & 3, L = item >> 9;
    const f16* kv = (const f16*)(WS + OFF_KVMEM) + (size_t)L * 1024 * 2048;
    f32x4 acc[4][4];
    f16* out;
    if (which == 0) {
        const int hd = rt >> 1, key0 = (rt & 1) * 128;
        const f16* wq = (const f16*)(WS + W_XAQ) + (size_t)L * 1024 * 1024;
        gemm_core<true>(acc, [&](int r) { return kv + (size_t)(b * 256 + key0 + r) * 2048 + hd * 256; }, [&](int r) { return wq + (size_t)(ct * 128 + r) * 1024 + hd * 256; }, 4, smem);
        out = (f16*)(WS + OFF_XM) + (size_t)(L * 4 + b) * 1024 * 1024;
    } else {
        const int hd = ct >> 1, key0 = (ct & 1) * 128;
        const f16* wo = (const f16*)(WS + W_XAO) + (size_t)L * 1024 * 1024;
        gemm_core<true>(acc, [&](int r) { return wo + (size_t)(rt * 128 + r) * 1024 + hd * 256; }, [&](int r) { return kv + (size_t)(b * 256 + key0 + r) * 2048 + 1024 + hd * 256; }, 4, smem);
        out = (f16*)(WS + OFF_XN) + (size_t)(L * 4 + b) * 1024 * 1024;
    }
    if (which == 0) {
        const float* g1 = IN(25) + L * 1024; const float* b1 = IN(26) + L * 1024;
        float* up = (float*)(WS + OFF_XUP) + (size_t)(L * 4 + b) * 1024 * 16; float* cp = (float*)(WS + OFF_XCP) + (size_t)(L * 4 + b) * 1024 * 16;
#pragma unroll
        for (int m = 0; m < 4; ++m) {
            const int row = rt * 128 + wr * 64 + m * 16 + fr;
            float us = 0.f, cs = 0.f;
#pragma unroll
            for (int n = 0; n < 4; ++n) {
                const int k = ct * 128 + wc * 64 + n * 16 + 4 * fq;
                const f16x4 xm = cvt4(acc[m][n] * *(const f32x4*)(g1 + k));
                *(f16x4*)(out + (size_t)row * 1024 + k) = xm;
                const f32x4 xr = cvt4f(xm), cb = acc[m][n] * *(const f32x4*)(b1 + k);
                us += (xr[0] + xr[1]) + (xr[2] + xr[3]); cs += (cb[0] + cb[1]) + (cb[2] + cb[3]);
            }
            us += __shfl_xor(us, 16); us += __shfl_xor(us, 32); cs += __shfl_xor(cs, 16); cs += __shfl_xor(cs, 32);
            if (fq == 0) { up[(size_t)row * 16 + ct * 2 + wc] = us; cp[(size_t)row * 16 + ct * 2 + wc] = cs; }
        }
        return;
    }
#pragma unroll
    for (int m = 0; m < 4; ++m)
#pragma unroll
        for (int n = 0; n < 4; ++n)
            *(f16x4*)(out + (size_t)(rt * 128 + wr * 64 + m * 16 + fr) * 1024 + ct * 128 + wc * 64 + n * 16 + 4 * fq) = cvt4(acc[m][n]);
}

__device__ __forceinline__ void xa_uc_reduce(const Params& p) {
    const float* up = (const float*)(WS + OFF_XUP); const float* cp = (const float*)(WS + OFF_XCP);
    float* xu = (float*)(WS + OFF_XU); float* xc = (float*)(WS + OFF_XC);
    for (int i = BID * 256 + TID; i < 16 * 1024; i += NBLK * 256) {
        float a = 0.f, c = 0.f;
#pragma unroll
        for (int q4 = 0; q4 < 4; ++q4) { const f32x4 v = *(const f32x4*)(up + (size_t)i * 16 + q4 * 4), w = *(const f32x4*)(cp + (size_t)i * 16 + q4 * 4); a += (v[0] + v[1]) + (v[2] + v[3]); c += (w[0] + w[1]) + (w[2] + w[3]); }
        xu[i] = a; xc[i] = c;
    }
}

__device__ __forceinline__ void phase_ab_in(const Params& p, int j, char* smem) {
    WAVE_IDS
    const f16* X = (const f16*)(WS + OFF_H16);
    const f16* Wt = (const f16*)(WS + W_ABIN) + (size_t)j * 2816 * 1024;
    f16* P = (f16*)(WS + S_P16);
    GPipe gp{0, 0};
    tile_loop2(128, 22, [&](int rt, int ct, bool hn, int nrt, int nct) {
        f32x4 acc[4][4];
        gemm_core_pf<true>(acc, [&](int a, int, int r) { return X + (size_t)(a * 128 + r) * 1024; }, [&](int, int c, int r) { return Wt + (size_t)(c * 128 + r) * 1024; },
                           rt, ct, 16, hn, nrt, nct, gp, smem);
#pragma unroll
        for (int m = 0; m < 4; ++m)
#pragma unroll
            for (int n = 0; n < 4; ++n)
                *(f16x4*)(P + (size_t)(rt * 128 + wr * 64 + m * 16 + fr) * 2816 + ct * 128 + wc * 64 + n * 16 + 4 * fq) = cvt4(acc[m][n]);
    });
}

__device__ __forceinline__ void phase_shift(const Params& p, int j) {
    const f16* P = (const f16*)(WS + S_P16); f16* PS = (f16*)(WS + S_PS16);
    const float* mu = IN(3) + j * 1792;
    const int total = T * 224;
    for (int i = BID * 256 + TID; i < total; i += NBLK * 256) {
        const int t = i / 224, c = (i % 224) * 8;
        const f16x8 cur = *(const f16x8*)(P + (size_t)t * 2816 + c);
        f16x8 prv; for (int e = 0; e < 8; ++e) prv[e] = (f16)0.f;
        if ((t & (SEQ - 1)) != 0) prv = *(const f16x8*)(P + (size_t)(t - 1) * 2816 + c);
        f16x8 o;
        const f32x4 mu0 = *(const f32x4*)(mu + c), mu1 = *(const f32x4*)(mu + c + 4);
#pragma unroll
        for (int e = 0; e < 8; ++e) {
            const float a = (float)cur[e]; float v = a + ((float)prv[e] - a) * (e < 4 ? mu0[e & 3] : mu1[e & 3]);
            if (c >= 1536 && c < 1600) v = tanh_(v);
            else if (c >= 1664) v = sigmoid_(v);
            o[e] = (f16)v;
        }
        *(f16x8*)(PS + (size_t)t * 1792 + c) = o;
    }
}

__device__ __forceinline__ void phase_lora(const Params& p, int j, char* smem) {
    WAVE_IDS
    const f16* PS = (const f16*)(WS + S_PS16);
    float* WD = (float*)(WS + S_WD32); f16* NKK = (f16*)(WS + S_NKK); f16* BB = (f16*)(WS + S_BB); f16* KP = (f16*)(WS + S_KP);
    f16* G16 = (f16*)(WS + S_G16); float* BSUM = (float*)(WS + S_BSUM);
    const float* w0 = IN(4) + j * 512; const float* a0 = IN(6) + j * 512; const float* k_k = IN(9) + j * 512; const float* k_a = IN(10) + j * 512; const float* r_k = IN(11) + j * 512;
    GPipe gp{0, 0};
    const f16* Wl0 = (const f16*)(WS + W_W2T) + (size_t)j * 512 * 64; const f16* Wl1 = (const f16*)(WS + W_A2T) + (size_t)j * 512 * 64;
    const f16* Wl2 = (const f16*)(WS + W_G2T) + (size_t)j * 512 * 128;
    tile_loop2(128, 12, [&](int rt, int ct, bool hn, int nrt, int nct) {
        const int type = ct >> 2, c4 = ct & 3;
        f32x4 acc[4][4];
        gemm_core_pf<true>(acc, [&](int a, int c, int r) { const int ty = c >> 2; return PS + (size_t)(a * 128 + r) * 1792 + (ty == 0 ? 1536 : (ty == 1 ? 1600 : 1664)); },
                           [&](int, int c, int r) { const int ty = c >> 2, cc = c & 3; return ty == 0 ? Wl0 + (size_t)(cc * 128 + r) * 64 : (ty == 1 ? Wl1 + (size_t)(cc * 128 + r) * 64 : Wl2 + (size_t)(cc * 128 + r) * 128); },
                           rt, ct, type == 2 ? 2 : 1, hn, nrt, nct, gp, smem);
        if (type == 0) {
#pragma unroll
            for (int m = 0; m < 4; ++m)
#pragma unroll
                for (int n = 0; n < 4; ++n) {
                    const int row = rt * 128 + wr * 64 + m * 16 + fr, col = c4 * 128 + wc * 64 + n * 16 + 4 * fq;
                    f32x4 o;
#pragma unroll
                    for (int e = 0; e < 4; ++e) {
                        const float z = -(w0[col + e] + acc[m][n][e]);
                        const float sp = fmaxf(z, 0.f) + __logf(1.0f + __expf(-fabsf(z)));
                        o[e] = __expf(-__expf(-sp - 0.5f));
                    }
                    *(f32x4*)(WD + (size_t)row * 512 + col) = o;
                }
        } else if (type == 1) {
            const int head = c4 * 2 + wc;
#pragma unroll
            for (int m = 0; m < 4; ++m) {
                const int row = rt * 128 + wr * 64 + m * 16 + fr;
                f32x4 av[4], kv[4], kr[4];
                float ss = 0.f, bs = 0.f;
#pragma unroll
                for (int n = 0; n < 4; ++n) {
                    const int col = head * 64 + n * 16 + 4 * fq;
                    const f32x4 kk_ = cvt4f(*(const f16x4*)(PS + (size_t)row * 1792 + 512 + col));
                    const f32x4 rr = cvt4f(*(const f16x4*)(PS + (size_t)row * 1792 + col));
#pragma unroll
                    for (int e = 0; e < 4; ++e) {
                        const float a = sigmoid_(a0[col + e] + acc[m][n][e]);
                        const float kraw = kk_[e] * k_k[col + e];
                        const float kp = kk_[e] * (1.0f + (a - 1.0f) * k_a[col + e]);
                        av[n][e] = a; kr[n][e] = kraw; kv[n][e] = kp;
                        ss += kraw * kraw; bs += rr[e] * kp * r_k[col + e];
                    }
                }
                ss += __shfl_xor(ss, 16); ss += __shfl_xor(ss, 32);
                bs += __shfl_xor(bs, 16); bs += __shfl_xor(bs, 32);
                const float inv = 1.0f / fmaxf(sqrtf(ss), 1e-12f);
#pragma unroll
                for (int n = 0; n < 4; ++n) {
                    const int col = head * 64 + n * 16 + 4 * fq;
                    f32x4 nk_, bb_;
#pragma unroll
                    for (int e = 0; e < 4; ++e) { const float kkn = kr[n][e] * inv; nk_[e] = -kkn; bb_[e] = kkn * av[n][e]; }
                    *(f16x4*)(NKK + (size_t)row * 512 + col) = cvt4(nk_);
                    *(f16x4*)(BB + (size_t)row * 512 + col) = cvt4(bb_);
                    *(f16x4*)(KP + (size_t)row * 512 + col) = cvt4(kv[n]);
                }
                if (fq == 0) BSUM[(size_t)row * 8 + head] = bs;
            }
        } else {
#pragma unroll
            for (int m = 0; m < 4; ++m)
#pragma unroll
                for (int n = 0; n < 4; ++n)
                    *(f16x4*)(G16 + (size_t)(rt * 128 + wr * 64 + m * 16 + fr) * 512 + c4 * 128 + wc * 64 + n * 16 + 4 * fq) = cvt4(acc[m][n]);
        }
    });
}

#if FAST_REC
constexpr int NREC = 128;
constexpr int SEG_C0 = 76;
__device__ __forceinline__ void rwkv_rec(const Params& p, int bh, int q, int c0, int nc, int part, bool wr_end, char* smem) {
    const int tid = TID, lane = tid & 63, wid = tid >> 6;
    const int b = bh >> 3, h = bh & 7;
    const int rl = lane >> 4, ks = lane & 15, vrow = wid * 4 + rl;
    const float* WD = (const float*)(WS + S_WD32); const f16* NKK = (const f16*)(WS + S_NKK); const f16* BB = (const f16*)(WS + S_BB);
    const f16* KP = (const f16*)(WS + S_KP); const f16* PS = (const f16*)(WS + S_PS16); float* Y = (float*)(WS + (part == 2 ? S_YT : S_Y32));
    float* sW = (float*)smem; float* sN = sW + 32 * 64; float* sB = sN + 32 * 64; float* sK = sB + 32 * 64; float* sWR = sK + 32 * 64;
    float* sV = sWR + 32 * 64; float* sS = sV + 32 * 16; float* sY = sS + 32 * 2;
    const size_t tb = (size_t)b * SEQ + (size_t)c0 * 32;
    f32x4 pw0, pw1; f16x8 pn, pb, pk, pr, pv;
    const int pst = tid >> 3, pc8 = tid & 7;
    auto prefetch = [&](int c) {
        const size_t t0 = tb + c * 32;
        const size_t o = (t0 + pst) * 512 + h * 64 + pc8 * 8;
        pw0 = *(const f32x4*)(WD + o); pw1 = *(const f32x4*)(WD + o + 4);
        pn = *(const f16x8*)(NKK + o); pb = *(const f16x8*)(BB + o); pk = *(const f16x8*)(KP + o); pr = *(const f16x8*)(PS + (t0 + pst) * 1792 + h * 64 + pc8 * 8);
        if (tid < 64) { const int st = tid >> 1, hf = tid & 1; pv = *(const f16x8*)(PS + (t0 + st) * 1792 + 1024 + h * 64 + q * 16 + hf * 8); }
    };
    f32x4 S = {0.f, 0.f, 0.f, 0.f};
    if (part == 2) {
#pragma unroll
        for (int e = 0; e < 4; ++e) S[e] = (4 * ks + e == q * 16 + vrow) ? 1.0f : 0.0f;
    }
    BSYNC();
    prefetch(0);
    for (int c = 0; c < nc; ++c) {
        BSYNC();
        if (c > 0) {
#pragma unroll
            for (int i = 0; i < 2; ++i) { const int e = tid + 256 * i, st = e >> 4, r = e & 15; Y[(tb + (c - 1) * 32 + st) * 512 + h * 64 + q * 16 + r] = sY[e]; }
        }
        {
            const int o = tid * 8;
            float br = 0.f, kr = 0.f;
            f32x4 wr0, wr1, n0, n1, b0, b1, k0, k1;
#pragma unroll
            for (int e = 0; e < 4; ++e) {
                const float r0 = (float)pr[e], r1 = (float)pr[4 + e];
                n0[e] = (float)pn[e]; n1[e] = (float)pn[4 + e]; b0[e] = (float)pb[e]; b1[e] = (float)pb[4 + e]; k0[e] = (float)pk[e]; k1[e] = (float)pk[4 + e];
                wr0[e] = pw0[e] * r0; wr1[e] = pw1[e] * r1;
                br += b0[e] * r0 + b1[e] * r1; kr += k0[e] * r0 + k1[e] * r1;
            }
            *(f32x4*)(sW + o) = pw0; *(f32x4*)(sW + o + 4) = pw1; *(f32x4*)(sN + o) = n0; *(f32x4*)(sN + o + 4) = n1;
            *(f32x4*)(sB + o) = b0; *(f32x4*)(sB + o + 4) = b1; *(f32x4*)(sK + o) = k0; *(f32x4*)(sK + o + 4) = k1;
            *(f32x4*)(sWR + o) = wr0; *(f32x4*)(sWR + o + 4) = wr1;
            br += __shfl_xor(br, 1); br += __shfl_xor(br, 2); br += __shfl_xor(br, 4);
            kr += __shfl_xor(kr, 1); kr += __shfl_xor(kr, 2); kr += __shfl_xor(kr, 4);
            if (pc8 == 0) { sS[pst * 2] = br; sS[pst * 2 + 1] = kr; }
            if (tid < 64) {
#pragma unroll
                for (int e = 0; e < 8; ++e) sV[tid * 8 + e] = (part == 2) ? 0.0f : (float)pv[e];
            }
        }
        BSYNC();
        if (c + 1 < nc) prefetch(c + 1);
        float y0 = 0.f, y1 = 0.f;
        f32x4 w4 = *(const f32x4*)(sW + ks * 4), n4 = *(const f32x4*)(sN + ks * 4), b4 = *(const f32x4*)(sB + ks * 4);
        f32x4 k4 = *(const f32x4*)(sK + ks * 4), q4 = *(const f32x4*)(sWR + ks * 4);
        float vv = sV[vrow]; f32x2 sc = *(const f32x2*)(sS);
#pragma unroll
        for (int s = 0; s < 32; ++s) {
            f32x4 w4n = w4, n4n = n4, b4n = b4, k4n = k4, q4n = q4; float vvn = vv; f32x2 scn = sc;
            if (s + 1 < 32) {
                w4n = *(const f32x4*)(sW + (s + 1) * 64 + ks * 4); n4n = *(const f32x4*)(sN + (s + 1) * 64 + ks * 4); b4n = *(const f32x4*)(sB + (s + 1) * 64 + ks * 4);
                k4n = *(const f32x4*)(sK + (s + 1) * 64 + ks * 4); q4n = *(const f32x4*)(sWR + (s + 1) * 64 + ks * 4);
                vvn = sV[(s + 1) * 16 + vrow]; scn = *(const f32x2*)(sS + (s + 1) * 2);
            }
            __builtin_amdgcn_sched_barrier(0);
            float d1 = fmaf(S[3], n4[3], fmaf(S[2], n4[2], fmaf(S[1], n4[1], S[0] * n4[0])));
            float d2 = fmaf(S[3], q4[3], fmaf(S[2], q4[2], fmaf(S[1], q4[1], S[0] * q4[0])));
            d1 = row16_sum(d1); d2 = row16_sum(d2);
            const float y = d2 + d1 * sc[0] + vv * sc[1];
            S = S * w4 + (b4 * d1 + k4 * vv);
            if (s < 16) y0 = (ks == s) ? y : y0; else y1 = (ks == s - 16) ? y : y1;
            __builtin_amdgcn_sched_barrier(0);
            w4 = w4n; n4 = n4n; b4 = b4n; k4 = k4n; q4 = q4n; vv = vvn; sc = scn;
        }
        sY[ks * 16 + vrow] = y0; sY[(16 + ks) * 16 + vrow] = y1;
    }
    BSYNC();
#pragma unroll
    for (int i = 0; i < 2; ++i) { const int e = tid + 256 * i, st = e >> 4, r = e & 15; Y[(tb + (size_t)(nc - 1) * 32 + st) * 512 + h * 64 + q * 16 + r] = sY[e]; }
    if (wr_end) *(f32x4*)((float*)(WS + S_SMID) + ((size_t)bh * 64 + q * 16 + vrow) * 64 + ks * 4) = S;
}
#else
constexpr int NREC = 8;
__device__ __forceinline__ void rwkv_rec(const Params& p, int rb, char*) {
    const int gt = rb * 256 + TID, bh = gt >> 6, v = gt & 63, b = bh >> 3, h = bh & 7;
    const float* WD = (const float*)(WS + S_WD32); const f16* NKK = (const f16*)(WS + S_NKK); const f16* BB = (const f16*)(WS + S_BB);
    const f16* KP = (const f16*)(WS + S_KP); const f16* PS = (const f16*)(WS + S_PS16); float* Y = (float*)(WS + S_Y32);
    float S[64];
#pragma unroll
    for (int k = 0; k < 64; ++k) S[k] = 0.f;
    for (int s = 0; s < SEQ; ++s) {
        const size_t t = (size_t)b * SEQ + s, o = t * 512 + h * 64;
        const float vv = (float)PS[t * 1792 + 1024 + h * 64 + v];
        float sa = 0.f;
#pragma unroll
        for (int k8 = 0; k8 < 8; ++k8) { const f16x8 n8 = *(const f16x8*)(NKK + o + k8 * 8);
#pragma unroll
            for (int e = 0; e < 8; ++e) sa += S[k8 * 8 + e] * (float)n8[e]; }
        float y = 0.f;
#pragma unroll
        for (int k8 = 0; k8 < 8; ++k8) {
            const f16x8 b8 = *(const f16x8*)(BB + o + k8 * 8), kp8 = *(const f16x8*)(KP + o + k8 * 8), r8 = *(const f16x8*)(PS + t * 1792 + h * 64 + k8 * 8);
            const f32x4 wa = *(const f32x4*)(WD + o + k8 * 8), wb = *(const f32x4*)(WD + o + k8 * 8 + 4);
#pragma unroll
            for (int e = 0; e < 8; ++e) {
                const float w = e < 4 ? wa[e & 3] : wb[e & 3];
                const float sn = S[k8 * 8 + e] * w + (sa * (float)b8[e] + vv * (float)kp8[e]);
                S[k8 * 8 + e] = sn; y += sn * (float)r8[e];
            }
        }
        Y[t * 512 + h * 64 + v] = y;
    }
}
#endif

__device__ __forceinline__ void sg_item(const Params& p, int j, int item, char* smem) {
    WAVE_IDS
    const int g = item & 3, bc = item >> 2;
    const f16* P = (const f16*)(WS + S_P16);
    f16* ZT = (f16*)(WS + S_ZT) + (size_t)item * 128 * 128;
    const float* lg = IN(14) + (j * 4 + g) * 128; const float* lb = IN(15) + (j * 4 + g) * 128;
    {
        const int sub = tid & 15, rloc = tid >> 4;
        for (int it = 0; it < 8; ++it) {
            const int s = it * 16 + rloc;
            const f16x8 x = *(const f16x8*)(P + (size_t)(bc * 128 + s) * 2816 + 2304 + g * 128 + sub * 8);
            float z[8], sum = 0.f;
#pragma unroll
            for (int e = 0; e < 8; ++e) { z[e] = gelu_((float)x[e]); sum += z[e]; }
            const float mean = row16_sum(sum) * (1.0f / 128.0f);
            float qq = 0.f;
#pragma unroll
            for (int e = 0; e < 8; ++e) { const float d = z[e] - mean; qq += d * d; }
            const float rstd = rsqrtf(row16_sum(qq) * (1.0f / 128.0f) + 1e-5f);
#pragma unroll
            for (int e = 0; e < 8; ++e) { const int d = sub * 8 + e; ZT[(size_t)d * 128 + s] = (f16)((z[e] - mean) * rstd * lg[d] + lb[d]); }
        }
    }
    asm volatile("s_waitcnt vmcnt(0)" ::: "memory");
    BSYNC();
    const f16* Wm = (const f16*)(WS + W_SGW) + (size_t)(j * 4 + g) * 128 * 128;
    f32x4 acc[4][4];
    gemm_core<true>(acc, [&](int r) { return Wm + (size_t)r * 128; }, [&](int r) { return (const f16*)ZT + (size_t)r * 128; }, 2, smem);
    const float* bs = IN(17) + (j * 4 + g) * 128;
    f16* MIX = (f16*)(WS + S_MIX16);
#pragma unroll
    for (int m = 0; m < 4; ++m)
#pragma unroll
        for (int n = 0; n < 4; ++n) {
            const int tl = wr * 64 + m * 16 + fr, d = wc * 64 + n * 16 + 4 * fq;
            const size_t t = (size_t)bc * 128 + tl;
            const f32x4 u = cvt4f(*(const f16x4*)(P + t * 2816 + 1792 + g * 128 + d));
            f32x4 o;
#pragma unroll
            for (int e = 0; e < 4; ++e) o[e] = gelu_(u[e]) * (acc[m][n][e] + bs[tl]);
            *(f16x4*)(MIX + t * 1024 + 512 + g * 128 + d) = cvt4(o);
        }
}

__device__ __forceinline__ void phase_rec_sg(const Params& p, int j, bool pre, bool segmode, char* smem) {
#if FAST_REC
    const int bid = BID, nb = NBLK;
    if (!segmode) {
        const bool isrec = (bid < 256) && (((bid >> 3) & 1) == 0);
        if (isrec) { const int u = ((bid >> 4) << 3) | (bid & 7); rwkv_rec(p, u >> 2, u & 3, 0, 128, 0, false, smem); }
        else {
            const int sgi = (bid < 256) ? (((bid >> 4) << 3) | (bid & 7)) : (bid - 128);
            for (int item = sgi; item < 512; item += nb - 128) sg_item(p, j, item, smem);
            if (pre) {
                for (int item = sgi; item < 2048; item += nb - 128) xa_pre_item(p, item, smem);
                BSYNC();
                convert_moe(p, smem, sgi, nb - 128, 0);
            }
        }
    } else {
        const int nrec = (nb * 3) >> 2;
        if (bid < nrec) {
            for (int v = bid; v < 384; v += nrec) {
                int bh, q, part;
                if (v >= 128 && v < 256) { const int u = v - 128; bh = u >> 2; q = u & 3; part = 0; }
                else { const int u = (v < 128) ? v : v - 128; bh = u >> 3; q = u & 3; part = 1 + ((u >> 2) & 1); }
                rwkv_rec(p, bh, q, part == 0 ? 0 : SEG_C0, part == 0 ? SEG_C0 : 128 - SEG_C0, part == 2 ? 2 : 0, part == 0, smem);
            }
        } else {
            for (int item = bid - nrec; item < 512; item += nb - nrec) sg_item(p, j, item, smem);
            BSYNC();
            convert_moe(p, smem, bid - nrec, nb - nrec, 1);
        }
    }
#else
    if (BID < NREC) rwkv_rec(p, BID, smem);
    else {
        for (int item = BID - NREC; item < 512; item += NBLK - NREC) sg_item(p, j, item, smem);
        if (pre) { for (int item = BID - NREC; item < 2048; item += NBLK - NREC) xa_pre_item(p, item, smem); BSYNC(); convert_moe(p, smem, BID - NREC, NBLK - NREC, 0); convert_moe(p, smem, BID - NREC, NBLK - NREC, 1); }
    }
#endif
}

__device__ __forceinline__ void phase_rw_fin_seg(const Params& p, int j, char* smem) {
    const int tid = TID, tl = tid >> 2, vq = tid & 3;
    const float* Y = (const float*)(WS + S_Y32); const float* YT = (const float*)(WS + S_YT); const float* SM = (const float*)(WS + S_SMID);
    const f16* PS = (const f16*)(WS + S_PS16); const f16* G16 = (const f16*)(WS + S_G16);
    const float* BSUM = (const float*)(WS + S_BSUM); f16* MIX = (f16*)(WS + S_MIX16);
    const float* gg = IN(12) + j * 512; const float* gb = IN(13) + j * 512;
    float* sST = (float*)smem;
    float* sYT = sST + 64 * 64;
    for (int item = BID; item < 2048; item += NBLK) {
        const int bh = item >> 6, tile = item & 63, b = bh >> 3, h = bh & 7;
        const size_t t = (size_t)b * SEQ + tile * 64 + tl;
        const int c = h * 64 + vq * 16;
        float y[16];
#pragma unroll
        for (int i4 = 0; i4 < 4; ++i4) { const f32x4 v4 = *(const f32x4*)(Y + t * 512 + c + i4 * 4); y[i4 * 4] = v4[0]; y[i4 * 4 + 1] = v4[1]; y[i4 * 4 + 2] = v4[2]; y[i4 * 4 + 3] = v4[3]; }
        if (tile >= SEG_C0 / 2) {
            BSYNC();
            {
                const int v = tid >> 2, i0 = (tid & 3) * 16;
#pragma unroll
                for (int i4 = 0; i4 < 4; ++i4) { const f32x4 v4 = *(const f32x4*)(SM + ((size_t)bh * 64 + v) * 64 + i0 + i4 * 4);
#pragma unroll
                    for (int e = 0; e < 4; ++e) sST[(i0 + i4 * 4 + e) * 64 + v] = v4[e]; }
#pragma unroll
                for (int i4 = 0; i4 < 4; ++i4) { const f32x4 v4 = *(const f32x4*)(YT + t * 512 + c + i4 * 4);
#pragma unroll
                    for (int e = 0; e < 4; ++e) sYT[tl * 65 + vq * 16 + i4 * 4 + e] = v4[e]; }
            }
            BSYNC();
            for (int i = 0; i < 64; ++i) {
                const float a = sYT[tl * 65 + i];
#pragma unroll
                for (int i4 = 0; i4 < 4; ++i4) { const f32x4 s4 = *(const f32x4*)(sST + i * 64 + vq * 16 + i4 * 4);
                    y[i4 * 4] += a * s4[0]; y[i4 * 4 + 1] += a * s4[1]; y[i4 * 4 + 2] += a * s4[2]; y[i4 * 4 + 3] += a * s4[3]; }
            }
        }
        float sum = 0.f;
#pragma unroll
        for (int e = 0; e < 16; ++e) sum += y[e];
        sum += __shfl_xor(sum, 1); sum += __shfl_xor(sum, 2);
        const float mean = sum * (1.0f / 64.0f);
        float qq = 0.f;
#pragma unroll
        for (int e = 0; e < 16; ++e) { const float d = y[e] - mean; qq += d * d; }
        qq += __shfl_xor(qq, 1); qq += __shfl_xor(qq, 2);
        const float rstd = rsqrtf(qq * (1.0f / 64.0f) + 64e-5f);
        const float bsum = BSUM[t * 8 + h];
#pragma unroll
        for (int hf = 0; hf < 2; ++hf) {
            const f16x8 v8 = *(const f16x8*)(PS + t * 1792 + 1024 + c + hf * 8), g8 = *(const f16x8*)(G16 + t * 512 + c + hf * 8);
            f16x8 o;
#pragma unroll
            for (int e = 0; e < 8; ++e) {
                const float r = ((y[hf * 8 + e] - mean) * rstd * gg[c + hf * 8 + e] + gb[c + hf * 8 + e] + bsum * (float)v8[e]) * (float)g8[e];
                o[e] = (f16)r;
            }
            *(f16x8*)(MIX + t * 1024 + c + hf * 8) = o;
        }
    }
}

__device__ __forceinline__ void phase_rw_fin(const Params& p, int j) {
    const int lane = TID & 63, gw = BID * 4 + (TID >> 6), nw = NBLK * 4;
    const float* Y = (const float*)(WS + S_Y32); const f16* PS = (const f16*)(WS + S_PS16); const f16* G16 = (const f16*)(WS + S_G16);
    const float* BSUM = (const float*)(WS + S_BSUM); f16* MIX = (f16*)(WS + S_MIX16);
    const float* gg = IN(12) + j * 512; const float* gb = IN(13) + j * 512;
    for (int t = gw; t < T; t += nw) {
        const int c = lane * 8, head = lane >> 3;
        const f32x4 y0 = *(const f32x4*)(Y + (size_t)t * 512 + c), y1 = *(const f32x4*)(Y + (size_t)t * 512 + c + 4);
        float s = (y0[0] + y0[1]) + (y0[2] + y0[3]) + (y1[0] + y1[1]) + (y1[2] + y1[3]);
        s += __shfl_xor(s, 1); s += __shfl_xor(s, 2); s += __shfl_xor(s, 4);
        const float mean = s * (1.0f / 64.0f);
        float qq = 0.f;
#pragma unroll
        for (int e = 0; e < 4; ++e) { const float d0 = y0[e] - mean, d1 = y1[e] - mean; qq += d0 * d0 + d1 * d1; }
        qq += __shfl_xor(qq, 1); qq += __shfl_xor(qq, 2); qq += __shfl_xor(qq, 4);
        const float rstd = rsqrtf(qq * (1.0f / 64.0f) + 64e-5f);
        const float bsum = BSUM[(size_t)t * 8 + head];
        const f16x8 v8 = *(const f16x8*)(PS + (size_t)t * 1792 + 1024 + c), g8 = *(const f16x8*)(G16 + (size_t)t * 512 + c);
        f16x8 o;
#pragma unroll
        for (int e = 0; e < 8; ++e) {
            const float yv = e < 4 ? y0[e & 3] : y1[e & 3];
            const float r = ((yv - mean) * rstd * gg[c + e] + gb[c + e] + bsum * (float)v8[e]) * (float)g8[e];
            o[e] = (f16)r;
        }
        *(f16x8*)(MIX + (size_t)t * 1024 + c) = o;
    }
}

__device__ __forceinline__ void phase_mla_in(const Params& p, int j, char* smem) {
    WAVE_IDS
    const f16* X = (const f16*)(WS + OFF_H16);
    const f16* Wt = (const f16*)(WS + W_MLAIN) + (size_t)j * 640 * 1024;
    f16* CQKV = (f16*)(WS + S_CQKV); f16* KPE = (f16*)(WS + S_KPE); float* SSQ = (float*)(WS + S_SSQ);
    const f32x2* rope = (const f32x2*)(WS + OFF_ROPE);
    GPipe gp{0, 0};
    tile_loop2(128, 5, [&](int rt, int ct, bool hn, int nrt, int nct) {
        f32x4 acc[4][4];
        gemm_core_pf<true>(acc, [&](int a, int, int r) { return X + (size_t)(a * 128 + r) * 1024; }, [&](int, int c, int r) { return Wt + (size_t)(c * 128 + r) * 1024; },
                           rt, ct, 16, hn, nrt, nct, gp, smem);
        if (ct < 4) {
#pragma unroll
            for (int m = 0; m < 4; ++m) {
                const int row = rt * 128 + wr * 64 + m * 16 + fr;
                float ss = 0.f;
#pragma unroll
                for (int n = 0; n < 4; ++n) {
                    *(f16x4*)(CQKV + (size_t)row * 512 + ct * 128 + wc * 64 + n * 16 + 4 * fq) = cvt4(acc[m][n]);
                    const f32x4 a = acc[m][n]; ss += (a[0] * a[0] + a[1] * a[1]) + (a[2] * a[2] + a[3] * a[3]);
                }
                ss += __shfl_xor(ss, 16); ss += __shfl_xor(ss, 32);
                if (fq == 0) SSQ[(size_t)row * 8 + ct * 2 + wc] = ss;
            }
        } else if (wc == 0) {
#pragma unroll
            for (int m = 0; m < 4; ++m) {
                const int row = rt * 128 + wr * 64 + m * 16 + fr, pos = row & (SEQ - 1);
                f32x4 o1, o2;
#pragma unroll
                for (int e = 0; e < 4; ++e) {
                    const f32x2 cs = rope[pos * 16 + 4 * fq + e];
                    const float x1 = acc[m][0][e], x2 = acc[m][1][e];
                    o1[e] = x1 * cs[0] - x2 * cs[1]; o2[e] = x1 * cs[1] + x2 * cs[0];
                }
                *(f16x4*)(KPE + (size_t)row * 32 + 4 * fq) = cvt4(o1);
                *(f16x4*)(KPE + (size_t)row * 32 + 16 + 4 * fq) = cvt4(o2);
            }
        }
    });
}

__device__ __forceinline__ void phase_mla_qkv(const Params& p, int j, char* smem) {
    WAVE_IDS
    const f16* CQKV = (const f16*)(WS + S_CQKV);
    f16* Q16 = (f16*)(WS + S_Q16); f16* KN = (f16*)(WS + S_KN16); f16* VT = (f16*)(WS + S_VT16);
    const f32x2* rope = (const f32x2*)(WS + OFF_ROPE);
    const float* SSQ = (const float*)(WS + S_SSQ);
    GPipe gp{0, 0};
    const f16* Wqb = (const f16*)(WS + W_Q) + (size_t)j * 1536 * 256; const f16* Wkvb = (const f16*)(WS + W_KV) + (size_t)j * 2048 * 256;
    auto xpf = [&](int a, int c, int r) { return CQKV + (size_t)(a * 128 + r) * 512 + (c < 12 ? 0 : 256); };
    auto wpf = [&](int, int c, int r) { return c < 12 ? Wqb + (size_t)(c * 128 + r) * 256 : Wkvb + (size_t)((c - 12) * 128 + r) * 256; };
    tile_loop2(128, 28, [&](int rt, int ct, bool hn, int nrt, int nct) {
        const bool isq = ct < 12;
        auto rrow = [&](int rl) { const f32x4 q4 = *(const f32x4*)(SSQ + (size_t)(rt * 128 + rl) * 8 + (isq ? 0 : 4)); return rsqrtf(((q4[0] + q4[1]) + (q4[2] + q4[3])) * (1.0f / 256.0f) + 1e-6f); };
        f32x4 acc[4][4];
        if (isq) {
            gemm_core_pf<true>(acc, xpf, wpf, rt, ct, 4, hn, nrt, nct, gp, smem);
            const int cb = ct * 128 + wc * 64;
#pragma unroll
            for (int m = 0; m < 4; ++m) {
                const int rl = wr * 64 + m * 16 + fr, row = rt * 128 + rl, pos = row & (SEQ - 1);
                const float sc = rrow(rl);
#pragma unroll
                for (int n = 0; n < 4; ++n) acc[m][n] = acc[m][n] * sc;
#pragma unroll
                for (int n = 0; n < 4; n += 2) {
                    if (((cb + n * 16) % 96) == 64) {
#pragma unroll
                        for (int e = 0; e < 4; ++e) {
                            const f32x2 cs = rope[pos * 16 + 4 * fq + e];
                            const float x1 = acc[m][n][e], x2 = acc[m][n + 1][e];
                            acc[m][n][e] = x1 * cs[0] - x2 * cs[1]; acc[m][n + 1][e] = x1 * cs[1] + x2 * cs[0];
                        }
                    }
                }
#pragma unroll
                for (int n = 0; n < 4; ++n) *(f16x4*)(Q16 + (size_t)row * 1536 + cb + n * 16 + 4 * fq) = cvt4(acc[m][n]);
            }
        } else {
            const int c2 = ct - 12;
            if (c2 < 8) {
                gemm_core_pf<true>(acc, xpf, wpf, rt, ct, 4, hn, nrt, nct, gp, smem);
#pragma unroll
                for (int m = 0; m < 4; ++m) {
                    const int rl = wr * 64 + m * 16 + fr; const float sc = rrow(rl);
#pragma unroll
                    for (int n = 0; n < 4; ++n) *(f16x4*)(KN + (size_t)(rt * 128 + rl) * 1024 + c2 * 128 + wc * 64 + n * 16 + 4 * fq) = cvt4(acc[m][n] * sc);
                }
            } else {
                gemm_core_pf<false>(acc, xpf, wpf, rt, ct, 4, hn, nrt, nct, gp, smem);
#pragma unroll
                for (int m = 0; m < 4; ++m) {
                    const int rl = wr * 64 + m * 16 + 4 * fq, row = rt * 128 + rl, b = row >> 12, s = row & (SEQ - 1);
                    f32x4 sc; sc[0] = rrow(rl); sc[1] = rrow(rl + 1); sc[2] = rrow(rl + 2); sc[3] = rrow(rl + 3);
#pragma unroll
                    for (int n = 0; n < 4; ++n) {
                        const int col = (c2 - 8) * 128 + wc * 64 + n * 16 + fr, h = col >> 6, d = col & 63;
                        *(f16x4*)(VT + ((size_t)((b * 16 + h) * 64 + d)) * SEQ + s) = cvt4(acc[m][n] * sc);
                    }
                }
            }
        }
    });
}

__device__ __forceinline__ f32x4 mfma16(f16x8 a, f16x8 b, f32x4 c) { return __builtin_amdgcn_mfma_f32_16x16x32_f16(a, b, c, 0, 0, 0); }
__device__ __forceinline__ f16x8 cat4(f16x4 lo, f16x4 hi) { return __builtin_shufflevector(lo, hi, 0, 1, 2, 3, 4, 5, 6, 7); }

__device__ __forceinline__ void phase_mla_attn(const Params& p, char* smem) {
    const int tid = TID, lane = tid & 63, wid = tid >> 6, li = lane & 15, g = lane >> 4;
    const f16* Q16 = (const f16*)(WS + S_Q16); const f16* KN = (const f16*)(WS + S_KN16); const f16* KPE = (const f16*)(WS + S_KPE);
    const f16* VT = (const f16*)(WS + S_VT16); f16* O = (f16*)(WS + S_MIX16);
    constexpr int BUF = 20480;
    const int sc8 = ((tid & 7) ^ ((tid >> 4) & 7)) * 8;
    const int scp = ((tid & 3) ^ ((0x78 >> (2 * ((tid >> 4) & 3))) & 3)) * 8;
    const int kn_rd0 = ((0 + g) ^ (li >> 1)) * 16, kn_rd1 = ((4 + g) ^ (li >> 1)) * 16;
    const int kp_rd = (g ^ ((0x78 >> (2 * ((li >> 2) & 3))) & 3)) * 16;
    const int v_rd[4] = {(((0 + (g >> 1)) ^ (li >> 1)) * 16) + (g & 1) * 8, (((2 + (g >> 1)) ^ (li >> 1)) * 16) + (g & 1) * 8,
                         (((4 + (g >> 1)) ^ (li >> 1)) * 16) + (g & 1) * 8, (((6 + (g >> 1)) ^ (li >> 1)) * 16) + (g & 1) * 8};
    const int nb_ = NBLK, xcd_ = BID & 7, lb_ = BID >> 3, nlb_ = nb_ >> 3;
    for (int j_ = lb_; j_ < 128; j_ += nlb_) {
        const int bh = xcd_ * 8 + (j_ >> 4), pr = j_ & 15, b = bh >> 4, h = bh & 15;
        const size_t tb = (size_t)b * SEQ;
        for (int half = 0; half < 2; ++half) {
            const int qb = half ? pr : 31 - pr;
            const int qw = qb * 128 + wid * 32;
            const int nch = 2 * qb + 2, lastw = (qw + 31) >> 6;
            f16x8 Qf[2][3];
#pragma unroll
            for (int jq = 0; jq < 2; ++jq)
#pragma unroll
                for (int ks = 0; ks < 3; ++ks) Qf[jq][ks] = *(const f16x8*)(Q16 + (tb + qw + jq * 16 + li) * 1536 + h * 96 + ks * 32 + 8 * g);
            asm volatile("s_waitcnt vmcnt(0)" ::: "memory");
#pragma unroll
            for (int jq = 0; jq < 2; ++jq)
#pragma unroll
                for (int ks = 0; ks < 3; ++ks) asm volatile("" : "+v"(Qf[jq][ks]));
            f32x4 Oa[5][2];
#pragma unroll
            for (int vb = 0; vb < 5; ++vb) { Oa[vb][0] = (f32x4){0.f, 0.f, 0.f, 0.f}; Oa[vb][1] = (f32x4){0.f, 0.f, 0.f, 0.f}; }
            f16x8 ones;
#pragma unroll
            for (int e = 0; e < 8; ++e) ones[e] = (f16)1.0f;
            const f16* kn_src = KN + (tb + (tid >> 3)) * 1024 + h * 64 + sc8;
            const f16* kp_src = KPE + (tb + (tid >> 2)) * 32 + scp;
            const f16* v_src = VT + ((size_t)((b * 16 + h) * 64 + (tid >> 3))) * SEQ + sc8;
            auto stage = [&](int kc, int s) {
                char* base = smem + s * BUF + tid * 16;
                __builtin_amdgcn_global_load_lds((const void*)(kn_src + (size_t)kc * 64 * 1024), (LAS void*)(base), 16, 0, 0);
                __builtin_amdgcn_global_load_lds((const void*)(kn_src + (size_t)(kc * 64 + 32) * 1024), (LAS void*)(base + 4096), 16, 0, 0);
                __builtin_amdgcn_global_load_lds((const void*)(v_src + kc * 64), (LAS void*)(base + 8192), 16, 0, 0);
                __builtin_amdgcn_global_load_lds((const void*)(v_src + (size_t)32 * SEQ + kc * 64), (LAS void*)(base + 8192 + 4096), 16, 0, 0);
                __builtin_amdgcn_global_load_lds((const void*)(kp_src + (size_t)kc * 64 * 32), (LAS void*)(base + 16384), 16, 0, 0);
            };
            BSYNC();
            stage(0, 0);
            if (nch > 1) stage(1, 1);
            for (int kc = 0; kc < nch; ++kc) {
                const int s = kc % 3;
                if (kc + 1 < nch) asm volatile("s_waitcnt vmcnt(5) lgkmcnt(0)" ::: "memory"); else asm volatile("s_waitcnt vmcnt(0) lgkmcnt(0)" ::: "memory");
                __builtin_amdgcn_s_barrier();
                asm volatile("" ::: "memory");
                if (kc + 2 < nch) stage(kc + 2, (kc + 2) % 3);
                if (kc > lastw) continue;
                const char* bK = smem + s * BUF; const char* bV = bK + 8192; const char* bP = bK + 16384;
                f32x4 Sx[4][2];
#pragma unroll
                for (int kb = 0; kb < 4; ++kb) { Sx[kb][0] = (f32x4){-8.f, -8.f, -8.f, -8.f}; Sx[kb][1] = (f32x4){-8.f, -8.f, -8.f, -8.f}; }
#pragma unroll
                for (int kb = 0; kb < 4; ++kb) {
                    const f16x8 K0 = *(const f16x8*)(bK + (kb * 16 + li) * 128 + kn_rd0);
                    const f16x8 K1 = *(const f16x8*)(bK + (kb * 16 + li) * 128 + kn_rd1);
                    const f16x8 K2 = *(const f16x8*)(bP + (kb * 16 + li) * 64 + kp_rd);
                    Sx[kb][0] = mfma16(K0, Qf[0][0], Sx[kb][0]); Sx[kb][1] = mfma16(K0, Qf[1][0], Sx[kb][1]);
                    Sx[kb][0] = mfma16(K1, Qf[0][1], Sx[kb][0]); Sx[kb][1] = mfma16(K1, Qf[1][1], Sx[kb][1]);
                    Sx[kb][0] = mfma16(K2, Qf[0][2], Sx[kb][0]); Sx[kb][1] = mfma16(K2, Qf[1][2], Sx[kb][1]);
                }
                if (kc * 64 + 63 > qw) {
#pragma unroll
                    for (int jq = 0; jq < 2; ++jq) {
                        const int qpos = qw + jq * 16 + li;
#pragma unroll
                        for (int kb = 0; kb < 4; ++kb)
#pragma unroll
                            for (int r = 0; r < 4; ++r)
                                if (kc * 64 + kb * 16 + 4 * g + r > qpos) Sx[kb][jq][r] = -1e4f;
                    }
                }
                f16x8 Pf[2][2];
#pragma unroll
                for (int jq = 0; jq < 2; ++jq) {
#pragma unroll
                    for (int kb = 0; kb < 4; ++kb)
#pragma unroll
                        for (int r = 0; r < 4; ++r) Sx[kb][jq][r] = __builtin_amdgcn_exp2f(Sx[kb][jq][r]);
                    Pf[jq][0] = cat4(cvt4(Sx[0][jq]), cvt4(Sx[1][jq]));
                    Pf[jq][1] = cat4(cvt4(Sx[2][jq]), cvt4(Sx[3][jq]));
                }
#pragma unroll
                for (int kp = 0; kp < 2; ++kp) {
#pragma unroll
                    for (int vb = 0; vb < 4; ++vb) {
                        const char* vp = bV + (vb * 16 + li) * 128;
                        const f16x8 Vf = cat4(*(const f16x4*)(vp + v_rd[kp * 2]), *(const f16x4*)(vp + v_rd[kp * 2 + 1]));
                        Oa[vb][0] = mfma16(Vf, Pf[0][kp], Oa[vb][0]);
                        Oa[vb][1] = mfma16(Vf, Pf[1][kp], Oa[vb][1]);
                    }
                    Oa[4][0] = mfma16(ones, Pf[0][kp], Oa[4][0]);
                    Oa[4][1] = mfma16(ones, Pf[1][kp], Oa[4][1]);
                }
            }
#pragma unroll
            for (int jq = 0; jq < 2; ++jq) {
                const float inv = 1.0f / Oa[4][jq][0];
#pragma unroll
                for (int vb = 0; vb < 4; ++vb)
                    *(f16x4*)(O + (tb + qw + jq * 16 + li) * 1024 + h * 64 + vb * 16 + 4 * g) = cvt4(Oa[vb][jq] * inv);
            }
        }
    }
}

__device__ __forceinline__ void phase_xa_scores(const Params& p, int L, char* smem) {
    WAVE_IDS
    const f16* X = (const f16*)(WS + S_Y32R); const float* PST = (const float*)(WS + S_PST1);
    const float* XU = (const float*)(WS + OFF_XU) + (size_t)(L * 4) * 1024; const float* XC = (const float*)(WS + OFF_XC) + (size_t)(L * 4) * 1024;
    f16* XP = (f16*)(WS + S_XP16); float* LP = (float*)(WS + S_XLP);
    float* srow = (float*)(smem + SMEM_MAIN + 1024);
    GPipe gp{0, 0};
    const f16* XMb = (const f16*)(WS + OFF_XM) + (size_t)(L * 4) * 1024 * 1024;
    tile_loop2(128, 8, [&](int rt, int ct, bool hn, int nrt, int nct) {
        row_stats_table(PST, [&](int r) { return rt * 128 + r; }, srow);
        f32x4 acc[4][4];
        gemm_core_pf<true>(acc, [&](int a, int, int r) { return X + (size_t)(a * 128 + r) * 1024; },
                           [&](int a, int c, int r) { return XMb + (size_t)(a >> 5) * 1024 * 1024 + (size_t)(c * 128 + r) * 1024; }, rt, ct, 16, hn, nrt, nct, gp, smem);
        f32x4 u4[4], c4[4];
#pragma unroll
        for (int n = 0; n < 4; ++n) { const int col = (rt >> 5) * 1024 + ct * 128 + wc * 64 + n * 16 + 4 * fq; u4[n] = *(const f32x4*)(XU + col); c4[n] = *(const f32x4*)(XC + col); }
#pragma unroll
        for (int m = 0; m < 4; ++m) {
            const int row = rt * 128 + wr * 64 + m * 16 + fr;
            const f32x2 st = *(const f32x2*)(srow + (wr * 64 + m * 16 + fr) * 2);
            float ps = 0.f;
#pragma unroll
            for (int n = 0; n < 4; ++n) {
                const f32x4 sc = (acc[m][n] - u4[n] * st[0]) * st[1] + c4[n];
                f32x4 e;
#pragma unroll
                for (int q = 0; q < 4; ++q) e[q] = __builtin_amdgcn_exp2f(sc[q] - 8.0f);
                const f16x4 e16 = cvt4(e);
                const f32x4 er = cvt4f(e16);
                ps += (er[0] + er[1]) + (er[2] + er[3]);
                *(f16x4*)(XP + (size_t)row * 1024 + ct * 128 + wc * 64 + n * 16 + 4 * fq) = e16;
            }
            ps += __shfl_xor(ps, 16); ps += __shfl_xor(ps, 32);
            if (fq == 0) LP[(size_t)row * 16 + ct * 2 + wc] = ps;
        }
    });
}

__device__ __forceinline__ void phase_router(const Params& p, int L, char* smem) {
    WAVE_IDS
    const f16* X = (const f16*)(WS + OFF_H16);
    const f16* Wt = (const f16*)(WS + W_ROUTER) + (size_t)L * 128 * 1024;
    unsigned* cnt = (unsigned*)(WS + OFF_CNT) + L * 32;
    unsigned* list = (unsigned*)(WS + S_LIST); float* gates = (float*)(WS + S_GATES);
    const float* bg = IN(33) + L * 4; const float* be = IN(35) + L * 32;
    float* lg = (float*)smem;
    int* hist = (int*)(smem + 128 * 40 * 4); int* base = hist + 32;
    for (int rt = BID; rt < 128; rt += NBLK) {
        f32x4 acc[4][4];
        gemm_core<true>(acc, [&](int r) { return X + (size_t)(rt * 128 + r) * 1024; }, [&](int r) { return Wt + (size_t)r * 1024; }, 16, smem);
        BSYNC();
        if (wc == 0) {
#pragma unroll
            for (int m = 0; m < 4; ++m)
#pragma unroll
                for (int n = 0; n < 3; ++n) {
                    const int row = wr * 64 + m * 16 + fr, col = n * 16 + 4 * fq;
                    if (col < 40) *(f32x4*)(lg + row * 40 + col) = acc[m][n];
                }
        }
        if (tid < 32) hist[tid] = 0;
        BSYNC();
        int e0 = 0, e1 = 0, p0 = 0, p1 = 0; float g0 = 0.f, g1 = 0.f;
        if (tid < 128) {
            const float* l = lg + tid * 40;
            int grp = 0; float gm = l[0] + bg[0];
            for (int i = 1; i < 4; ++i) { const float v = l[i] + bg[i]; if (v > gm) { gm = v; grp = i; } }
            float den = 0.f;
            for (int i = 0; i < 4; ++i) den += __expf(l[i] + bg[i] - gm);
            const float pg = 1.0f / den;
            int i1 = 0; float v1 = l[4 + grp * 8] + be[grp * 8];
            for (int i = 1; i < 8; ++i) { const float v = l[4 + grp * 8 + i] + be[grp * 8 + i]; if (v > v1) { v1 = v; i1 = i; } }
            int i2 = -1; float v2 = -3.0e38f;
            for (int i = 0; i < 8; ++i) { const float v = l[4 + grp * 8 + i] + be[grp * 8 + i]; if (i != i1 && v > v2) { v2 = v; i2 = i; } }
            const float ex = __expf(v2 - v1);
            g0 = pg / (1.0f + ex); g1 = pg * ex / (1.0f + ex);
            e0 = grp * 8 + i1; e1 = grp * 8 + i2;
            p0 = atomicAdd(&hist[e0], 1); p1 = atomicAdd(&hist[e1], 1);
        }
        BSYNC();
        if (tid < 32) base[tid] = hist[tid] ? (int)atomicAdd(&cnt[tid], (unsigned)hist[tid]) : 0;
        BSYNC();
        if (tid < 128) {
            const int t = rt * 128 + tid;
            list[(size_t)e0 * 16384 + base[e0] + p0] = (unsigned)(t * 2);
            list[(size_t)e1 * 16384 + base[e1] + p1] = (unsigned)(t * 2 + 1);
            gates[t * 2] = g0; gates[t * 2 + 1] = g1;
        }
    }
}

__device__ __forceinline__ void moe_blocks(const Params& p, int L, char* smem, int* bs) {
    const unsigned* cnt = (const unsigned*)(WS + OFF_CNT) + L * 32;
    BSYNC();
    if (TID == 0) { int a = 0; for (int e = 0; e < 32; ++e) { bs[e] = a; a += ((int)cnt[e] + 127) >> 7; } bs[32] = a; }
    BSYNC();
}

__device__ __forceinline__ void phase_moe_up(const Params& p, int L, char* smem) {
    WAVE_IDS
    int* bs = (int*)(smem + SMEM_MAIN + 64); int* rowtok = bs + 40;
    moe_blocks(p, L, smem, bs);
    const unsigned* cnt = (const unsigned*)(WS + OFF_CNT) + L * 32; const unsigned* list = (const unsigned*)(WS + S_LIST);
    const f16* X = (const f16*)(WS + OFF_H16); f16* HB = (f16*)(WS + S_HBUF);
    const int nitems = bs[32] * 8;
    for (int item = BID; item < nitems; item += NBLK) {
        const int rbg = item >> 3, nt = item & 7;
        int e = 0; for (int i = 1; i < 32; ++i) if (bs[i] <= rbg) e = i;
        const int rb = rbg - bs[e], nrow = (int)cnt[e] - rb * 128;
        BSYNC();
        if (tid < 128) rowtok[tid] = (tid < nrow) ? (int)(list[(size_t)e * 16384 + rb * 128 + tid] >> 1) : 0;
        BSYNC();
        const f16* Wt = (const f16*)(WS + W_GU) + ((size_t)(L * 32 + e) * 1024 + nt * 128) * 1024;
        f32x4 acc[4][4];
        gemm_core<true>(acc, [&](int r) { return X + (size_t)rowtok[r] * 1024; }, [&](int r) { return Wt + (size_t)r * 1024; }, 16, smem);
#pragma unroll
        for (int m = 0; m < 4; ++m)
#pragma unroll
            for (int n = 0; n < 2; ++n) {
                f32x4 o;
#pragma unroll
                for (int q = 0; q < 4; ++q) { const float gv = acc[m][n][q]; o[q] = gv * sigmoid_(gv) * acc[m][n + 2][q]; }
                *(f16x4*)(HB + (size_t)(rbg * 128 + wr * 64 + m * 16 + fr) * 512 + nt * 64 + wc * 32 + n * 16 + 4 * fq) = cvt4(o);
            }
    }
}

__device__ __forceinline__ void phase_moe_down(const Params& p, int L, char* smem) {
    WAVE_IDS
    int* bs = (int*)(smem + SMEM_MAIN + 64); int* rowent = bs + 40;
    moe_blocks(p, L, smem, bs);
    const unsigned* cnt = (const unsigned*)(WS + OFF_CNT) + L * 32; const unsigned* list = (const unsigned*)(WS + S_LIST);
    const float* gates = (const float*)(WS + S_GATES);
    const f16* HB = (const f16*)(WS + S_HBUF); f16* FF = (f16*)(WS + S_FF16);
    const int nitems = bs[32] * 8;
    for (int item = BID; item < nitems; item += NBLK) {
        const int rbg = item >> 3, nt = item & 7;
        int e = 0; for (int i = 1; i < 32; ++i) if (bs[i] <= rbg) e = i;
        const int rb = rbg - bs[e], nrow = (int)cnt[e] - rb * 128;
        BSYNC();
        if (tid < 128) rowent[tid] = (tid < nrow) ? (int)list[(size_t)e * 16384 + rb * 128 + tid] : -1;
        BSYNC();
        const f16* Wt = (const f16*)(WS + W_D) + ((size_t)(L * 32 + e) * 1024 + nt * 128) * 512;
        f32x4 acc[4][4];
        gemm_core<true>(acc, [&](int r) { return HB + (size_t)(rbg * 128 + r) * 512; }, [&](int r) { return Wt + (size_t)r * 512; }, 8, smem);
#pragma unroll
        for (int m = 0; m < 4; ++m) {
            const int ent = rowent[wr * 64 + m * 16 + fr];
            if (ent >= 0) {
                const float gt = gates[ent];
                f16* dst = FF + ((size_t)(ent & 1) * T + (ent >> 1)) * 1024 + nt * 128 + wc * 64 + 4 * fq;
#pragma unroll
                for (int n = 0; n < 4; ++n) *(f16x4*)(dst + n * 16) = cvt4(acc[m][n] * gt);
            }
        }
    }
}

constexpr int NPHASES = 1 + 2 * 13 + 2 * 11;

__global__ void __launch_bounds__(256, 2) trunk_kernel(Params p) {
    __shared__ __attribute__((aligned(16))) char smem[SMEM_BYTES];
    volatile LAS unsigned* st = (volatile LAS unsigned*)(smem + SMEM_MAIN);
#if MEGA
    if (threadIdx.x == 0) { st[0] = 0u; st[1] = 0u; }
    BSYNC();
    const XcdBarrier xb = xcd_barrier_post((unsigned*)(WS + OFF_BAR), st);
#endif
    int ph = 0;
    char* ws = p.ws;
    f16* y16 = (f16*)(ws + S_Y32R); f16* h16 = (f16*)(ws + OFF_H16);
#ifndef ENMASK
#define ENMASK 0xFFFFFFFFu
#endif
#define EN(k) (((ENMASK) >> (k)) & 1u)
#ifndef REPMASK
#define REPMASK 0u
#endif
#ifndef REPN
#define REPN 2
#endif
#define NREP(k) ((((REPMASK) >> (k)) & 1u) ? (1 + REPN) : 1)
#if MEGA
#define STEP(k, ...) do { if (ph >= p.ph_begin && ph < p.ph_end) { if (EN(k)) { for (int rep_ = 0; rep_ < NREP(k); ++rep_) { __VA_ARGS__; } } if (ph + 1 < p.ph_end) xcd_barrier(xb); } ++ph; } while (0)
#else
#define STEP(k, ...) do { if (ph >= p.ph_begin && ph < p.ph_end) { if (EN(k)) { for (int rep_ = 0; rep_ < NREP(k); ++rep_) { __VA_ARGS__; } } } ++ph; } while (0)
#endif
    STEP(0, phase_convert(p, smem));
    for (int L = 0; L < 4; ++L) {
        const int j = L >> 1;
        const float* res32 = (L == 0) ? IN(0) : (const float*)nullptr;
        if ((L & 1) == 0) {
            STEP(1, phase_ab_in(p, j, smem); if (L == 0) phase_memkv(p, smem));
            STEP(2, phase_shift(p, j));
            STEP(3, phase_lora(p, j, smem));
            STEP(4, phase_rec_sg(p, j, L == 0, L != 0, smem));
            STEP(5, if (L != 0) phase_rw_fin_seg(p, j, smem); else { phase_rw_fin(p, j); xa_uc_reduce(p); });
            STEP(6, phase_gemm_res((const f16*)(ws + S_MIX16), (const f16*)(ws + W_ABOUT) + (size_t)j * 1024 * 1024, res32, h16, y16, (float*)(ws + S_PST1), smem));
        } else {
            STEP(7, phase_mla_in(p, j, smem));
            STEP(8, phase_mla_qkv(p, j, smem));
            STEP(9, phase_mla_attn(p, smem));
            STEP(6, phase_gemm_res((const f16*)(ws + S_MIX16), (const f16*)(ws + W_MLAOUT) + (size_t)j * 1024 * 1024, res32, h16, y16, (float*)(ws + S_PST1), smem));
        }
        STEP(11, phase_xa_scores(p, L, smem));
        STEP(12, phase_xa_out(p, L, y16, smem));
        STEP(10, phase_ln<2>(y16, nullptr, nullptr, nullptr, nullptr, IN(30) + L * 1024, IN(31) + L * 1024, nullptr, h16, nullptr));
        STEP(13, phase_router(p, L, smem));
        STEP(14, phase_moe_up(p, L, smem));
        STEP(15, phase_moe_down(p, L, smem));
        STEP(10, phase_ln<1>(y16, (const f16*)(ws + S_FF16), (const f16*)(ws + S_FF16) + (size_t)T * 1024, IN(30) + L * 1024, IN(31) + L * 1024, IN(39) + L * 1024, IN(40) + L * 1024,
                         (L == 3) ? p.out : (float*)nullptr, (L == 3) ? (f16*)nullptr : h16, nullptr));
    }
}

}

extern "C" void kernel_launch(void* const* d_in, const int* in_sizes, int n_in, void* d_out, int out_size, void* d_ws, size_t ws_size, hipStream_t stream) {
    (void)in_sizes; (void)n_in; (void)out_size; (void)ws_size;
    static int grid_blocks = 0;
    if (!grid_blocks) {
        int dev = 0, cus = 0, per_cu = 0;
        hipGetDevice(&dev);
        hipDeviceGetAttribute(&cus, hipDeviceAttributeMultiprocessorCount, dev);
        hipOccupancyMaxActiveBlocksPerMultiprocessor(&per_cu, trunk_kernel, 256, 0);
        if (per_cu > 2) per_cu = 2;
        if (per_cu < 1) per_cu = 1;
        grid_blocks = cus * per_cu;
        grid_blocks &= ~7;
    }
    Params p{};
    for (int i = 0; i < 41; ++i) p.in[i] = (const float*)d_in[i];
    p.out = (float*)d_out;
    p.ws = (char*)d_ws;
    hipMemsetAsync((char*)d_ws + OFF_BAR, 0, XCD_BAR_WORDS * 4, stream);
#if MEGA
    p.ph_begin = 0; p.ph_end = NPHASES;
    void* args[] = {&p};
    hipError_t e = hipLaunchCooperativeKernel((const void*)trunk_kernel, dim3(grid_blocks), dim3(256), args, 0, stream);
    if (e != hipSuccess) fprintf(stderr, "cooperative launch failed: %s (grid %d)\n", hipGetErrorString(e), grid_blocks);
#else
    for (int ph = 0; ph < NPHASES; ++ph) {
        p.ph_begin = ph; p.ph_end = ph + 1;
        hipLaunchKernelGGL(trunk_kernel, dim3(grid_blocks), dim3(256), 0, stream, p);
    }
#endif
}
```

```cpp
#include <hip/hip_runtime.h>
#include <stdint.h>
#include <stdio.h>

#ifndef MEGA
#define MEGA 1
#endif
#ifndef FAST_GEMM
#define FAST_GEMM 1
#endif
#ifndef FAST_REC
#define FAST_REC 1
#endif

typedef _Float16 f16;
typedef f16 f16x8 __attribute__((ext_vector_type(8)));
typedef f16 f16x4 __attribute__((ext_vector_type(4)));
typedef float f32x4 __attribute__((ext_vector_type(4)));
typedef float f32x2 __attribute__((ext_vector_type(2)));
#define LAS __attribute__((address_space(3)))

namespace {

constexpr int T = 16384, SEQ = 4096, D = 1024;
constexpr float DN_ALPHA = 1.681792830507429f;
constexpr float LOG2E = 1.4426950408889634f;

constexpr size_t al(size_t x) { return (x + 255) & ~(size_t)255; }
constexpr size_t OFF_BAR   = 0;
constexpr size_t OFF_CNT   = 16384;
constexpr size_t OFF_ROPE  = 32768;
constexpr size_t OFF_H32   = OFF_ROPE + al((size_t)SEQ * 16 * 8);
constexpr size_t OFF_H16   = OFF_H32 + al((size_t)T * D * 4);
constexpr size_t OFF_MEM16 = OFF_H16 + al((size_t)T * D * 2);
constexpr size_t OFF_KVMEM = OFF_MEM16 + al((size_t)1024 * 1024 * 2);
constexpr size_t OFF_XM    = OFF_KVMEM + al((size_t)4 * 1024 * 2048 * 2);
constexpr size_t OFF_XN    = OFF_XM + al((size_t)16 * 1024 * 1024 * 2);
constexpr size_t OFF_XUP   = OFF_XN + al((size_t)16 * 1024 * 1024 * 2);
constexpr size_t OFF_XCP   = OFF_XUP + al((size_t)16 * 1024 * 16 * 4);
constexpr size_t OFF_XU    = OFF_XCP + al((size_t)16 * 1024 * 16 * 4);
constexpr size_t OFF_XC    = OFF_XU + al((size_t)16 * 1024 * 4);
constexpr size_t W_ABIN    = OFF_XC + al((size_t)16 * 1024 * 4);
constexpr size_t W_W2T     = W_ABIN + al((size_t)2 * 2816 * 1024 * 2);
constexpr size_t W_A2T     = W_W2T + al((size_t)2 * 512 * 64 * 2);
constexpr size_t W_G2T     = W_A2T + al((size_t)2 * 512 * 64 * 2);
constexpr size_t W_SGW     = W_G2T + al((size_t)2 * 512 * 128 * 2);
constexpr size_t W_ABOUT   = W_SGW + al((size_t)2 * 4 * 128 * 128 * 2);
constexpr size_t W_MLAIN   = W_ABOUT + al((size_t)2 * 1024 * 1024 * 2);
constexpr size_t W_Q       = W_MLAIN + al((size_t)2 * 640 * 1024 * 2);
constexpr size_t W_KV      = W_Q + al((size_t)2 * 1536 * 256 * 2);
constexpr size_t W_MLAOUT  = W_KV + al((size_t)2 * 2048 * 256 * 2);
constexpr size_t W_XAQ     = W_MLAOUT + al((size_t)2 * 1024 * 1024 * 2);
constexpr size_t W_XAKV    = W_XAQ + al((size_t)4 * 1024 * 1024 * 2);
constexpr size_t W_XAO     = W_XAKV + al((size_t)4 * 2048 * 1024 * 2);
constexpr size_t W_ROUTER  = W_XAO + al((size_t)4 * 1024 * 1024 * 2);
constexpr size_t W_GU      = W_ROUTER + al((size_t)4 * 128 * 1024 * 2);
constexpr size_t W_D       = W_GU + al((size_t)4 * 32 * 1024 * 1024 * 2);
constexpr size_t OFF_SCR   = W_D + al((size_t)4 * 32 * 1024 * 512 * 2);
constexpr size_t S_P16   = OFF_SCR;
constexpr size_t S_PS16  = S_P16 + al((size_t)T * 2816 * 2);
constexpr size_t S_WD32  = S_PS16 + al((size_t)T * 1792 * 2);
constexpr size_t S_NKK   = S_WD32 + al((size_t)T * 512 * 4);
constexpr size_t S_BB    = S_NKK + al((size_t)T * 512 * 2);
constexpr size_t S_KP    = S_BB + al((size_t)T * 512 * 2);
constexpr size_t S_G16   = S_KP + al((size_t)T * 512 * 2);
constexpr size_t S_BSUM  = S_G16 + al((size_t)T * 512 * 2);
constexpr size_t S_Y32   = S_BSUM + al((size_t)T * 8 * 4);
constexpr size_t S_ZT    = S_Y32 + al((size_t)T * 512 * 4);
constexpr size_t S_MIX16 = S_ZT + al((size_t)512 * 128 * 128 * 2);
constexpr size_t S_YT    = S_MIX16 + al((size_t)T * 1024 * 2);
constexpr size_t S_SMID  = S_YT + al((size_t)T * 512 * 4);
constexpr size_t S_END_EVEN = S_SMID + al((size_t)32 * 64 * 64 * 4);
constexpr size_t S_CQKV  = OFF_SCR;
constexpr size_t S_KPE   = S_CQKV + al((size_t)T * 512 * 2);
constexpr size_t S_Q16   = S_KPE + al((size_t)T * 32 * 2);
constexpr size_t S_KN16  = S_Q16 + al((size_t)T * 1536 * 2);
constexpr size_t S_VT16  = S_KN16 + al((size_t)T * 1024 * 2);
constexpr size_t S_SSQ   = S_VT16 + al((size_t)T * 1024 * 2);
constexpr size_t S_END_ODD = S_SSQ + al((size_t)T * 8 * 4);
constexpr size_t S_XP16  = OFF_SCR;
constexpr size_t S_XLP   = S_XP16 + al((size_t)T * 1024 * 2);
constexpr size_t S_XSTAT = S_XLP + al((size_t)T * 16 * 4);
constexpr size_t S_PST1  = S_XSTAT + al((size_t)T * 2 * 4);
constexpr size_t S_LIST  = OFF_SCR;
constexpr size_t S_GATES = S_LIST + al((size_t)32 * 16384 * 4);
constexpr size_t S_HBUF  = S_GATES + al((size_t)T * 2 * 4);
constexpr size_t S_FF16  = S_HBUF + al((size_t)36864 * 512 * 2);
constexpr size_t S_END_MOE = S_FF16 + al((size_t)2 * T * 1024 * 2);
constexpr size_t S_Y32R  = OFF_SCR + (size_t)128 * 1024 * 1024;
static_assert(S_Y32R + (size_t)T * 1024 * 4 <= S_MIX16, "y32 overlay");
static_assert(S_END_ODD <= S_MIX16, "odd overlay");
static_assert(S_END_MOE <= S_MIX16, "moe overlay");
static_assert(S_END_EVEN <= (size_t)1024 * 1024 * 1024, "workspace");

constexpr int SMEM_MAIN = 65536;
constexpr int SMEM_BYTES = SMEM_MAIN + 2048;

struct Params {
    const float* in[41];
    float* out;
    char* ws;
    int ph_begin, ph_end;
};

__device__ __forceinline__ int opq_s(int x) { asm volatile("" : "+v"(x)); return __builtin_amdgcn_readfirstlane(x); }
__device__ __forceinline__ int opq_v(int x) { asm volatile("" : "+v"(x)); return x; }
#define TID opq_v((int)threadIdx.x)
#define BID opq_s((int)blockIdx.x)
#define NBLK opq_s((int)gridDim.x)
__device__ __forceinline__ const float* opq_p(const float* q) {
    const uint64_t u = (uint64_t)q; uint32_t lo = (uint32_t)u, hi = (uint32_t)(u >> 32);
    asm volatile("" : "+v"(lo), "+v"(hi));
    lo = __builtin_amdgcn_readfirstlane(lo); hi = __builtin_amdgcn_readfirstlane(hi);
    return (const float*)(((uint64_t)hi << 32) | lo);
}
typedef const __attribute__((address_space(4))) Params* KargPtr;
__device__ __forceinline__ KargPtr kparams() {
    const uint64_t u = (uint64_t)__builtin_amdgcn_kernarg_segment_ptr(); uint32_t lo = (uint32_t)u, hi = (uint32_t)(u >> 32);
    asm volatile("" : "+v"(lo), "+v"(hi));
    lo = __builtin_amdgcn_readfirstlane(lo); hi = __builtin_amdgcn_readfirstlane(hi);
    return (KargPtr)(((uint64_t)hi << 32) | lo);
}
#define IN(k) (kparams()->in[k])
#define WS (kparams()->ws)

__device__ __forceinline__ float sigmoid_(float x) { return 1.0f / (1.0f + __expf(-x)); }
__device__ __forceinline__ float tanh_(float x) { return 1.0f - 2.0f / (1.0f + __expf(2.0f * x)); }
__device__ __forceinline__ float gelu_(float x) { const float u = 0.7978845608028654f * (x + 0.044715f * x * x * x); return 0.5f * x * (1.0f + tanh_(u)); }
__device__ __forceinline__ float dpp_ror(float x, int) { return x; }
__device__ __forceinline__ float row16_sum(float x) {
    x += __builtin_bit_cast(float, __builtin_amdgcn_update_dpp(0, __builtin_bit_cast(int, x), 0x128, 0xf, 0xf, false));
    x += __builtin_bit_cast(float, __builtin_amdgcn_update_dpp(0, __builtin_bit_cast(int, x), 0x124, 0xf, 0xf, false));
    x += __builtin_bit_cast(float, __builtin_amdgcn_update_dpp(0, __builtin_bit_cast(int, x), 0x122, 0xf, 0xf, false));
    x += __builtin_bit_cast(float, __builtin_amdgcn_update_dpp(0, __builtin_bit_cast(int, x), 0x121, 0xf, 0xf, false));
    return x;
}
__device__ __forceinline__ float wave_sum(float x) {
    x += __shfl_xor(x, 32); x += __shfl_xor(x, 16); x += __shfl_xor(x, 8); x += __shfl_xor(x, 4); x += __shfl_xor(x, 2); x += __shfl_xor(x, 1);
    return x;
}
__device__ __forceinline__ f16x4 cvt4(f32x4 v) { return __builtin_convertvector(v, f16x4); }
__device__ __forceinline__ f32x4 cvt4f(f16x4 v) { return __builtin_convertvector(v, f32x4); }

#define BSYNC() do { asm volatile("s_waitcnt lgkmcnt(0)" ::: "memory"); __syncthreads(); } while (0)

#define XB_TMO      128
#define XB_XCNT(j)  (256  + 64 * (j))
#define XB_XSUB(j)  (1280 + 64 * (j))
#define XB_XGEN(j)  (2304 + 64 * (j))
#define XB_TOP      3328
#define XB_TOPGEN   3392
#define XCD_BAR_WORDS 3456
#define XB_SPIN_CAP (1u << 22)
__device__ __forceinline__ unsigned xb_ld(unsigned* p) { return __hip_atomic_load(p, __ATOMIC_RELAXED, __HIP_MEMORY_SCOPE_AGENT); }
__device__ __forceinline__ unsigned xb_add(unsigned* p, unsigned v) { return __hip_atomic_fetch_add(p, v, __ATOMIC_RELAXED, __HIP_MEMORY_SCOPE_AGENT); }
__device__ __forceinline__ unsigned xb_xcc_id() { return (unsigned)__builtin_amdgcn_s_getreg((3 << 11) | 20) & 0xFu; }
#define XB_SPIN(cond, bar) do { unsigned _sp = 0; while (cond) { __builtin_amdgcn_s_sleep(1); \
    if ((++_sp & 255u) == 0u) { if (xb_ld(&(bar)[XB_TMO])) break; if (_sp > XB_SPIN_CAP) { atomicAdd(&(bar)[XB_TMO], 1u); break; } } } } while (0)
struct XcdBarrier { unsigned* bar; unsigned x; volatile LAS unsigned* st; };
__device__ __forceinline__ XcdBarrier xcd_barrier_post(unsigned* bar, volatile LAS unsigned* st) {
    XcdBarrier b; b.bar = bar; b.x = xb_xcc_id(); b.st = st;
    if (threadIdx.x == 0) (void)xb_add(&bar[XB_XCNT(b.x)], 1u);
    return b;
}
__device__ __forceinline__ void xcd_barrier_complete(unsigned* bar, unsigned x, unsigned& nloc, unsigned& nx) {
    const unsigned G = gridDim.x;
    unsigned sum, cnt, mine, sp = 0u;
    for (;;) {
        sum = 0u; cnt = 0u; mine = 0u;
#pragma unroll
        for (unsigned j = 0; j < 16; ++j) { const unsigned c = xb_ld(&bar[XB_XCNT(j)]); sum += c; cnt += (c > 0u) ? 1u : 0u; mine = (j == x) ? c : mine; }
        if (sum == G) break;
        __builtin_amdgcn_s_sleep(1);
        if ((++sp & 255u) == 0u) { if (xb_ld(&bar[XB_TMO])) break; if (sp > XB_SPIN_CAP) { atomicAdd(&bar[XB_TMO], 1u); break; } }
    }
    nloc = mine > 0u ? mine : 1u; nx = cnt > 0u ? cnt : 1u;
}
__device__ __forceinline__ void xcd_barrier(const XcdBarrier& b) {
    asm volatile("s_waitcnt vmcnt(0)" ::: "memory");
    __syncthreads();
    if (threadIdx.x == 0) {
        unsigned* bar = b.bar;
        __builtin_amdgcn_s_waitcnt(0);
        unsigned nloc = b.st[0], nx = b.st[1];
        if (nloc == 0u) { xcd_barrier_complete(bar, b.x, nloc, nx); b.st[0] = nloc; b.st[1] = nx; }
        const unsigned old = xb_add(&bar[XB_XSUB(b.x)], 1u);
        const unsigned gen = old / nloc;
        if (old + 1u == (gen + 1u) * nloc) {
            __builtin_amdgcn_fence(__ATOMIC_RELEASE, "agent");
            asm volatile("s_waitcnt vmcnt(0)" ::: "memory");
            const unsigned og = xb_add(&bar[XB_TOP], 1u);
            const unsigned tg = og / nx;
            if (og + 1u == (tg + 1u) * nx) xb_add(&bar[XB_TOPGEN], 1u);
            else XB_SPIN(xb_ld(&bar[XB_TOPGEN]) == tg, bar);
            __builtin_amdgcn_fence(__ATOMIC_ACQUIRE, "agent");
            xb_add(&bar[XB_XGEN(b.x)], 1u);
            asm volatile("s_waitcnt vmcnt(0)" ::: "memory");
        } else {
            XB_SPIN(xb_ld(&bar[XB_XGEN(b.x)]) == gen, bar);
            __builtin_amdgcn_fence(__ATOMIC_ACQUIRE, "agent");
            asm volatile("s_waitcnt vmcnt(0)" ::: "memory");
        }
    }
    __syncthreads();
}

#define GEMM_STEP_ORDERED(bs) do { \
        f16x8 xa[4], wa[4], xb[4], wb[4]; \
        _Pragma("unroll") for (int m = 0; m < 4; ++m) xa[m] = *(const f16x8*)((bs) + xoff + m * 2048 + rd0); \
        _Pragma("unroll") for (int n = 0; n < 4; ++n) wa[n] = *(const f16x8*)((bs) + woff + n * 2048 + rd0); \
        _Pragma("unroll") for (int m = 0; m < 4; ++m) xb[m] = *(const f16x8*)((bs) + xoff + m * 2048 + rd1); \
        _Pragma("unroll") for (int n = 0; n < 4; ++n) wb[n] = *(const f16x8*)((bs) + woff + n * 2048 + rd1); \
        __builtin_amdgcn_sched_barrier(0); \
        _Pragma("unroll") for (int m = 0; m < 4; ++m) _Pragma("unroll") for (int n = 0; n < 4; ++n) \
            acc[m][n] = TRANS ? __builtin_amdgcn_mfma_f32_16x16x32_f16(wa[n], xa[m], acc[m][n], 0, 0, 0) : __builtin_amdgcn_mfma_f32_16x16x32_f16(xa[m], wa[n], acc[m][n], 0, 0, 0); \
        _Pragma("unroll") for (int m = 0; m < 4; ++m) _Pragma("unroll") for (int n = 0; n < 4; ++n) \
            acc[m][n] = TRANS ? __builtin_amdgcn_mfma_f32_16x16x32_f16(wb[n], xb[m], acc[m][n], 0, 0, 0) : __builtin_amdgcn_mfma_f32_16x16x32_f16(xb[m], wb[n], acc[m][n], 0, 0, 0); \
        __builtin_amdgcn_sched_barrier(0); \
    } while (0)
struct NoSeg { __device__ __forceinline__ void operator()(int, f32x4 (&)[4][4]) const {} };
template <bool TRANS, class XR, class WR, class SEG = NoSeg>
__device__ __forceinline__ void gemm_core(f32x4 (&acc)[4][4], XR xrow, WR wrow, const int nk, char* smem, SEG seg = SEG()) {
    const int tid = TID, lane = tid & 63, wid = tid >> 6, wr = wid >> 1, wc = wid & 1, fr = lane & 15, fq = lane >> 4;
#pragma unroll
    for (int m = 0; m < 4; ++m)
#pragma unroll
        for (int n = 0; n < 4; ++n) acc[m][n] = (f32x4){0.f, 0.f, 0.f, 0.f};
#if FAST_GEMM
    const int sc = ((tid & 7) ^ ((tid >> 4) & 7)) * 8;
    const f16* px[4]; const f16* pw[4];
#pragma unroll
    for (int i = 0; i < 4; ++i) { px[i] = xrow((tid >> 3) + 32 * i) + sc; pw[i] = wrow((tid >> 3) + 32 * i) + sc; }
    const int rd0 = ((0 * 4 + fq) ^ (fr >> 1)) * 16, rd1 = ((1 * 4 + fq) ^ (fr >> 1)) * 16;
    const int xoff = (wr * 64 + fr) * 128, woff = 16384 + (wc * 64 + fr) * 128;
    BSYNC();
    auto stage = [&](int kt, int s) {
        char* base = smem + s * 32768 + tid * 16;
#pragma unroll
        for (int i = 0; i < 4; ++i) {
            __builtin_amdgcn_global_load_lds((const void*)(px[i] + kt * 64), (LAS void*)(base + i * 4096), 16, 0, 0);
            __builtin_amdgcn_global_load_lds((const void*)(pw[i] + kt * 64), (LAS void*)(base + 16384 + i * 4096), 16, 0, 0);
        }
    };
    stage(0, 0);
    for (int kt = 0; kt < nk; ++kt) {
        const int s = kt & 1;
        asm volatile("s_waitcnt vmcnt(0)" ::: "memory");
        BSYNC();
        __builtin_amdgcn_sched_barrier(0);
        if (kt + 1 < nk) stage(kt + 1, s ^ 1);
        __builtin_amdgcn_sched_barrier(0);
        seg(kt, acc);
        const char* bs = smem + s * 32768;
        GEMM_STEP_ORDERED(bs);
    }
#else
    float* ctile = (float*)smem;
    BSYNC();
    for (int i = 0; i < 64; ++i) {
        const int idx = tid + 256 * i, r = idx >> 7, c = idx & 127;
        const f16* xp = xrow(r); const f16* wp = wrow(c);
        float s = 0.f;
        for (int k = 0; k < nk * 64; k += 8) {
            const f16x8 a = *(const f16x8*)(xp + k), b = *(const f16x8*)(wp + k);
#pragma unroll
            for (int e = 0; e < 8; ++e) s += (float)a[e] * (float)b[e];
        }
        ctile[idx] = s;
    }
    BSYNC();
#pragma unroll
    for (int m = 0; m < 4; ++m)
#pragma unroll
        for (int n = 0; n < 4; ++n)
#pragma unroll
            for (int j = 0; j < 4; ++j)
                acc[m][n][j] = TRANS ? ctile[(wr * 64 + m * 16 + fr) * 128 + wc * 64 + n * 16 + 4 * fq + j] : ctile[(wr * 64 + m * 16 + 4 * fq + j) * 128 + wc * 64 + n * 16 + fr];
    BSYNC();
#endif
}

template <class TR> __device__ __forceinline__ void row_stats_table(const float* pst, TR tokrow, float* srow) {
    const int tid = TID;
    float su = 0.f, sq = 0.f;
    if (tid < 128) {
        const float* ps = pst + (size_t)tokrow(tid) * 32;
#pragma unroll
        for (int i = 0; i < 8; ++i) { const f32x4 v = *(const f32x4*)(ps + i * 4); su += v[0] + v[2]; sq += v[1] + v[3]; }
    }
    BSYNC();
    if (tid < 128) {
        const float mean = su * (1.0f / 1024.0f), var = fmaxf(sq * (1.0f / 1024.0f) - mean * mean, 0.f);
        srow[tid * 2] = mean; srow[tid * 2 + 1] = rsqrtf(var + 1e-5f);
    }
}

struct GPipe { int staged, b0; };
template <bool TRANS, class XP, class WP, class SEG = NoSeg>
__device__ __forceinline__ void gemm_core_pf(f32x4 (&acc)[4][4], XP xp, WP wp, int rt, int ct, const int nk, bool has_next, int nrt, int nct, GPipe& gp,
                                             char* smem, SEG seg = SEG()) {
    const int tid = TID, lane = tid & 63, wid = tid >> 6, wr = wid >> 1, wc = wid & 1, fr = lane & 15, fq = lane >> 4;
#pragma unroll
    for (int m = 0; m < 4; ++m)
#pragma unroll
        for (int n = 0; n < 4; ++n) acc[m][n] = (f32x4){0.f, 0.f, 0.f, 0.f};
    const int sc = ((tid & 7) ^ ((tid >> 4) & 7)) * 8;
    const f16* px[4]; const f16* pw[4];
#pragma unroll
    for (int i = 0; i < 4; ++i) { px[i] = xp(rt, ct, (tid >> 3) + 32 * i) + sc; pw[i] = wp(rt, ct, (tid >> 3) + 32 * i) + sc; }
    const int rd0 = ((0 * 4 + fq) ^ (fr >> 1)) * 16, rd1 = ((1 * 4 + fq) ^ (fr >> 1)) * 16;
    const int xoff = (wr * 64 + fr) * 128, woff = 16384 + (wc * 64 + fr) * 128;
    auto stage = [&](int kt, int s) {
        char* base = smem + s * 32768 + tid * 16;
#pragma unroll
        for (int i = 0; i < 4; ++i) {
            __builtin_amdgcn_global_load_lds((const void*)(px[i] + kt * 64), (LAS void*)(base + i * 4096), 16, 0, 0);
            __builtin_amdgcn_global_load_lds((const void*)(pw[i] + kt * 64), (LAS void*)(base + 16384 + i * 4096), 16, 0, 0);
        }
    };
    if (!gp.staged) { BSYNC(); gp.b0 = 0; stage(0, 0); }
    const int b0 = gp.b0;
    for (int kt = 0; kt < nk; ++kt) {
        const int s = (kt + b0) & 1;
        asm volatile("s_waitcnt vmcnt(0)" ::: "memory");
        BSYNC();
        __builtin_amdgcn_sched_barrier(0);
        if (kt + 1 < nk) stage(kt + 1, s ^ 1);
        else if (has_next) {
            char* base = smem + (s ^ 1) * 32768 + tid * 16;
#pragma unroll
            for (int i = 0; i < 4; ++i) {
                __builtin_amdgcn_global_load_lds((const void*)(xp(nrt, nct, (tid >> 3) + 32 * i) + sc), (LAS void*)(base + i * 4096), 16, 0, 0);
                __builtin_amdgcn_global_load_lds((const void*)(wp(nrt, nct, (tid >> 3) + 32 * i) + sc), (LAS void*)(base + 16384 + i * 4096), 16, 0, 0);
            }
        }
        __builtin_amdgcn_sched_barrier(0);
        seg(kt, acc);
        const char* bs = smem + s * 32768;
        GEMM_STEP_ORDERED(bs);
    }
    gp.staged = has_next ? 1 : 0; gp.b0 = ((nk - 1 + b0) & 1) ^ 1;
}

template <class F> __device__ __forceinline__ void tile_loop2(int nrt, int nct, F f) {
    const int xcd = BID & 7, lb = BID >> 3, nlb = NBLK >> 3;
    const int per = (nrt >> 3) * nct;
    for (int j = lb; j < per; j += nlb) {
        const int jn = j + nlb; const bool hn = jn < per; const int je = hn ? jn : j;
        f(((j / nct) << 3) + xcd, j % nct, hn, ((je / nct) << 3) + xcd, je % nct);
    }
}

template <class F> __device__ __forceinline__ void tile_loop(int nrt, int nct, F f) {
    const int xcd = BID & 7, lb = BID >> 3, nlb = NBLK >> 3;
    const int per = (nrt >> 3) * nct;
    for (int j = lb; j < per; j += nlb) f(((j / nct) << 3) + xcd, j % nct);
}

#define WAVE_IDS const int tid = TID, lane = tid & 63, wid = tid >> 6, wr = wid >> 1, wc = wid & 1, fr = lane & 15, fq = lane >> 4; (void)lane; (void)wid; (void)wr; (void)wc; (void)fr; (void)fq;

template <class RowMap, class KScale>
__device__ __forceinline__ void conv_T(const float* src, f16* dst, int nbatch, int K, int N, size_t src_bs, size_t dst_bs, int ldd, RowMap rowmap, KScale kscale, int& off, float* tile, int myid, int G) {
    const int tk = K / 64, tn = (N + 63) / 64, total = nbatch * tk * tn, t = TID;
    int start = (myid - off) % G; if (start < 0) start += G;
    auto load = [&](int i, f32x4 (&v)[4]) {
        const int bi = i / (tk * tn), r = i % (tk * tn), k0 = (r / tn) * 64, n0 = (r % tn) * 64;
#pragma unroll
        for (int j = 0; j < 4; ++j) {
            const int k = (t >> 4) + 16 * j, c = (t & 15) * 4;
            v[j] = (f32x4){0.f, 0.f, 0.f, 0.f};
            if (i < total && n0 + c < N) v[j] = *(const f32x4*)(src + (size_t)bi * src_bs + (size_t)(k0 + k) * N + n0 + c);
        }
    };
    f32x4 va[4], vb[4];
    load(start, va); load(start + G, vb);
    for (int i = start; i < total; i += G) {
        const int bi = i / (tk * tn), r = i % (tk * tn), k0 = (r / tn) * 64, n0 = (r % tn) * 64;
        BSYNC();
#pragma unroll
        for (int j = 0; j < 4; ++j) {
            const int k = (t >> 4) + 16 * j, c = (t & 15) * 4;
            const float s = kscale(k0 + k);
            tile[k * 65 + c + 0] = va[j][0] * s; tile[k * 65 + c + 1] = va[j][1] * s; tile[k * 65 + c + 2] = va[j][2] * s; tile[k * 65 + c + 3] = va[j][3] * s;
        }
#pragma unroll
        for (int j = 0; j < 4; ++j) va[j] = vb[j];
        load(i + 2 * G, vb);
        BSYNC();
        const int n = t >> 2, kc = (t & 3) * 16;
        if (n0 + n < N) {
            f16x8 o0, o1;
#pragma unroll
            for (int j = 0; j < 8; ++j) { o0[j] = (f16)tile[(kc + j) * 65 + n]; o1[j] = (f16)tile[(kc + 8 + j) * 65 + n]; }
            f16* dp = dst + (size_t)bi * dst_bs + (size_t)rowmap(n0 + n) * ldd + k0 + kc;
            *(f16x8*)dp = o0; *(f16x8*)(dp + 8) = o1;
        }
    }
    off = (off + total) % G;
}

__device__ __forceinline__ void phase_convert(const Params& p, char* smem) {
    char* ws = WS;
    float* tile = (float*)smem;
    const int gtid = BID * 256 + TID, gsz = NBLK * 256;
    int off = 0;
    const int cb = BID, cn = NBLK;
    auto ident = [](int n) { return n; };
    auto one = [](int) { return 1.0f; };
    {
        const float* x = IN(0); f16* h16 = (f16*)(ws + OFF_H16);
        for (size_t i = gtid; i < (size_t)T * D / 4; i += gsz) *(f16x4*)(h16 + i * 4) = cvt4(*(const f32x4*)(x + i * 4));
        const float* mem = IN(1); f16* m16 = (f16*)(ws + OFF_MEM16);
        for (size_t i = gtid; i < (size_t)1024 * 1024 / 4; i += gsz) *(f16x4*)(m16 + i * 4) = cvt4(*(const f32x4*)(mem + i * 4));
    }
    {
        const float* w = IN(16); f16* o = (f16*)(ws + W_SGW);
        for (int i = gtid; i < 2 * 4 * 128 * 128; i += gsz) { const int s = i & 127, tt = (i >> 7) & 127; o[i] = (s <= tt) ? (f16)w[i] : (f16)0.f; }
    }
    {
        f32x2* rt = (f32x2*)(ws + OFF_ROPE);
        for (int i = gtid; i < SEQ * 16; i += gsz) {
            const int pos = i >> 4, fi = i & 15;
            const double inv = exp2(-(double)fi * (13.287712379549449 / 16.0));
            double rev = (double)pos * inv * 0.15915494309189535;
            rev -= floor(rev);
            const float fr_ = (float)rev;
            rt[i] = (f32x2){__builtin_amdgcn_cosf(fr_), __builtin_amdgcn_sinf(fr_)};
        }
    }
    {
        unsigned* cnt = (unsigned*)(ws + OFF_CNT);
        if (gtid < 128) cnt[gtid] = 0u;
        f16* wr_ = (f16*)(ws + W_ROUTER);
        for (int i = gtid; i < 4 * 92 * 1024; i += gsz) { const int l = i / (92 * 1024), r = i % (92 * 1024); wr_[(size_t)l * 128 * 1024 + 36 * 1024 + r] = (f16)0.f; }
        f16* wm = (f16*)(ws + W_MLAIN);
        for (int i = gtid; i < 2 * 96 * 1024; i += gsz) { const int l = i / (96 * 1024), r = i % (96 * 1024); wm[(size_t)l * 640 * 1024 + 544 * 1024 + r] = (f16)0.f; }
    }
    conv_T(IN(2), (f16*)(ws + W_ABIN), 2, 1024, 2816, (size_t)1024 * 2816, (size_t)2816 * 1024, 1024, ident, one, off, tile, cb, cn);
    conv_T(IN(5), (f16*)(ws + W_W2T), 2, 64, 512, (size_t)64 * 512, (size_t)512 * 64, 64, ident, one, off, tile, cb, cn);
    conv_T(IN(7), (f16*)(ws + W_A2T), 2, 64, 512, (size_t)64 * 512, (size_t)512 * 64, 64, ident, one, off, tile, cb, cn);
    conv_T(IN(8), (f16*)(ws + W_G2T), 2, 128, 512, (size_t)128 * 512, (size_t)512 * 128, 128, ident, one, off, tile, cb, cn);
    conv_T(IN(18), (f16*)(ws + W_ABOUT), 2, 1024, 1024, (size_t)1024 * 1024, (size_t)1024 * 1024, 1024, ident, one, off, tile, cb, cn);
    conv_T(IN(19), (f16*)(ws + W_MLAIN), 2, 1024, 544, (size_t)1024 * 544, (size_t)640 * 1024, 1024, ident, one, off, tile, cb, cn);
    for (int l = 0; l < 2; ++l) {
        const float* qn = IN(20) + l * 256; const float* kvn = IN(21) + l * 256;
        const float qs = 0.10206207261596577f * LOG2E;
        conv_T(IN(22) + (size_t)l * 256 * 1536, (f16*)(ws + W_Q) + (size_t)l * 1536 * 256, 1, 256, 1536, 0, 0, 256, ident, [=](int k) { return qn[k] * qs; }, off, tile, cb, cn);
        conv_T(IN(23) + (size_t)l * 256 * 2048, (f16*)(ws + W_KV) + (size_t)l * 2048 * 256, 1, 256, 2048, 0, 0, 256,
               [](int n) { const int h = n >> 7, j = n & 127; return j < 64 ? h * 64 + j : 1024 + h * 64 + (j - 64); }, [=](int k) { return kvn[k]; }, off, tile, cb, cn);
    }
    conv_T(IN(24), (f16*)(ws + W_MLAOUT), 2, 1024, 1024, (size_t)1024 * 1024, (size_t)1024 * 1024, 1024, ident, one, off, tile, cb, cn);
    {
        const float* w = IN(27); f16* o = (f16*)(ws + W_XAQ); const float sc = 0.0625f * LOG2E;
        for (size_t i = gtid; i < (size_t)4 * 1024 * 1024 / 4; i += gsz) *(f16x4*)(o + i * 4) = cvt4(*(const f32x4*)(w + i * 4) * sc);
    }
    conv_T(IN(28), (f16*)(ws + W_XAKV), 4, 1024, 2048, (size_t)1024 * 2048, (size_t)2048 * 1024, 1024, ident, one, off, tile, cb, cn);
    conv_T(IN(29), (f16*)(ws + W_XAO), 4, 1024, 1024, (size_t)1024 * 1024, (size_t)1024 * 1024, 1024, ident, one, off, tile, cb, cn);
    conv_T(IN(32), (f16*)(ws + W_ROUTER), 4, 1024, 4, (size_t)1024 * 4, (size_t)128 * 1024, 1024, ident, one, off, tile, cb, cn);
    conv_T(IN(34), (f16*)(ws + W_ROUTER), 4, 1024, 32, (size_t)1024 * 32, (size_t)128 * 1024, 1024, [](int n) { return n + 4; }, one, off, tile, cb, cn);
}

__device__ __forceinline__ void convert_moe(const Params& p, char* smem, int cb, int cn, int part) {
    char* ws = WS;
    float* tile = (float*)smem;
    int off = 0;
    auto ident = [](int n) { return n; };
    auto one = [](int) { return 1.0f; };
    const int b0 = part ? 96 : 0, nbt = part ? 32 : 96;
    conv_T(IN(36) + (size_t)b0 * 1024 * 512, (f16*)(ws + W_GU) + (size_t)b0 * 1024 * 1024, nbt, 1024, 512, (size_t)1024 * 512, (size_t)1024 * 1024, 1024,
           [](int n) { return (n >> 6) * 128 + ((n >> 5) & 1) * 64 + (n & 31); }, one, off, tile, cb, cn);
    conv_T(IN(37) + (size_t)b0 * 1024 * 512, (f16*)(ws + W_GU) + (size_t)b0 * 1024 * 1024, nbt, 1024, 512, (size_t)1024 * 512, (size_t)1024 * 1024, 1024,
           [](int n) { return (n >> 6) * 128 + ((n >> 5) & 1) * 64 + 32 + (n & 31); }, one, off, tile, cb, cn);
    if (part) return;
    conv_T(IN(38), (f16*)(ws + W_D), 128, 512, 1024, (size_t)512 * 1024, (size_t)1024 * 512, 512, ident, one, off, tile, cb, cn);
}

template <int MODE>
__device__ __forceinline__ void phase_ln(const f16* src, const f16* ff0, const f16* ff1, const float* gp, const float* bp, const float* g, const float* b,
                                         float* dst32, f16* dst16, float* stat) {
    const int lane = TID & 63, gw = BID * 4 + (TID >> 6), nw = NBLK * 4;
    for (int row = gw; row < T; row += nw) {
        f32x4 v[4]; float s = 0.f;
#pragma unroll
        for (int i = 0; i < 4; ++i) {
            v[i] = cvt4f(*(const f16x4*)(src + (size_t)row * D + i * 256 + lane * 4));
            s += (v[i][0] + v[i][1]) + (v[i][2] + v[i][3]);
        }
        float mean = wave_sum(s) * (1.0f / 1024.0f);
        float q = 0.f;
#pragma unroll
        for (int i = 0; i < 4; ++i) { const f32x4 d = v[i] - mean; q += (d[0] * d[0] + d[1] * d[1]) + (d[2] * d[2] + d[3] * d[3]); }
        float rstd = rsqrtf(wave_sum(q) * (1.0f / 1024.0f) + 1e-5f);
        if (MODE == 1) {
            s = 0.f;
#pragma unroll
            for (int i = 0; i < 4; ++i) {
                const int c = i * 256 + lane * 4; const size_t o = (size_t)row * D + c;
                const f32x4 h2 = (v[i] - mean) * rstd * *(const f32x4*)(gp + c) + *(const f32x4*)(bp + c);
                v[i] = h2 * DN_ALPHA + cvt4f(*(const f16x4*)(ff0 + o)) + cvt4f(*(const f16x4*)(ff1 + o));
                s += (v[i][0] + v[i][1]) + (v[i][2] + v[i][3]);
            }
            mean = wave_sum(s) * (1.0f / 1024.0f);
            q = 0.f;
#pragma unroll
            for (int i = 0; i < 4; ++i) { const f32x4 d = v[i] - mean; q += (d[0] * d[0] + d[1] * d[1]) + (d[2] * d[2] + d[3] * d[3]); }
            rstd = rsqrtf(wave_sum(q) * (1.0f / 1024.0f) + 1e-5f);
        }
        if (MODE == 0 && lane == 0) *(f32x2*)(stat + (size_t)row * 2) = (f32x2){mean, rstd};
#pragma unroll
        for (int i = 0; i < 4; ++i) {
            const int c = i * 256 + lane * 4; const size_t o = (size_t)row * D + c;
            const f32x4 y = (v[i] - mean) * rstd * *(const f32x4*)(g + c) + *(const f32x4*)(b + c);
            if (MODE == 1 && dst32) *(f32x4*)(dst32 + o) = y;
            if (dst16) *(f16x4*)(dst16 + o) = cvt4(y);
        }
    }
}

__device__ __forceinline__ void phase_gemm_res(const f16* X, const f16* Wt, const float* res32, const f16* res16, f16* y16, float* pst, char* smem) {
    WAVE_IDS
    GPipe gp{0, 0};
    tile_loop2(128, 8, [&](int rt, int ct, bool hn, int nrt, int nct) {
        float su[4] = {0.f, 0.f, 0.f, 0.f}, sq[4] = {0.f, 0.f, 0.f, 0.f};
        f32x4 acc[4][4];
        gemm_core_pf<true>(acc, [&](int a, int, int r) { return X + (size_t)(a * 128 + r) * 1024; }, [&](int, int c, int r) { return Wt + (size_t)(c * 128 + r) * 1024; },
                           rt, ct, 16, hn, nrt, nct, gp, smem);
#pragma unroll
        for (int m = 0; m < 4; ++m)
#pragma unroll
            for (int n = 0; n < 4; ++n) {
                const size_t o = (size_t)(rt * 128 + wr * 64 + m * 16 + fr) * 1024 + ct * 128 + wc * 64 + n * 16 + 4 * fq;
                const f32x4 r4 = res32 ? *(const f32x4*)(res32 + o) : cvt4f(*(const f16x4*)(res16 + o));
                const f16x4 y4 = cvt4(r4 * DN_ALPHA + acc[m][n]);
                *(f16x4*)(y16 + o) = y4;
                const f32x4 yr = cvt4f(y4);
                su[m] += (yr[0] + yr[1]) + (yr[2] + yr[3]); sq[m] += (yr[0] * yr[0] + yr[1] * yr[1]) + (yr[2] * yr[2] + yr[3] * yr[3]);
            }
#pragma unroll
        for (int m = 0; m < 4; ++m) {
            float a = su[m], q = sq[m];
            a += __shfl_xor(a, 16); a += __shfl_xor(a, 32); q += __shfl_xor(q, 16); q += __shfl_xor(q, 32);
            if (fq == 0) *(f32x2*)(pst + ((size_t)(rt * 128 + wr * 64 + m * 16 + fr) * 16 + ct * 2 + wc) * 2) = (f32x2){a, q};
        }
    });
}

__device__ __forceinline__ void phase_xa_out(const Params& p, int L, f16* y16, char* smem) {
    WAVE_IDS
    const f16* XP = (const f16*)(WS + S_XP16); const float* LP = (const float*)(WS + S_XLP); const float* PST = (const float*)(WS + S_PST1);
    const float* g1 = IN(25) + L * 1024; const float* b1 = IN(26) + L * 1024;
    float* srow = (float*)(smem + SMEM_MAIN + 1024);
    GPipe gp{0, 0};
    const f16* XNb = (const f16*)(WS + OFF_XN) + (size_t)(L * 4) * 1024 * 1024;
    tile_loop2(128, 8, [&](int rt, int ct, bool hn, int nrt, int nct) {
        row_stats_table(PST, [&](int r) { return rt * 128 + r; }, srow);
        float ratio[4][4];
#pragma unroll
        for (int m = 0; m < 4; ++m) {
            const float* lp = LP + (size_t)(rt * 128 + wr * 64 + m * 16 + fr) * 16;
            float l[4];
#pragma unroll
            for (int h = 0; h < 4; ++h) { const f32x4 v = *(const f32x4*)(lp + 4 * h); l[h] = (v[0] + v[1]) + (v[2] + v[3]); }
            ratio[m][0] = l[1] / l[0]; ratio[m][1] = l[2] / l[1]; ratio[m][2] = l[3] / l[2]; ratio[m][3] = 1.0f / l[3];
        }
        f32x4 acc[4][4];
        gemm_core_pf<true>(acc, [&](int a, int, int r) { return XP + (size_t)(a * 128 + r) * 1024; },
            [&](int a, int c, int r) { return XNb + (size_t)(a >> 5) * 1024 * 1024 + (size_t)(c * 128 + r) * 1024; }, rt, ct, 16, hn, nrt, nct, gp, smem,
            [&](int kt, f32x4 (&a)[4][4]) {
                if (kt == 4 || kt == 8 || kt == 12) {
#pragma unroll
                    for (int m = 0; m < 4; ++m) {
                        const float sc = kt == 4 ? ratio[m][0] : (kt == 8 ? ratio[m][1] : ratio[m][2]);
#pragma unroll
                        for (int n = 0; n < 4; ++n) a[m][n] = a[m][n] * sc;
                    }
                }
            });
        f32x4 gv[4], bv[4];
#pragma unroll
        for (int n = 0; n < 4; ++n) { const int c = ct * 128 + wc * 64 + n * 16 + 4 * fq; gv[n] = *(const f32x4*)(g1 + c); bv[n] = *(const f32x4*)(b1 + c); }
#pragma unroll
        for (int m = 0; m < 4; ++m) {
            const int row = rt * 128 + wr * 64 + m * 16 + fr;
            const f32x2 st = *(const f32x2*)(srow + (wr * 64 + m * 16 + fr) * 2);
#pragma unroll
            for (int n = 0; n < 4; ++n) {
                const size_t o = (size_t)row * 1024 + ct * 128 + wc * 64 + n * 16 + 4 * fq;
                const f32x4 hres = (cvt4f(*(const f16x4*)(y16 + o)) - st[0]) * st[1] * gv[n] + bv[n];
                *(f16x4*)(y16 + o) = cvt4(hres * DN_ALPHA + acc[m][n] * ratio[m][3]);
            }
        }
    });
}

__device__ __forceinline__ void phase_memkv(const Params& p, char* smem) {
    WAVE_IDS
    const f16* mem16 = (const f16*)(WS + OFF_MEM16);
    for (int item = BID; item < 4 * 8 * 16; item += NBLK) {
        const int L = item >> 7, rt = (item >> 4) & 7, ct = item & 15;
        const f16* Wt = (const f16*)(WS + W_XAKV) + (size_t)L * 2048 * 1024;
        f16* kv = (f16*)(WS + OFF_KVMEM) + (size_t)L * 1024 * 2048;
        f32x4 acc[4][4];
        gemm_core<true>(acc, [&](int r) { return mem16 + (size_t)(rt * 128 + r) * 1024; }, [&](int r) { return Wt + (size_t)(ct * 128 + r) * 1024; }, 16, smem);
#pragma unroll
        for (int m = 0; m < 4; ++m)
#pragma unroll
            for (int n = 0; n < 4; ++n)
                *(f16x4*)(kv + (size_t)(rt * 128 + wr * 64 + m * 16 + fr) * 2048 + ct * 128 + wc * 64 + n * 16 + 4 * fq) = cvt4(acc[m][n]);
    }
}

__device__ __forceinline__ void xa_pre_item(const Params& p, int item, char* smem) {
    WAVE_IDS
    const int ct = item & 7, rt = (item >> 3) & 7, which = (item >> 6) & 1, b = (item >> 7) & 3, L = item >> 9;
    const f16* kv = (const f16*)(WS + OFF_KVMEM) + (size_t)L * 1024 * 2048;
    f32x4 acc[4][4];
    f16* out;
    if (which == 0) {
        const int hd = rt >> 1, key0 = (rt & 1) * 128;
        const f16* wq = (const f16*)(WS + W_XAQ) + (size_t)L * 1024 * 1024;
        gemm_core<true>(acc, [&](int r) { return kv + (size_t)(b * 256 + key0 + r) * 2048 + hd * 256; }, [&](int r) { return wq + (size_t)(ct * 128 + r) * 1024 + hd * 256; }, 4, smem);
        out = (f16*)(WS + OFF_XM) + (size_t)(L * 4 + b) * 1024 * 1024;
    } else {
        const int hd = ct >> 1, key0 = (ct & 1) * 128;
        const f16* wo = (const f16*)(WS + W_XAO) + (size_t)L * 1024 * 1024;
        gemm_core<true>(acc, [&](int r) { return wo + (size_t)(rt * 128 + r) * 1024 + hd * 256; }, [&](int r) { return kv + (size_t)(b * 256 + key0 + r) * 2048 + 1024 + hd * 256; }, 4, smem);
        out = (f16*)(WS + OFF_XN) + (size_t)(L * 4 + b) * 1024 * 1024;
    }
    if (which == 0) {
        const float* g1 = IN(25) + L * 1024; const float* b1 = IN(26) + L * 1024;
        float* up = (float*)(WS + OFF_XUP) + (size_t)(L * 4 + b) * 1024 * 16; float* cp = (float*)(WS + OFF_XCP) + (size_t)(L * 4 + b) * 1024 * 16;
#pragma unroll
        for (int m = 0; m < 4; ++m) {
            const int row = rt * 128 + wr * 64 + m * 16 + fr;
            float us = 0.f, cs = 0.f;
#pragma unroll
            for (int n = 0; n < 4; ++n) {
                const int k = ct * 128 + wc * 64 + n * 16 + 4 * fq;
                const f16x4 xm = cvt4(acc[m][n] * *(const f32x4*)(g1 + k));
                *(f16x4*)(out + (size_t)row * 1024 + k) = xm;
                const f32x4 xr = cvt4f(xm), cb = acc[m][n] * *(const f32x4*)(b1 + k);
                us += (xr[0] + xr[1]) + (xr[2] + xr[3]); cs += (cb[0] + cb[1]) + (cb[2] + cb[3]);
            }
            us += __shfl_xor(us, 16); us += __shfl_xor(us, 32); cs += __shfl_xor(cs, 16); cs += __shfl_xor(cs, 32);
            if (fq == 0) { up[(size_t)row * 16 + ct * 2 + wc] = us; cp[(size_t)row * 16 + ct * 2 + wc] = cs; }
        }
        return;
    }
#pragma unroll
    for (int m = 0; m < 4; ++m)
#pragma unroll
        for (int n = 0; n < 4; ++n)
            *(f16x4*)(out + (size_t)(rt * 128 + wr * 64 + m * 16 + fr) * 1024 + ct * 128 + wc * 64 + n * 16 + 4 * fq) = cvt4(acc[m][n]);
}

__device__ __forceinline__ void xa_uc_reduce(const Params& p) {
    const float* up = (const float*)(WS + OFF_XUP); const float* cp = (const float*)(WS + OFF_XCP);
    float* xu = (float*)(WS + OFF_XU); float* xc = (float*)(WS + OFF_XC);
    for (int i = BID * 256 + TID; i < 16 * 1024; i += NBLK * 256) {
        float a = 0.f, c = 0.f;
#pragma unroll
        for (int q4 = 0; q4 < 4; ++q4) { const f32x4 v = *(const f32x4*)(up + (size_t)i * 16 + q4 * 4), w = *(const f32x4*)(cp + (size_t)i * 16 + q4 * 4); a += (v[0] + v[1]) + (v[2] + v[3]); c += (w[0] + w[1]) + (w[2] + w[3]); }
        xu[i] = a; xc[i] = c;
    }
}

__device__ __forceinline__ void phase_ab_in(const Params& p, int j, char* smem) {
    WAVE_IDS
    const f16* X = (const f16*)(WS + OFF_H16);
    const f16* Wt = (const f16*)(WS + W_ABIN) + (size_t)j * 2816 * 1024;
    f16* P = (f16*)(WS + S_P16);
    GPipe gp{0, 0};
    tile_loop2(128, 22, [&](int rt, int ct, bool hn, int nrt, int nct) {
        f32x4 acc[4][4];
        gemm_core_pf<true>(acc, [&](int a, int, int r) { return X + (size_t)(a * 128 + r) * 1024; }, [&](int, int c, int r) { return Wt + (size_t)(c * 128 + r) * 1024; },
                           rt, ct, 16, hn, nrt, nct, gp, smem);
#pragma unroll
        for (int m = 0; m < 4; ++m)
#pragma unroll
            for (int n = 0; n < 4; ++n)
                *(f16x4*)(P + (size_t)(rt * 128 + wr * 64 + m * 16 + fr) * 2816 + ct * 128 + wc * 64 + n * 16 + 4 * fq) = cvt4(acc[m][n]);
    });
}

__device__ __forceinline__ void phase_shift(const Params& p, int j) {
    const f16* P = (const f16*)(WS + S_P16); f16* PS = (f16*)(WS + S_PS16);
    const float* mu = IN(3) + j * 1792;
    const int total = T * 224;
    for (int i = BID * 256 + TID; i < total; i += NBLK * 256) {
        const int t = i / 224, c = (i % 224) * 8;
        const f16x8 cur = *(const f16x8*)(P + (size_t)t * 2816 + c);
        f16x8 prv; for (int e = 0; e < 8; ++e) prv[e] = (f16)0.f;
        if ((t & (SEQ - 1)) != 0) prv = *(const f16x8*)(P + (size_t)(t - 1) * 2816 + c);
        f16x8 o;
        const f32x4 mu0 = *(const f32x4*)(mu + c), mu1 = *(const f32x4*)(mu + c + 4);
#pragma unroll
        for (int e = 0; e < 8; ++e) {
            const float a = (float)cur[e]; float v = a + ((float)prv[e] - a) * (e < 4 ? mu0[e & 3] : mu1[e & 3]);
            if (c >= 1536 && c < 1600) v = tanh_(v);
            else if (c >= 1664) v = sigmoid_(v);
            o[e] = (f16)v;
        }
        *(f16x8*)(PS + (size_t)t * 1792 + c) = o;
    }
}

__device__ __forceinline__ void phase_lora(const Params& p, int j, char* smem) {
    WAVE_IDS
    const f16* PS = (const f16*)(WS + S_PS16);
    float* WD = (float*)(WS + S_WD32); f16* NKK = (f16*)(WS + S_NKK); f16* BB = (f16*)(WS + S_BB); f16* KP = (f16*)(WS + S_KP);
    f16* G16 = (f16*)(WS + S_G16); float* BSUM = (float*)(WS + S_BSUM);
    const float* w0 = IN(4) + j * 512; const float* a0 = IN(6) + j * 512; const float* k_k = IN(9) + j * 512; const float* k_a = IN(10) + j * 512; const float* r_k = IN(11) + j * 512;
    GPipe gp{0, 0};
    const f16* Wl0 = (const f16*)(WS + W_W2T) + (size_t)j * 512 * 64; const f16* Wl1 = (const f16*)(WS + W_A2T) + (size_t)j * 512 * 64;
    const f16* Wl2 = (const f16*)(WS + W_G2T) + (size_t)j * 512 * 128;
    tile_loop2(128, 12, [&](int rt, int ct, bool hn, int nrt, int nct) {
        const int type = ct >> 2, c4 = ct & 3;
        f32x4 acc[4][4];
        gemm_core_pf<true>(acc, [&](int a, int c, int r) { const int ty = c >> 2; return PS + (size_t)(a * 128 + r) * 1792 + (ty == 0 ? 1536 : (ty == 1 ? 1600 : 1664)); },
                           [&](int, int c, int r) { const int ty = c >> 2, cc = c & 3; return ty == 0 ? Wl0 + (size_t)(cc * 128 + r) * 64 : (ty == 1 ? Wl1 + (size_t)(cc * 128 + r) * 64 : Wl2 + (size_t)(cc * 128 + r) * 128); },
                           rt, ct, type == 2 ? 2 : 1, hn, nrt, nct, gp, smem);
        if (type == 0) {
#pragma unroll
            for (int m = 0; m < 4; ++m)
#pragma unroll
                for (int n = 0; n < 4; ++n) {
                    const int row = rt * 128 + wr * 64 + m * 16 + fr, col = c4 * 128 + wc * 64 + n * 16 + 4 * fq;
                    f32x4 o;
#pragma unroll
                    for (int e = 0; e < 4; ++e) {
                        const float z = -(w0[col + e] + acc[m][n][e]);
                        const float sp = fmaxf(z, 0.f) + __logf(1.0f + __expf(-fabsf(z)));
                        o[e] = __expf(-__expf(-sp - 0.5f));
                    }
                    *(f32x4*)(WD + (size_t)row * 512 + col) = o;
                }
        } else if (type == 1) {
            const int head = c4 * 2 + wc;
#pragma unroll
            for (int m = 0; m < 4; ++m) {
                const int row = rt * 128 + wr * 64 + m * 16 + fr;
                f32x4 av[4], kv[4], kr[4];
                float ss = 0.f, bs = 0.f;
#pragma unroll
                for (int n = 0; n < 4; ++n) {
                    const int col = head * 64 + n * 16 + 4 * fq;
                    const f32x4 kk_ = cvt4f(*(const f16x4*)(PS + (size_t)row * 1792 + 512 + col));
                    const f32x4 rr = cvt4f(*(const f16x4*)(PS + (size_t)row * 1792 + col));
#pragma unroll
                    for (int e = 0; e < 4; ++e) {
                        const float a = sigmoid_(a0[col + e] + acc[m][n][e]);
                        const float kraw = kk_[e] * k_k[col + e];
                        const float kp = kk_[e] * (1.0f + (a - 1.0f) * k_a[col + e]);
                        av[n][e] = a; kr[n][e] = kraw; kv[n][e] = kp;
                        ss += kraw * kraw; bs += rr[e] * kp * r_k[col + e];
                    }
                }
                ss += __shfl_xor(ss, 16); ss += __shfl_xor(ss, 32);
                bs += __shfl_xor(bs, 16); bs += __shfl_xor(bs, 32);
                const float inv = 1.0f / fmaxf(sqrtf(ss), 1e-12f);
#pragma unroll
                for (int n = 0; n < 4; ++n) {
                    const int col = head * 64 + n * 16 + 4 * fq;
                    f32x4 nk_, bb_;
#pragma unroll
                    for (int e = 0; e < 4; ++e) { const float kkn = kr[n][e] * inv; nk_[e] = -kkn; bb_[e] = kkn * av[n][e]; }
                    *(f16x4*)(NKK + (size_t)row * 512 + col) = cvt4(nk_);
                    *(f16x4*)(BB + (size_t)row * 512 + col) = cvt4(bb_);
                    *(f16x4*)(KP + (size_t)row * 512 + col) = cvt4(kv[n]);
                }
                if (fq == 0) BSUM[(size_t)row * 8 + head] = bs;
            }
        } else {
#pragma unroll
            for (int m = 0; m < 4; ++m)
#pragma unroll
                for (int n = 0; n < 4; ++n)
                    *(f16x4*)(G16 + (size_t)(rt * 128 + wr * 64 + m * 16 + fr) * 512 + c4 * 128 + wc * 64 + n * 16 + 4 * fq) = cvt4(acc[m][n]);
        }
    });
}

#if FAST_REC
constexpr int NREC = 128;
constexpr int SEG_C0 = 76;
__device__ __forceinline__ void rwkv_rec(const Params& p, int bh, int q, int c0, int nc, int part, bool wr_end, char* smem) {
    const int tid = TID, lane = tid & 63, wid = tid >> 6;
    const int b = bh >> 3, h = bh & 7;
    const int rl = lane >> 4, ks = lane & 15, vrow = wid * 4 + rl;
    const float* WD = (const float*)(WS + S_WD32); const f16* NKK = (const f16*)(WS + S_NKK); const f16* BB = (const f16*)(WS + S_BB);
    const f16* KP = (const f16*)(WS + S_KP); const f16* PS = (const f16*)(WS + S_PS16); float* Y = (float*)(WS + (part == 2 ? S_YT : S_Y32));
    float* sW = (float*)smem; float* sN = sW + 32 * 64; float* sB = sN + 32 * 64; float* sK = sB + 32 * 64; float* sWR = sK + 32 * 64;
    float* sV = sWR + 32 * 64; float* sS = sV + 32 * 16; float* sY = sS + 32 * 2;
    const size_t tb = (size_t)b * SEQ + (size_t)c0 * 32;
    f32x4 pw0, pw1; f16x8 pn, pb, pk, pr, pv;
    const int pst = tid >> 3, pc8 = tid & 7;
    auto prefetch = [&](int c) {
        const size_t t0 = tb + c * 32;
        const size_t o = (t0 + pst) * 512 + h * 64 + pc8 * 8;
        pw0 = *(const f32x4*)(WD + o); pw1 = *(const f32x4*)(WD + o + 4);
        pn = *(const f16x8*)(NKK + o); pb = *(const f16x8*)(BB + o); pk = *(const f16x8*)(KP + o); pr = *(const f16x8*)(PS + (t0 + pst) * 1792 + h * 64 + pc8 * 8);
        if (tid < 64) { const int st = tid >> 1, hf = tid & 1; pv = *(const f16x8*)(PS + (t0 + st) * 1792 + 1024 + h * 64 + q * 16 + hf * 8); }
    };
    f32x4 S = {0.f, 0.f, 0.f, 0.f};
    if (part == 2) {
#pragma unroll
        for (int e = 0; e < 4; ++e) S[e] = (4 * ks + e == q * 16 + vrow) ? 1.0f : 0.0f;
    }
    BSYNC();
    prefetch(0);
    for (int c = 0; c < nc; ++c) {
        BSYNC();
        if (c > 0) {
#pragma unroll
            for (int i = 0; i < 2; ++i) { const int e = tid + 256 * i, st = e >> 4, r = e & 15; Y[(tb + (c - 1) * 32 + st) * 512 + h * 64 + q * 16 + r] = sY[e]; }
        }
        {
            const int o = tid * 8;
            float br = 0.f, kr = 0.f;
            f32x4 wr0, wr1, n0, n1, b0, b1, k0, k1;
#pragma unroll
            for (int e = 0; e < 4; ++e) {
                const float r0 = (float)pr[e], r1 = (float)pr[4 + e];
                n0[e] = (float)pn[e]; n1[e] = (float)pn[4 + e]; b0[e] = (float)pb[e]; b1[e] = (float)pb[4 + e]; k0[e] = (float)pk[e]; k1[e] = (float)pk[4 + e];
                wr0[e] = pw0[e] * r0; wr1[e] = pw1[e] * r1;
                br += b0[e] * r0 + b1[e] * r1; kr += k0[e] * r0 + k1[e] * r1;
            }
            *(f32x4*)(sW + o) = pw0; *(f32x4*)(sW + o + 4) = pw1; *(f32x4*)(sN + o) = n0; *(f32x4*)(sN + o + 4) = n1;
            *(f32x4*)(sB + o) = b0; *(f32x4*)(sB + o + 4) = b1; *(f32x4*)(sK + o) = k0; *(f32x4*)(sK + o + 4) = k1;
            *(f32x4*)(sWR + o) = wr0; *(f32x4*)(sWR + o + 4) = wr1;
            br += __shfl_xor(br, 1); br += __shfl_xor(br, 2); br += __shfl_xor(br, 4);
            kr += __shfl_xor(kr, 1); kr += __shfl_xor(kr, 2); kr += __shfl_xor(kr, 4);
            if (pc8 == 0) { sS[pst * 2] = br; sS[pst * 2 + 1] = kr; }
            if (tid < 64) {
#pragma unroll
                for (int e = 0; e < 8; ++e) sV[tid * 8 + e] = (part == 2) ? 0.0f : (float)pv[e];
            }
        }
        BSYNC();
        if (c + 1 < nc) prefetch(c + 1);
        float y0 = 0.f, y1 = 0.f;
        f32x4 w4 = *(const f32x4*)(sW + ks * 4), n4 = *(const f32x4*)(sN + ks * 4), b4 = *(const f32x4*)(sB + ks * 4);
        f32x4 k4 = *(const f32x4*)(sK + ks * 4), q4 = *(const f32x4*)(sWR + ks * 4);
        float vv = sV[vrow]; f32x2 sc = *(const f32x2*)(sS);
#pragma unroll
        for (int s = 0; s < 32; ++s) {
            f32x4 w4n = w4, n4n = n4, b4n = b4, k4n = k4, q4n = q4; float vvn = vv; f32x2 scn = sc;
            if (s + 1 < 32) {
                w4n = *(const f32x4*)(sW + (s + 1) * 64 + ks * 4); n4n = *(const f32x4*)(sN + (s + 1) * 64 + ks * 4); b4n = *(const f32x4*)(sB + (s + 1) * 64 + ks * 4);
                k4n = *(const f32x4*)(sK + (s + 1) * 64 + ks * 4); q4n = *(const f32x4*)(sWR + (s + 1) * 64 + ks * 4);
                vvn = sV[(s + 1) * 16 + vrow]; scn = *(const f32x2*)(sS + (s + 1) * 2);
            }
            __builtin_amdgcn_sched_barrier(0);
            float d1 = fmaf(S[3], n4[3], fmaf(S[2], n4[2], fmaf(S[1], n4[1], S[0] * n4[0])));
            float d2 = fmaf(S[3], q4[3], fmaf(S[2], q4[2], fmaf(S[1], q4[1], S[0] * q4[0])));
            d1 = row16_sum(d1); d2 = row16_sum(d2);
            const float y = d2 + d1 * sc[0] + vv * sc[1];
            S = S * w4 + (b4 * d1 + k4 * vv);
            if (s < 16) y0 = (ks == s) ? y : y0; else y1 = (ks == s - 16) ? y : y1;
            __builtin_amdgcn_sched_barrier(0);
            w4 = w4n; n4 = n4n; b4 = b4n; k4 = k4n; q4 = q4n; vv = vvn; sc = scn;
        }
        sY[ks * 16 + vrow] = y0; sY[(16 + ks) * 16 + vrow] = y1;
    }
    BSYNC();
#pragma unroll
    for (int i = 0; i < 2; ++i) { const int e = tid + 256 * i, st = e >> 4, r = e & 15; Y[(tb + (size_t)(nc - 1) * 32 + st) * 512 + h * 64 + q * 16 + r] = sY[e]; }
    if (wr_end) *(f32x4*)((float*)(WS + S_SMID) + ((size_t)bh * 64 + q * 16 + vrow) * 64 + ks * 4) = S;
}
#else
constexpr int NREC = 8;
__device__ __forceinline__ void rwkv_rec(const Params& p, int rb, char*) {
    const int gt = rb * 256 + TID, bh = gt >> 6, v = gt & 63, b = bh >> 3, h = bh & 7;
    const float* WD = (const float*)(WS + S_WD32); const f16* NKK = (const f16*)(WS + S_NKK); const f16* BB = (const f16*)(WS + S_BB);
    const f16* KP = (const f16*)(WS + S_KP); const f16* PS = (const f16*)(WS + S_PS16); float* Y = (float*)(WS + S_Y32);
    float S[64];
#pragma unroll
    for (int k = 0; k < 64; ++k) S[k] = 0.f;
    for (int s = 0; s < SEQ; ++s) {
        const size_t t = (size_t)b * SEQ + s, o = t * 512 + h * 64;
        const float vv = (float)PS[t * 1792 + 1024 + h * 64 + v];
        float sa = 0.f;
#pragma unroll
        for (int k8 = 0; k8 < 8; ++k8) { const f16x8 n8 = *(const f16x8*)(NKK + o + k8 * 8);
#pragma unroll
            for (int e = 0; e < 8; ++e) sa += S[k8 * 8 + e] * (float)n8[e]; }
        float y = 0.f;
#pragma unroll
        for (int k8 = 0; k8 < 8; ++k8) {
            const f16x8 b8 = *(const f16x8*)(BB + o + k8 * 8), kp8 = *(const f16x8*)(KP + o + k8 * 8), r8 = *(const f16x8*)(PS + t * 1792 + h * 64 + k8 * 8);
            const f32x4 wa = *(const f32x4*)(WD + o + k8 * 8), wb = *(const f32x4*)(WD + o + k8 * 8 + 4);
#pragma unroll
            for (int e = 0; e < 8; ++e) {
                const float w = e < 4 ? wa[e & 3] : wb[e & 3];
                const float sn = S[k8 * 8 + e] * w + (sa * (float)b8[e] + vv * (float)kp8[e]);
                S[k8 * 8 + e] = sn; y += sn * (float)r8[e];
            }
        }
        Y[t * 512 + h * 64 + v] = y;
    }
}
#endif

__device__ __forceinline__ void sg_item(const Params& p, int j, int item, char* smem) {
    WAVE_IDS
    const int g = item & 3, bc = item >> 2;
    const f16* P = (const f16*)(WS + S_P16);
    f16* ZT = (f16*)(WS + S_ZT) + (size_t)item * 128 * 128;
    const float* lg = IN(14) + (j * 4 + g) * 128; const float* lb = IN(15) + (j * 4 + g) * 128;
    {
        const int sub = tid & 15, rloc = tid >> 4;
        for (int it = 0; it < 8; ++it) {
            const int s = it * 16 + rloc;
            const f16x8 x = *(const f16x8*)(P + (size_t)(bc * 128 + s) * 2816 + 2304 + g * 128 + sub * 8);
            float z[8], sum = 0.f;
#pragma unroll
            for (int e = 0; e < 8; ++e) { z[e] = gelu_((float)x[e]); sum += z[e]; }
            const float mean = row16_sum(sum) * (1.0f / 128.0f);
            float qq = 0.f;
#pragma unroll
            for (int e = 0; e < 8; ++e) { const float d = z[e] - mean; qq += d * d; }
            const float rstd = rsqrtf(row16_sum(qq) * (1.0f / 128.0f) + 1e-5f);
#pragma unroll
            for (int e = 0; e < 8; ++e) { const int d = sub * 8 + e; ZT[(size_t)d * 128 + s] = (f16)((z[e] - mean) * rstd * lg[d] + lb[d]); }
        }
    }
    asm volatile("s_waitcnt vmcnt(0)" ::: "memory");
    BSYNC();
    const f16* Wm = (const f16*)(WS + W_SGW) + (size_t)(j * 4 + g) * 128 * 128;
    f32x4 acc[4][4];
    gemm_core<true>(acc, [&](int r) { return Wm + (size_t)r * 128; }, [&](int r) { return (const f16*)ZT + (size_t)r * 128; }, 2, smem);
    const float* bs = IN(17) + (j * 4 + g) * 128;
    f16* MIX = (f16*)(WS + S_MIX16);
#pragma unroll
    for (int m = 0; m < 4; ++m)
#pragma unroll
        for (int n = 0; n < 4; ++n) {
            const int tl = wr * 64 + m * 16 + fr, d = wc * 64 + n * 16 + 4 * fq;
            const size_t t = (size_t)bc * 128 + tl;
            const f32x4 u = cvt4f(*(const f16x4*)(P + t * 2816 + 1792 + g * 128 + d));
            f32x4 o;
#pragma unroll
            for (int e = 0; e < 4; ++e) o[e] = gelu_(u[e]) * (acc[m][n][e] + bs[tl]);
            *(f16x4*)(MIX + t * 1024 + 512 + g * 128 + d) = cvt4(o);
        }
}

__device__ __forceinline__ void phase_rec_sg(const Params& p, int j, bool pre, bool segmode, char* smem) {
#if FAST_REC
    const int bid = BID, nb = NBLK;
    if (!segmode) {
        const bool isrec = (bid < 256) && (((bid >> 3) & 1) == 0);
        if (isrec) { const int u = ((bid >> 4) << 3) | (bid & 7); rwkv_rec(p, u >> 2, u & 3, 0, 128, 0, false, smem); }
        else {
            const int sgi = (bid < 256) ? (((bid >> 4) << 3) | (bid & 7)) : (bid - 128);
            for (int item = sgi; item < 512; item += nb - 128) sg_item(p, j, item, smem);
            if (pre) {
                for (int item = sgi; item < 2048; item += nb - 128) xa_pre_item(p, item, smem);
                BSYNC();
                convert_moe(p, smem, sgi, nb - 128, 0);
            }
        }
    } else {
        const int nrec = (nb * 3) >> 2;
        if (bid < nrec) {
            for (int v = bid; v < 384; v += nrec) {
                int bh, q, part;
                if (v >= 128 && v < 256) { const int u = v - 128; bh = u >> 2; q = u & 3; part = 0; }
                else { const int u = (v < 128) ? v : v - 128; bh = u >> 3; q = u & 3; part = 1 + ((u >> 2) & 1); }
                rwkv_rec(p, bh, q, part == 0 ? 0 : SEG_C0, part == 0 ? SEG_C0 : 128 - SEG_C0, part == 2 ? 2 : 0, part == 0, smem);
            }
        } else {
            for (int item = bid - nrec; item < 512; item += nb - nrec) sg_item(p, j, item, smem);
            BSYNC();
            convert_moe(p, smem, bid - nrec, nb - nrec, 1);
        }
    }
#else
    if (BID < NREC) rwkv_rec(p, BID, smem);
    else {
        for (int item = BID - NREC; item < 512; item += NBLK - NREC) sg_item(p, j, item, smem);
        if (pre) { for (int item = BID - NREC; item < 2048; item += NBLK - NREC) xa_pre_item(p, item, smem); BSYNC(); convert_moe(p, smem, BID - NREC, NBLK - NREC, 0); convert_moe(p, smem, BID - NREC, NBLK - NREC, 1); }
    }
#endif
}

__device__ __forceinline__ void phase_rw_fin_seg(const Params& p, int j, char* smem) {
    const int tid = TID, tl = tid >> 2, vq = tid & 3;
    const float* Y = (const float*)(WS + S_Y32); const float* YT = (const float*)(WS + S_YT); const float* SM = (const float*)(WS + S_SMID);
    const f16* PS = (const f16*)(WS + S_PS16); const f16* G16 = (const f16*)(WS + S_G16);
    const float* BSUM = (const float*)(WS + S_BSUM); f16* MIX = (f16*)(WS + S_MIX16);
    const float* gg = IN(12) + j * 512; const float* gb = IN(13) + j * 512;
    float* sST = (float*)smem;
    float* sYT = sST + 64 * 64;
    for (int item = BID; item < 2048; item += NBLK) {
        const int bh = item >> 6, tile = item & 63, b = bh >> 3, h = bh & 7;
        const size_t t = (size_t)b * SEQ + tile * 64 + tl;
        const int c = h * 64 + vq * 16;
        float y[16];
#pragma unroll
        for (int i4 = 0; i4 < 4; ++i4) { const f32x4 v4 = *(const f32x4*)(Y + t * 512 + c + i4 * 4); y[i4 * 4] = v4[0]; y[i4 * 4 + 1] = v4[1]; y[i4 * 4 + 2] = v4[2]; y[i4 * 4 + 3] = v4[3]; }
        if (tile >= SEG_C0 / 2) {
            BSYNC();
            {
                const int v = tid >> 2, i0 = (tid & 3) * 16;
#pragma unroll
                for (int i4 = 0; i4 < 4; ++i4) { const f32x4 v4 = *(const f32x4*)(SM + ((size_t)bh * 64 + v) * 64 + i0 + i4 * 4);
#pragma unroll
                    for (int e = 0; e < 4; ++e) sST[(i0 + i4 * 4 + e) * 64 + v] = v4[e]; }
#pragma unroll
                for (int i4 = 0; i4 < 4; ++i4) { const f32x4 v4 = *(const f32x4*)(YT + t * 512 + c + i4 * 4);
#pragma unroll
                    for (int e = 0; e < 4; ++e) sYT[tl * 65 + vq * 16 + i4 * 4 + e] = v4[e]; }
            }
            BSYNC();
            for (int i = 0; i < 64; ++i) {
                const float a = sYT[tl * 65 + i];
#pragma unroll
                for (int i4 = 0; i4 < 4; ++i4) { const f32x4 s4 = *(const f32x4*)(sST + i * 64 + vq * 16 + i4 * 4);
                    y[i4 * 4] += a * s4[0]; y[i4 * 4 + 1] += a * s4[1]; y[i4 * 4 + 2] += a * s4[2]; y[i4 * 4 + 3] += a * s4[3]; }
            }
        }
        float sum = 0.f;
#pragma unroll
        for (int e = 0; e < 16; ++e) sum += y[e];
        sum += __shfl_xor(sum, 1); sum += __shfl_xor(sum, 2);
        const float mean = sum * (1.0f / 64.0f);
        float qq = 0.f;
#pragma unroll
        for (int e = 0; e < 16; ++e) { const float d = y[e] - mean; qq += d * d; }
        qq += __shfl_xor(qq, 1); qq += __shfl_xor(qq, 2);
        const float rstd = rsqrtf(qq * (1.0f / 64.0f) + 64e-5f);
        const float bsum = BSUM[t * 8 + h];
#pragma unroll
        for (int hf = 0; hf < 2; ++hf) {
            const f16x8 v8 = *(const f16x8*)(PS + t * 1792 + 1024 + c + hf * 8), g8 = *(const f16x8*)(G16 + t * 512 + c + hf * 8);
            f16x8 o;
#pragma unroll
            for (int e = 0; e < 8; ++e) {
                const float r = ((y[hf * 8 + e] - mean) * rstd * gg[c + hf * 8 + e] + gb[c + hf * 8 + e] + bsum * (float)v8[e]) * (float)g8[e];
                o[e] = (f16)r;
            }
            *(f16x8*)(MIX + t * 1024 + c + hf * 8) = o;
        }
    }
}

__device__ __forceinline__ void phase_rw_fin(const Params& p, int j) {
    const int lane = TID & 63, gw = BID * 4 + (TID >> 6), nw = NBLK * 4;
    const float* Y = (const float*)(WS + S_Y32); const f16* PS = (const f16*)(WS + S_PS16); const f16* G16 = (const f16*)(WS + S_G16);
    const float* BSUM = (const float*)(WS + S_BSUM); f16* MIX = (f16*)(WS + S_MIX16);
    const float* gg = IN(12) + j * 512; const float* gb = IN(13) + j * 512;
    for (int t = gw; t < T; t += nw) {
        const int c = lane * 8, head = lane >> 3;
        const f32x4 y0 = *(const f32x4*)(Y + (size_t)t * 512 + c), y1 = *(const f32x4*)(Y + (size_t)t * 512 + c + 4);
        float s = (y0[0] + y0[1]) + (y0[2] + y0[3]) + (y1[0] + y1[1]) + (y1[2] + y1[3]);
        s += __shfl_xor(s, 1); s += __shfl_xor(s, 2); s += __shfl_xor(s, 4);
        const float mean = s * (1.0f / 64.0f);
        float qq = 0.f;
#pragma unroll
        for (int e = 0; e < 4; ++e) { const float d0 = y0[e] - mean, d1 = y1[e] - mean; qq += d0 * d0 + d1 * d1; }
        qq += __shfl_xor(qq, 1); qq += __shfl_xor(qq, 2); qq += __shfl_xor(qq, 4);
        const float rstd = rsqrtf(qq * (1.0f / 64.0f) + 64e-5f);
        const float bsum = BSUM[(size_t)t * 8 + head];
        const f16x8 v8 = *(const f16x8*)(PS + (size_t)t * 1792 + 1024 + c), g8 = *(const f16x8*)(G16 + (size_t)t * 512 + c);
        f16x8 o;
#pragma unroll
        for (int e = 0; e < 8; ++e) {
            const float yv = e < 4 ? y0[e & 3] : y1[e & 3];
            const float r = ((yv - mean) * rstd * gg[c + e] + gb[c + e] + bsum * (float)v8[e]) * (float)g8[e];
            o[e] = (f16)r;
        }
        *(f16x8*)(MIX + (size_t)t * 1024 + c) = o;
    }
}

__device__ __forceinline__ void phase_mla_in(const Params& p, int j, char* smem) {
    WAVE_IDS
    const f16* X = (const f16*)(WS + OFF_H16);
    const f16* Wt = (const f16*)(WS + W_MLAIN) + (size_t)j * 640 * 1024;
    f16* CQKV = (f16*)(WS + S_CQKV); f16* KPE = (f16*)(WS + S_KPE); float* SSQ = (float*)(WS + S_SSQ);
    const f32x2* rope = (const f32x2*)(WS + OFF_ROPE);
    GPipe gp{0, 0};
    tile_loop2(128, 5, [&](int rt, int ct, bool hn, int nrt, int nct) {
        f32x4 acc[4][4];
        gemm_core_pf<true>(acc, [&](int a, int, int r) { return X + (size_t)(a * 128 + r) * 1024; }, [&](int, int c, int r) { return Wt + (size_t)(c * 128 + r) * 1024; },
                           rt, ct, 16, hn, nrt, nct, gp, smem);
        if (ct < 4) {
#pragma unroll
            for (int m = 0; m < 4; ++m) {
                const int row = rt * 128 + wr * 64 + m * 16 + fr;
                float ss = 0.f;
#pragma unroll
                for (int n = 0; n < 4; ++n) {
                    *(f16x4*)(CQKV + (size_t)row * 512 + ct * 128 + wc * 64 + n * 16 + 4 * fq) = cvt4(acc[m][n]);
                    const f32x4 a = acc[m][n]; ss += (a[0] * a[0] + a[1] * a[1]) + (a[2] * a[2] + a[3] * a[3]);
                }
                ss += __shfl_xor(ss, 16); ss += __shfl_xor(ss, 32);
                if (fq == 0) SSQ[(size_t)row * 8 + ct * 2 + wc] = ss;
            }
        } else if (wc == 0) {
#pragma unroll
            for (int m = 0; m < 4; ++m) {
                const int row = rt * 128 + wr * 64 + m * 16 + fr, pos = row & (SEQ - 1);
                f32x4 o1, o2;
#pragma unroll
                for (int e = 0; e < 4; ++e) {
                    const f32x2 cs = rope[pos * 16 + 4 * fq + e];
                    const float x1 = acc[m][0][e], x2 = acc[m][1][e];
                    o1[e] = x1 * cs[0] - x2 * cs[1]; o2[e] = x1 * cs[1] + x2 * cs[0];
                }
                *(f16x4*)(KPE + (size_t)row * 32 + 4 * fq) = cvt4(o1);
                *(f16x4*)(KPE + (size_t)row * 32 + 16 + 4 * fq) = cvt4(o2);
            }
        }
    });
}

__device__ __forceinline__ void phase_mla_qkv(const Params& p, int j, char* smem) {
    WAVE_IDS
    const f16* CQKV = (const f16*)(WS + S_CQKV);
    f16* Q16 = (f16*)(WS + S_Q16); f16* KN = (f16*)(WS + S_KN16); f16* VT = (f16*)(WS + S_VT16);
    const f32x2* rope = (const f32x2*)(WS + OFF_ROPE);
    const float* SSQ = (const float*)(WS + S_SSQ);
    GPipe gp{0, 0};
    const f16* Wqb = (const f16*)(WS + W_Q) + (size_t)j * 1536 * 256; const f16* Wkvb = (const f16*)(WS + W_KV) + (size_t)j * 2048 * 256;
    auto xpf = [&](int a, int c, int r) { return CQKV + (size_t)(a * 128 + r) * 512 + (c < 12 ? 0 : 256); };
    auto wpf = [&](int, int c, int r) { return c < 12 ? Wqb + (size_t)(c * 128 + r) * 256 : Wkvb + (size_t)((c - 12) * 128 + r) * 256; };
    tile_loop2(128, 28, [&](int rt, int ct, bool hn, int nrt, int nct) {
        const bool isq = ct < 12;
        auto rrow = [&](int rl) { const f32x4 q4 = *(const f32x4*)(SSQ + (size_t)(rt * 128 + rl) * 8 + (isq ? 0 : 4)); return rsqrtf(((q4[0] + q4[1]) + (q4[2] + q4[3])) * (1.0f / 256.0f) + 1e-6f); };
        f32x4 acc[4][4];
        if (isq) {
            gemm_core_pf<true>(acc, xpf, wpf, rt, ct, 4, hn, nrt, nct, gp, smem);
            const int cb = ct * 128 + wc * 64;
#pragma unroll
            for (int m = 0; m < 4; ++m) {
                const int rl = wr * 64 + m * 16 + fr, row = rt * 128 + rl, pos = row & (SEQ - 1);
                const float sc = rrow(rl);
#pragma unroll
                for (int n = 0; n < 4; ++n) acc[m][n] = acc[m][n] * sc;
#pragma unroll
                for (int n = 0; n < 4; n += 2) {
                    if (((cb + n * 16) % 96) == 64) {
#pragma unroll
                        for (int e = 0; e < 4; ++e) {
                            const f32x2 cs = rope[pos * 16 + 4 * fq + e];
                            const float x1 = acc[m][n][e], x2 = acc[m][n + 1][e];
                            acc[m][n][e] = x1 * cs[0] - x2 * cs[1]; acc[m][n + 1][e] = x1 * cs[1] + x2 * cs[0];
                        }
                    }
                }
#pragma unroll
                for (int n = 0; n < 4; ++n) *(f16x4*)(Q16 + (size_t)row * 1536 + cb + n * 16 + 4 * fq) = cvt4(acc[m][n]);
            }
        } else {
            const int c2 = ct - 12;
            if (c2 < 8) {
                gemm_core_pf<true>(acc, xpf, wpf, rt, ct, 4, hn, nrt, nct, gp, smem);
#pragma unroll
                for (int m = 0; m < 4; ++m) {
                    const int rl = wr * 64 + m * 16 + fr; const float sc = rrow(rl);
#pragma unroll
                    for (int n = 0; n < 4; ++n) *(f16x4*)(KN + (size_t)(rt * 128 + rl) * 1024 + c2 * 128 + wc * 64 + n * 16 + 4 * fq) = cvt4(acc[m][n] * sc);
                }
            } else {
                gemm_core_pf<false>(acc, xpf, wpf, rt, ct, 4, hn, nrt, nct, gp, smem);
#pragma unroll
                for (int m = 0; m < 4; ++m) {
                    const int rl = wr * 64 + m * 16 + 4 * fq, row = rt * 128 + rl, b = row >> 12, s = row & (SEQ - 1);
                    f32x4 sc; sc[0] = rrow(rl); sc[1] = rrow(rl + 1); sc[2] = rrow(rl + 2); sc[3] = rrow(rl + 3);
#pragma unroll
                    for (int n = 0; n < 4; ++n) {
                        const int col = (c2 - 8) * 128 + wc * 64 + n * 16 + fr, h = col >> 6, d = col & 63;
                        *(f16x4*)(VT + ((size_t)((b * 16 + h) * 64 + d)) * SEQ + s) = cvt4(acc[m][n] * sc);
                    }
                }
            }
        }
    });
}

__device__ __forceinline__ f32x4 mfma16(f16x8 a, f16x8 b, f32x4 c) { return __builtin_amdgcn_mfma_f32_16x16x32_f16(a, b, c, 0, 0, 0); }
__device__ __forceinline__ f16x8 cat4(f16x4 lo, f16x4 hi) { return __builtin_shufflevector(lo, hi, 0, 1, 2, 3, 4, 5, 6, 7); }

__device__ __forceinline__ void phase_mla_attn(const Params& p, char* smem) {
    const int tid = TID, lane = tid & 63, wid = tid >> 6, li = lane & 15, g = lane >> 4;
    const f16* Q16 = (const f16*)(WS + S_Q16); const f16* KN = (const f16*)(WS + S_KN16); const f16* KPE = (const f16*)(WS + S_KPE);
    const f16* VT = (const f16*)(WS + S_VT16); f16* O = (f16*)(WS + S_MIX16);
    constexpr int BUF = 20480;
    const int sc8 = ((tid & 7) ^ ((tid >> 4) & 7)) * 8;
    const int scp = ((tid & 3) ^ ((0x78 >> (2 * ((tid >> 4) & 3))) & 3)) * 8;
    const int kn_rd0 = ((0 + g) ^ (li >> 1)) * 16, kn_rd1 = ((4 + g) ^ (li >> 1)) * 16;
    const int kp_rd = (g ^ ((0x78 >> (2 * ((li >> 2) & 3))) & 3)) * 16;
    const int v_rd[4] = {(((0 + (g >> 1)) ^ (li >> 1)) * 16) + (g & 1) * 8, (((2 + (g >> 1)) ^ (li >> 1)) * 16) + (g & 1) * 8,
                         (((4 + (g >> 1)) ^ (li >> 1)) * 16) + (g & 1) * 8, (((6 + (g >> 1)) ^ (li >> 1)) * 16) + (g & 1) * 8};
    const int nb_ = NBLK, xcd_ = BID & 7, lb_ = BID >> 3, nlb_ = nb_ >> 3;
    for (int j_ = lb_; j_ < 128; j_ += nlb_) {
        const int bh = xcd_ * 8 + (j_ >> 4), pr = j_ & 15, b = bh >> 4, h = bh & 15;
        const size_t tb = (size_t)b * SEQ;
        for (int half = 0; half < 2; ++half) {
            const int qb = half ? pr : 31 - pr;
            const int qw = qb * 128 + wid * 32;
            const int nch = 2 * qb + 2, lastw = (qw + 31) >> 6;
            f16x8 Qf[2][3];
#pragma unroll
            for (int jq = 0; jq < 2; ++jq)
#pragma unroll
                for (int ks = 0; ks < 3; ++ks) Qf[jq][ks] = *(const f16x8*)(Q16 + (tb + qw + jq * 16 + li) * 1536 + h * 96 + ks * 32 + 8 * g);
            asm volatile("s_waitcnt vmcnt(0)" ::: "memory");
#pragma unroll
            for (int jq = 0; jq < 2; ++jq)
#pragma unroll
                for (int ks = 0; ks < 3; ++ks) asm volatile("" : "+v"(Qf[jq][ks]));
            f32x4 Oa[5][2];
#pragma unroll
            for (int vb = 0; vb < 5; ++vb) { Oa[vb][0] = (f32x4){0.f, 0.f, 0.f, 0.f}; Oa[vb][1] = (f32x4){0.f, 0.f, 0.f, 0.f}; }
            f16x8 ones;
#pragma unroll
            for (int e = 0; e < 8; ++e) ones[e] = (f16)1.0f;
            const f16* kn_src = KN + (tb + (tid >> 3)) * 1024 + h * 64 + sc8;
            const f16* kp_src = KPE + (tb + (tid >> 2)) * 32 + scp;
            const f16* v_src = VT + ((size_t)((b * 16 + h) * 64 + (tid >> 3))) * SEQ + sc8;
            auto stage = [&](int kc, int s) {
                char* base = smem + s * BUF + tid * 16;
                __builtin_amdgcn_global_load_lds((const void*)(kn_src + (size_t)kc * 64 * 1024), (LAS void*)(base), 16, 0, 0);
                __builtin_amdgcn_global_load_lds((const void*)(kn_src + (size_t)(kc * 64 + 32) * 1024), (LAS void*)(base + 4096), 16, 0, 0);
                __builtin_amdgcn_global_load_lds((const void*)(v_src + kc * 64), (LAS void*)(base + 8192), 16, 0, 0);
                __builtin_amdgcn_global_load_lds((const void*)(v_src + (size_t)32 * SEQ + kc * 64), (LAS void*)(base + 8192 + 4096), 16, 0, 0);
                __builtin_amdgcn_global_load_lds((const void*)(kp_src + (size_t)kc * 64 * 32), (LAS void*)(base + 16384), 16, 0, 0);
            };
            BSYNC();
            stage(0, 0);
            if (nch > 1) stage(1, 1);
            for (int kc = 0; kc < nch; ++kc) {
                const int s = kc % 3;
                if (kc + 1 < nch) asm volatile("s_waitcnt vmcnt(5) lgkmcnt(0)" ::: "memory"); else asm volatile("s_waitcnt vmcnt(0) lgkmcnt(0)" ::: "memory");
                __builtin_amdgcn_s_barrier();
                asm volatile("" ::: "memory");
                if (kc + 2 < nch) stage(kc + 2, (kc + 2) % 3);
                if (kc > lastw) continue;
                const char* bK = smem + s * BUF; const char* bV = bK + 8192; const char* bP = bK + 16384;
                f32x4 Sx[4][2];
#pragma unroll
                for (int kb = 0; kb < 4; ++kb) { Sx[kb][0] = (f32x4){-8.f, -8.f, -8.f, -8.f}; Sx[kb][1] = (f32x4){-8.f, -8.f, -8.f, -8.f}; }
#pragma unroll
                for (int kb = 0; kb < 4; ++kb) {
                    const f16x8 K0 = *(const f16x8*)(bK + (kb * 16 + li) * 128 + kn_rd0);
                    const f16x8 K1 = *(const f16x8*)(bK + (kb * 16 + li) * 128 + kn_rd1);
                    const f16x8 K2 = *(const f16x8*)(bP + (kb * 16 + li) * 64 + kp_rd);
                    Sx[kb][0] = mfma16(K0, Qf[0][0], Sx[kb][0]); Sx[kb][1] = mfma16(K0, Qf[1][0], Sx[kb][1]);
                    Sx[kb][0] = mfma16(K1, Qf[0][1], Sx[kb][0]); Sx[kb][1] = mfma16(K1, Qf[1][1], Sx[kb][1]);
                    Sx[kb][0] = mfma16(K2, Qf[0][2], Sx[kb][0]); Sx[kb][1] = mfma16(K2, Qf[1][2], Sx[kb][1]);
                }
                if (kc * 64 + 63 > qw) {
#pragma unroll
                    for (int jq = 0; jq < 2; ++jq) {
                        const int qpos = qw + jq * 16 + li;
#pragma unroll
                        for (int kb = 0; kb < 4; ++kb)
#pragma unroll
                            for (int r = 0; r < 4; ++r)
                                if (kc * 64 + kb * 16 + 4 * g + r > qpos) Sx[kb][jq][r] = -1e4f;
                    }
                }
                f16x8 Pf[2][2];
#pragma unroll
                for (int jq = 0; jq < 2; ++jq) {
#pragma unroll
                    for (int kb = 0; kb < 4; ++kb)
#pragma unroll
                        for (int r = 0; r < 4; ++r) Sx[kb][jq][r] = __builtin_amdgcn_exp2f(Sx[kb][jq][r]);
                    Pf[jq][0] = cat4(cvt4(Sx[0][jq]), cvt4(Sx[1][jq]));
                    Pf[jq][1] = cat4(cvt4(Sx[2][jq]), cvt4(Sx[3][jq]));
                }
#pragma unroll
                for (int kp = 0; kp < 2; ++kp) {
#pragma unroll
                    for (int vb = 0; vb < 4; ++vb) {
                        const char* vp = bV + (vb * 16 + li) * 128;
                        const f16x8 Vf = cat4(*(const f16x4*)(vp + v_rd[kp * 2]), *(const f16x4*)(vp + v_rd[kp * 2 + 1]));
                        Oa[vb][0] = mfma16(Vf, Pf[0][kp], Oa[vb][0]);
                        Oa[vb][1] = mfma16(Vf, Pf[1][kp], Oa[vb][1]);
                    }
                    Oa[4][0] = mfma16(ones, Pf[0][kp], Oa[4][0]);
                    Oa[4][1] = mfma16(ones, Pf[1][kp], Oa[4][1]);
                }
            }
#pragma unroll
            for (int jq = 0; jq < 2; ++jq) {
                const float inv = 1.0f / Oa[4][jq][0];
#pragma unroll
                for (int vb = 0; vb < 4; ++vb)
                    *(f16x4*)(O + (tb + qw + jq * 16 + li) * 1024 + h * 64 + vb * 16 + 4 * g) = cvt4(Oa[vb][jq] * inv);
            }
        }
    }
}

__device__ __forceinline__ void phase_xa_scores(const Params& p, int L, char* smem) {
    WAVE_IDS
    const f16* X = (const f16*)(WS + S_Y32R); const float* PST = (const float*)(WS + S_PST1);
    const float* XU = (const float*)(WS + OFF_XU) + (size_t)(L * 4) * 1024; const float* XC = (const float*)(WS + OFF_XC) + (size_t)(L * 4) * 1024;
    f16* XP = (f16*)(WS + S_XP16); float* LP = (float*)(WS + S_XLP);
    float* srow = (float*)(smem + SMEM_MAIN + 1024);
    GPipe gp{0, 0};
    const f16* XMb = (const f16*)(WS + OFF_XM) + (size_t)(L * 4) * 1024 * 1024;
    tile_loop2(128, 8, [&](int rt, int ct, bool hn, int nrt, int nct) {
        row_stats_table(PST, [&](int r) { return rt * 128 + r; }, srow);
        f32x4 acc[4][4];
        gemm_core_pf<true>(acc, [&](int a, int, int r) { return X + (size_t)(a * 128 + r) * 1024; },
                           [&](int a, int c, int r) { return XMb + (size_t)(a >> 5) * 1024 * 1024 + (size_t)(c * 128 + r) * 1024; }, rt, ct, 16, hn, nrt, nct, gp, smem);
        f32x4 u4[4], c4[4];
#pragma unroll
        for (int n = 0; n < 4; ++n) { const int col = (rt >> 5) * 1024 + ct * 128 + wc * 64 + n * 16 + 4 * fq; u4[n] = *(const f32x4*)(XU + col); c4[n] = *(const f32x4*)(XC + col); }
#pragma unroll
        for (int m = 0; m < 4; ++m) {
            const int row = rt * 128 + wr * 64 + m * 16 + fr;
            const f32x2 st = *(const f32x2*)(srow + (wr * 64 + m * 16 + fr) * 2);
            float ps = 0.f;
#pragma unroll
            for (int n = 0; n < 4; ++n) {
                const f32x4 sc = (acc[m][n] - u4[n] * st[0]) * st[1] + c4[n];
                f32x4 e;
#pragma unroll
                for (int q = 0; q < 4; ++q) e[q] = __builtin_amdgcn_exp2f(sc[q] - 8.0f);
                const f16x4 e16 = cvt4(e);
                const f32x4 er = cvt4f(e16);
                ps += (er[0] + er[1]) + (er[2] + er[3]);
                *(f16x4*)(XP + (size_t)row * 1024 + ct * 128 + wc * 64 + n * 16 + 4 * fq) = e16;
            }
            ps += __shfl_xor(ps, 16); ps += __shfl_xor(ps, 32);
            if (fq == 0) LP[(size_t)row * 16 + ct * 2 + wc] = ps;
        }
    });
}

__device__ __forceinline__ void phase_router(const Params& p, int L, char* smem) {
    WAVE_IDS
    const f16* X = (const f16*)(WS + OFF_H16);
    const f16* Wt = (const f16*)(WS + W_ROUTER) + (size_t)L * 128 * 1024;
    unsigned* cnt = (unsigned*)(WS + OFF_CNT) + L * 32;
    unsigned* list = (unsigned*)(WS + S_LIST); float* gates = (float*)(WS + S_GATES);
    const float* bg = IN(33) + L * 4; const float* be = IN(35) + L * 32;
    float* lg = (float*)smem;
    int* hist = (int*)(smem + 128 * 40 * 4); int* base = hist + 32;
    for (int rt = BID; rt < 128; rt += NBLK) {
        f32x4 acc[4][4];
        gemm_core<true>(acc, [&](int r) { return X + (size_t)(rt * 128 + r) * 1024; }, [&](int r) { return Wt + (size_t)r * 1024; }, 16, smem);
        BSYNC();
        if (wc == 0) {
#pragma unroll
            for (int m = 0; m < 4; ++m)
#pragma unroll
                for (int n = 0; n < 3; ++n) {
                    const int row = wr * 64 + m * 16 + fr, col = n * 16 + 4 * fq;
                    if (col < 40) *(f32x4*)(lg + row * 40 + col) = acc[m][n];
                }
        }
        if (tid < 32) hist[tid] = 0;
        BSYNC();
        int e0 = 0, e1 = 0, p0 = 0, p1 = 0; float g0 = 0.f, g1 = 0.f;
        if (tid < 128) {
            const float* l = lg + tid * 40;
            int grp = 0; float gm = l[0] + bg[0];
            for (int i = 1; i < 4; ++i) { const float v = l[i] + bg[i]; if (v > gm) { gm = v; grp = i; } }
            float den = 0.f;
            for (int i = 0; i < 4; ++i) den += __expf(l[i] + bg[i] - gm);
            const float pg = 1.0f / den;
            int i1 = 0; float v1 = l[4 + grp * 8] + be[grp * 8];
            for (int i = 1; i < 8; ++i) { const float v = l[4 + grp * 8 + i] + be[grp * 8 + i]; if (v > v1) { v1 = v; i1 = i; } }
            int i2 = -1; float v2 = -3.0e38f;
            for (int i = 0; i < 8; ++i) { const float v = l[4 + grp * 8 + i] + be[grp * 8 + i]; if (i != i1 && v > v2) { v2 = v; i2 = i; } }
            const float ex = __expf(v2 - v1);
            g0 = pg / (1.0f + ex); g1 = pg * ex / (1.0f + ex);
            e0 = grp * 8 + i1; e1 = grp * 8 + i2;
            p0 = atomicAdd(&hist[e0], 1); p1 = atomicAdd(&hist[e1], 1);
        }
        BSYNC();
        if (tid < 32) base[tid] = hist[tid] ? (int)atomicAdd(&cnt[tid], (unsigned)hist[tid]) : 0;
        BSYNC();
        if (tid < 128) {
            const int t = rt * 128 + tid;
            list[(size_t)e0 * 16384 + base[e0] + p0] = (unsigned)(t * 2);
            list[(size_t)e1 * 16384 + base[e1] + p1] = (unsigned)(t * 2 + 1);
            gates[t * 2] = g0; gates[t * 2 + 1] = g1;
        }
    }
}

__device__ __forceinline__ void moe_blocks(const Params& p, int L, char* smem, int* bs) {
    const unsigned* cnt = (const unsigned*)(WS + OFF_CNT) + L * 32;
    BSYNC();
    if (TID == 0) { int a = 0; for (int e = 0; e < 32; ++e) { bs[e] = a; a += ((int)cnt[e] + 127) >> 7; } bs[32] = a; }
    BSYNC();
}

__device__ __forceinline__ void phase_moe_up(const Params& p, int L, char* smem) {
    WAVE_IDS
    int* bs = (int*)(smem + SMEM_MAIN + 64); int* rowtok = bs + 40;
    moe_blocks(p, L, smem, bs);
    const unsigned* cnt = (const unsigned*)(WS + OFF_CNT) + L * 32; const unsigned* list = (const unsigned*)(WS + S_LIST);
    const f16* X = (const f16*)(WS + OFF_H16); f16* HB = (f16*)(WS + S_HBUF);
    const int nitems = bs[32] * 8;
    for (int item = BID; item < nitems; item += NBLK) {
        const int rbg = item >> 3, nt = item & 7;
        int e = 0; for (int i = 1; i < 32; ++i) if (bs[i] <= rbg) e = i;
        const int rb = rbg - bs[e], nrow = (int)cnt[e] - rb * 128;
        BSYNC();
        if (tid < 128) rowtok[tid] = (tid < nrow) ? (int)(list[(size_t)e * 16384 + rb * 128 + tid] >> 1) : 0;
        BSYNC();
        const f16* Wt = (const f16*)(WS + W_GU) + ((size_t)(L * 32 + e) * 1024 + nt * 128) * 1024;
        f32x4 acc[4][4];
        gemm_core<true>(acc, [&](int r) { return X + (size_t)rowtok[r] * 1024; }, [&](int r) { return Wt + (size_t)r * 1024; }, 16, smem);
#pragma unroll
        for (int m = 0; m < 4; ++m)
#pragma unroll
            for (int n = 0; n < 2; ++n) {
                f32x4 o;
#pragma unroll
                for (int q = 0; q < 4; ++q) { const float gv = acc[m][n][q]; o[q] = gv * sigmoid_(gv) * acc[m][n + 2][q]; }
                *(f16x4*)(HB + (size_t)(rbg * 128 + wr * 64 + m * 16 + fr) * 512 + nt * 64 + wc * 32 + n * 16 + 4 * fq) = cvt4(o);
            }
    }
}

__device__ __forceinline__ void phase_moe_down(const Params& p, int L, char* smem) {
    WAVE_IDS
    int* bs = (int*)(smem + SMEM_MAIN + 64); int* rowent = bs + 40;
    moe_blocks(p, L, smem, bs);
    const unsigned* cnt = (const unsigned*)(WS + OFF_CNT) + L * 32; const unsigned* list = (const unsigned*)(WS + S_LIST);
    const float* gates = (const float*)(WS + S_GATES);
    const f16* HB = (const f16*)(WS + S_HBUF); f16* FF = (f16*)(WS + S_FF16);
    const int nitems = bs[32] * 8;
    for (int item = BID; item < nitems; item += NBLK) {
        const int rbg = item >> 3, nt = item & 7;
        int e = 0; for (int i = 1; i < 32; ++i) if (bs[i] <= rbg) e = i;
        const int rb = rbg - bs[e], nrow = (int)cnt[e] - rb * 128;
        BSYNC();
        if (tid < 128) rowent[tid] = (tid < nrow) ? (int)list[(size_t)e * 16384 + rb * 128 + tid] : -1;
        BSYNC();
        const f16* Wt = (const f16*)(WS + W_D) + ((size_t)(L * 32 + e) * 1024 + nt * 128) * 512;
        f32x4 acc[4][4];
        gemm_core<true>(acc, [&](int r) { return HB + (size_t)(rbg * 128 + r) * 512; }, [&](int r) { return Wt + (size_t)r * 512; }, 8, smem);
#pragma unroll
        for (int m = 0; m < 4; ++m) {
            const int ent = rowent[wr * 64 + m * 16 + fr];
            if (ent >= 0) {
                const float gt = gates[ent];
                f16* dst = FF + ((size_t)(ent & 1) * T + (ent >> 1)) * 1024 + nt * 128 + wc * 64 + 4 * fq;
#pragma unroll
                for (int n = 0; n < 4; ++n) *(f16x4*)(dst + n * 16) = cvt4(acc[m][n] * gt);
            }
        }
    }
}

constexpr int NPHASES = 1 + 2 * 13 + 2 * 11;

__global__ void __launch_bounds__(256, 2) trunk_kernel(Params p) {
    __shared__ __attribute__((aligned(16))) char smem[SMEM_BYTES];
    volatile LAS unsigned* st = (volatile LAS unsigned*)(smem + SMEM_MAIN);
#if MEGA
    if (threadIdx.x == 0) { st[0] = 0u; st[1] = 0u; }
    BSYNC();
    const XcdBarrier xb = xcd_barrier_post((unsigned*)(WS + OFF_BAR), st);
#endif
    int ph = 0;
    char* ws = p.ws;
    f16* y16 = (f16*)(ws + S_Y32R); f16* h16 = (f16*)(ws + OFF_H16);
#ifndef ENMASK
#define ENMASK 0xFFFFFFFFu
#endif
#define EN(k) (((ENMASK) >> (k)) & 1u)
#ifndef REPMASK
#define REPMASK 0u
#endif
#ifndef REPN
#define REPN 2
#endif
#define NREP(k) ((((REPMASK) >> (k)) & 1u) ? (1 + REPN) : 1)
#if MEGA
#define STEP(k, ...) do { if (ph >= p.ph_begin && ph < p.ph_end) { if (EN(k)) { for (int rep_ = 0; rep_ < NREP(k); ++rep_) { __VA_ARGS__; } } if (ph + 1 < p.ph_end) xcd_barrier(xb); } ++ph; } while (0)
#else
#define STEP(k, ...) do { if (ph >= p.ph_begin && ph < p.ph_end) { if (EN(k)) { for (int rep_ = 0; rep_ < NREP(k); ++rep_) { __VA_ARGS__; } } } ++ph; } while (0)
#endif
    STEP(0, phase_convert(p, smem));
    for (int L = 0; L < 4; ++L) {
        const int j = L >> 1;
        const float* res32 = (L == 0) ? IN(0) : (const float*)nullptr;
        if ((L & 1) == 0) {
            STEP(1, phase_ab_in(p, j, smem); if (L == 0) phase_memkv(p, smem));
            STEP(2, phase_shift(p, j));
            STEP(3, phase_lora(p, j, smem));
            STEP(4, phase_rec_sg(p, j, L == 0, L != 0, smem));
            STEP(5, if (L != 0) phase_rw_fin_seg(p, j, smem); else { phase_rw_fin(p, j); xa_uc_reduce(p); });
            STEP(6, phase_gemm_res((const f16*)(ws + S_MIX16), (const f16*)(ws + W_ABOUT) + (size_t)j * 1024 * 1024, res32, h16, y16, (float*)(ws + S_PST1), smem));
        } else {
            STEP(7, phase_mla_in(p, j, smem));
            STEP(8, phase_mla_qkv(p, j, smem));
            STEP(9, phase_mla_attn(p, smem));
            STEP(6, phase_gemm_res((const f16*)(ws + S_MIX16), (const f16*)(ws + W_MLAOUT) + (size_t)j * 1024 * 1024, res32, h16, y16, (float*)(ws + S_PST1), smem));
        }
        STEP(11, phase_xa_scores(p, L, smem));
        STEP(12, phase_xa_out(p, L, y16, smem));
        STEP(10, phase_ln<2>(y16, nullptr, nullptr, nullptr, nullptr, IN(30) + L * 1024, IN(31) + L * 1024, nullptr, h16, nullptr));
        STEP(13, phase_router(p, L, smem));
        STEP(14, phase_moe_up(p, L, smem));
        STEP(15, phase_moe_down(p, L, smem));
        STEP(10, phase_ln<1>(y16, (const f16*)(ws + S_FF16), (const f16*)(ws + S_FF16) + (size_t)T * 1024, IN(30) + L * 1024, IN(31) + L * 1024, IN(39) + L * 1024, IN(40) + L * 1024,
                         (L == 3) ? p.out : (float*)nullptr, (L == 3) ? (f16*)nullptr : h16, nullptr));
    }
}

}

extern "C" void kernel_launch(void* const* d_in, const int* in_sizes, int n_in, void* d_out, int out_size, void* d_ws, size_t ws_size, hipStream_t stream) {
    (void)in_sizes; (void)n_in; (void)out_size; (void)ws_size;
    static int grid_blocks = 0;
    if (!grid_blocks) {
        int dev = 0, cus = 0, per_cu = 0;
        hipGetDevice(&dev);
        hipDeviceGetAttribute(&cus, hipDeviceAttributeMultiprocessorCount, dev);
        hipOccupancyMaxActiveBlocksPerMultiprocessor(&per_cu, trunk_kernel, 256, 0);
        if (per_cu > 2) per_cu = 2;
        if (per_cu < 1) per_cu = 1;
        grid_blocks = cus * per_cu;
        grid_blocks &= ~7;
    }
    Params p{};
    for (int i = 0; i < 41; ++i) p.in[i] = (const float*)d_in[i];
    p.out = (float*)d_out;
    p.ws = (char*)d_ws;
    hipMemsetAsync((char*)d_ws + OFF_BAR, 0, XCD_BAR_WORDS * 4, stream);
#if MEGA
    p.ph_begin = 0; p.ph_end = NPHASES;
    void* args[] = {&p};
    hipError_t e = hipLaunchCooperativeKernel((const void*)trunk_kernel, dim3(grid_blocks), dim3(256), args, 0, stream);
    if (e != hipSuccess) fprintf(stderr, "cooperative launch failed: %s (grid %d)\n", hipGetErrorString(e), grid_blocks);
#else
    for (int ph = 0; ph < NPHASES; ++ph) {
        p.ph_begin = ph; p.ph_end = ph + 1;
        hipLaunchKernelGGL(trunk_kernel, dim3(grid_blocks), dim3(256), 0, stream, p);
    }
#endif
}
```

```cpp
#include <hip/hip_runtime.h>
#include <stdint.h>
#include <stdio.h>

#ifndef MEGA
#define MEGA 1
#endif
#ifndef FAST_GEMM
#define FAST_GEMM 1
#endif
#ifndef FAST_REC
#define FAST_REC 1
#endif

typedef _Float16 f16;
typedef f16 f16x8 __attribute__((ext_vector_type(8)));
typedef f16 f16x4 __attribute__((ext_vector_type(4)));
typedef f16 f16x2 __attribute__((ext_vector_type(2)));
typedef float f32x4 __attribute__((ext_vector_type(4)));
typedef float f32x2 __attribute__((ext_vector_type(2)));
#define LAS __attribute__((address_space(3)))

namespace {

constexpr int T = 16384, SEQ = 4096, D = 1024;
constexpr float DN_ALPHA = 1.681792830507429f;
constexpr float LOG2E = 1.4426950408889634f;

constexpr size_t al(size_t x) { return (x + 255) & ~(size_t)255; }
constexpr size_t OFF_BAR   = 0;
constexpr size_t OFF_CNT   = 16384;
constexpr size_t OFF_ROPE  = 32768;
constexpr size_t OFF_H32   = OFF_ROPE + al((size_t)SEQ * 16 * 8);
constexpr size_t OFF_RUC   = OFF_H32;
constexpr size_t OFF_H16   = OFF_H32 + al((size_t)T * D * 4);
constexpr size_t OFF_MEM16 = OFF_H16 + al((size_t)T * D * 2);
constexpr size_t OFF_KVMEM = OFF_MEM16 + al((size_t)1024 * 1024 * 2);
constexpr size_t OFF_XM    = OFF_KVMEM + al((size_t)4 * 1024 * 2048 * 2);
constexpr size_t OFF_XN    = OFF_XM + al((size_t)16 * 1024 * 1024 * 2);
constexpr size_t OFF_XUP   = OFF_XN + al((size_t)16 * 1024 * 1024 * 2);
constexpr size_t OFF_XCP   = OFF_XUP + al((size_t)16 * 1024 * 16 * 4);
constexpr size_t OFF_XU    = OFF_XCP + al((size_t)16 * 1024 * 16 * 4);
constexpr size_t OFF_XC    = OFF_XU + al((size_t)16 * 1024 * 4);
constexpr size_t W_ABIN    = OFF_XC + al((size_t)16 * 1024 * 4);
constexpr size_t W_W2T     = W_ABIN + al((size_t)2 * 2816 * 1024 * 2);
constexpr size_t W_A2T     = W_W2T + al((size_t)2 * 512 * 64 * 2);
constexpr size_t W_G2T     = W_A2T + al((size_t)2 * 512 * 64 * 2);
constexpr size_t W_SGW     = W_G2T + al((size_t)2 * 512 * 128 * 2);
constexpr size_t W_ABOUT   = W_SGW + al((size_t)2 * 4 * 128 * 128 * 2);
constexpr size_t W_MLAIN   = W_ABOUT + al((size_t)2 * 1024 * 1024 * 2);
constexpr size_t W_Q       = W_MLAIN + al((size_t)2 * 640 * 1024 * 2);
constexpr size_t W_KV      = W_Q + al((size_t)2 * 1536 * 256 * 2);
constexpr size_t W_MLAOUT  = W_KV + al((size_t)2 * 2048 * 256 * 2);
constexpr size_t W_XAQ     = W_MLAOUT + al((size_t)2 * 1024 * 1024 * 2);
constexpr size_t W_XAKV    = W_XAQ + al((size_t)4 * 1024 * 1024 * 2);
constexpr size_t W_XAO     = W_XAKV + al((size_t)4 * 2048 * 1024 * 2);
constexpr size_t W_ROUTER  = W_XAO + al((size_t)4 * 1024 * 1024 * 2);
constexpr size_t W_GU      = W_ROUTER + al((size_t)4 * 128 * 1024 * 2);
constexpr size_t W_D       = W_GU + al((size_t)4 * 32 * 1024 * 1024 * 2);
constexpr size_t OFF_SCR   = W_D + al((size_t)4 * 32 * 1024 * 512 * 2);
constexpr size_t S_P16   = OFF_SCR;
constexpr size_t S_PS16  = S_P16 + al((size_t)T * 2816 * 2);
constexpr size_t S_WD32  = S_PS16 + al((size_t)T * 1792 * 2);
constexpr size_t S_NKK   = S_WD32 + al((size_t)T * 512 * 4);
constexpr size_t S_BB    = S_NKK + al((size_t)T * 512 * 2);
constexpr size_t S_KP    = S_BB + al((size_t)T * 512 * 2);
constexpr size_t S_G16   = S_KP + al((size_t)T * 512 * 2);
constexpr size_t S_BSUM  = S_G16 + al((size_t)T * 512 * 2);
constexpr size_t S_Y32   = S_BSUM + al((size_t)T * 8 * 4);
constexpr size_t S_ZT    = S_Y32 + al((size_t)T * 512 * 4);
constexpr size_t S_MIX16 = S_ZT + al((size_t)512 * 128 * 128 * 2);
constexpr size_t S_YT    = S_MIX16 + al((size_t)T * 1024 * 2);
constexpr size_t S_SMID  = S_YT + al((size_t)T * 512 * 4);
constexpr size_t S_SEND  = S_SMID + al((size_t)32 * 64 * 64 * 4);
constexpr size_t S_SMID3 = S_SEND + al((size_t)32 * 5 * 64 * 64 * 4);
constexpr size_t S_END_EVEN = S_SMID3 + al((size_t)32 * 3 * 64 * 64 * 4);
constexpr size_t S_CQKV  = OFF_SCR;
constexpr size_t S_KPE   = S_CQKV + al((size_t)T * 512 * 2);
constexpr size_t S_Q16   = S_KPE + al((size_t)T * 32 * 2);
constexpr size_t S_KN16  = S_Q16 + al((size_t)T * 1536 * 2);
constexpr size_t S_VT16  = S_KN16 + al((size_t)T * 1024 * 2);
constexpr size_t S_SSQ   = S_VT16 + al((size_t)T * 1024 * 2);
constexpr size_t S_END_ODD = S_SSQ + al((size_t)T * 8 * 4);
constexpr size_t S_XP16  = OFF_SCR;
constexpr size_t S_XLP   = S_XP16 + al((size_t)T * 1024 * 2);
constexpr size_t S_XSTAT = S_XLP + al((size_t)T * 16 * 4);
constexpr size_t S_PST1  = S_XSTAT + al((size_t)T * 2 * 4);
constexpr size_t S_PST2  = OFF_SCR + (size_t)192 * 1024 * 1024;
static_assert(S_PST2 + (size_t)T * 32 * 4 <= S_MIX16, "pst2 overlay");
constexpr size_t S_LIST  = OFF_SCR;
constexpr size_t S_GATES = S_LIST + al((size_t)32 * 16384 * 4);
constexpr size_t S_HBUF  = S_GATES + al((size_t)T * 2 * 4);
constexpr size_t S_FF16  = S_HBUF + al((size_t)36864 * 512 * 2);
constexpr size_t S_END_MOE = S_FF16 + al((size_t)2 * T * 1024 * 2);
constexpr size_t S_Y32R  = OFF_SCR + (size_t)128 * 1024 * 1024;
static_assert(S_Y32R + (size_t)T * 1024 * 4 <= S_MIX16, "y32 overlay");
static_assert(S_END_ODD <= S_MIX16, "odd overlay");
static_assert(S_END_MOE <= S_MIX16, "moe overlay");
static_assert(S_END_EVEN <= (size_t)1024 * 1024 * 1024, "workspace");

constexpr int SMEM_MAIN = 65536;
constexpr int SMEM_BYTES = SMEM_MAIN + 2048;

struct Params {
    const float* in[41];
    float* out;
    char* ws;
    int ph_begin, ph_end;
};

__device__ __forceinline__ int opq_s(int x) { asm volatile("" : "+v"(x)); return __builtin_amdgcn_readfirstlane(x); }
__device__ __forceinline__ int opq_v(int x) { asm volatile("" : "+v"(x)); return x; }
#define TID opq_v((int)threadIdx.x)
#define BID opq_s((int)blockIdx.x)
#define NBLK opq_s((int)gridDim.x)
__device__ __forceinline__ const float* opq_p(const float* q) {
    const uint64_t u = (uint64_t)q; uint32_t lo = (uint32_t)u, hi = (uint32_t)(u >> 32);
    asm volatile("" : "+v"(lo), "+v"(hi));
    lo = __builtin_amdgcn_readfirstlane(lo); hi = __builtin_amdgcn_readfirstlane(hi);
    return (const float*)(((uint64_t)hi << 32) | lo);
}
typedef const __attribute__((address_space(4))) Params* KargPtr;
__device__ __forceinline__ KargPtr kparams() {
    const uint64_t u = (uint64_t)__builtin_amdgcn_kernarg_segment_ptr(); uint32_t lo = (uint32_t)u, hi = (uint32_t)(u >> 32);
    asm volatile("" : "+v"(lo), "+v"(hi));
    lo = __builtin_amdgcn_readfirstlane(lo); hi = __builtin_amdgcn_readfirstlane(hi);
    return (KargPtr)(((uint64_t)hi << 32) | lo);
}
#define IN(k) (kparams()->in[k])
#define WS (kparams()->ws)

__device__ __forceinline__ float sigmoid_(float x) { return 1.0f / (1.0f + __expf(-x)); }
__device__ __forceinline__ float tanh_(float x) { return 1.0f - 2.0f / (1.0f + __expf(2.0f * x)); }
__device__ __forceinline__ float gelu_(float x) { const float u = 0.7978845608028654f * (x + 0.044715f * x * x * x); return 0.5f * x * (1.0f + tanh_(u)); }
__device__ __forceinline__ float dpp_ror(float x, int) { return x; }
__device__ __forceinline__ float row16_sum(float x) {
    x += __builtin_bit_cast(float, __builtin_amdgcn_update_dpp(0, __builtin_bit_cast(int, x), 0x128, 0xf, 0xf, false));
    x += __builtin_bit_cast(float, __builtin_amdgcn_update_dpp(0, __builtin_bit_cast(int, x), 0x124, 0xf, 0xf, false));
    x += __builtin_bit_cast(float, __builtin_amdgcn_update_dpp(0, __builtin_bit_cast(int, x), 0x122, 0xf, 0xf, false));
    x += __builtin_bit_cast(float, __builtin_amdgcn_update_dpp(0, __builtin_bit_cast(int, x), 0x121, 0xf, 0xf, false));
    return x;
}
__device__ __forceinline__ float wave_sum(float x) {
    x += __shfl_xor(x, 32); x += __shfl_xor(x, 16); x += __shfl_xor(x, 8); x += __shfl_xor(x, 4); x += __shfl_xor(x, 2); x += __shfl_xor(x, 1);
    return x;
}
__device__ __forceinline__ f16x4 cvt4(f32x4 v) { return __builtin_convertvector(v, f16x4); }
__device__ __forceinline__ f32x4 cvt4f(f16x4 v) { return __builtin_convertvector(v, f32x4); }

#define BSYNC() do { asm volatile("s_waitcnt lgkmcnt(0)" ::: "memory"); __syncthreads(); } while (0)

#define XB_TMO      128
#define XB_XCNT(j)  (256  + 64 * (j))
#define XB_XSUB(j)  (1280 + 64 * (j))
#define XB_XGEN(j)  (2304 + 64 * (j))
#define XB_TOP      3328
#define XB_TOPGEN   3392
#define XCD_BAR_WORDS 3456
#define XB_SPIN_CAP (1u << 22)
__device__ __forceinline__ unsigned xb_ld(unsigned* p) { return __hip_atomic_load(p, __ATOMIC_RELAXED, __HIP_MEMORY_SCOPE_AGENT); }
__device__ __forceinline__ unsigned xb_add(unsigned* p, unsigned v) { return __hip_atomic_fetch_add(p, v, __ATOMIC_RELAXED, __HIP_MEMORY_SCOPE_AGENT); }
__device__ __forceinline__ unsigned xb_xcc_id() { return (unsigned)__builtin_amdgcn_s_getreg((3 << 11) | 20) & 0xFu; }
#define XB_SPIN(cond, bar) do { unsigned _sp = 0; while (cond) { __builtin_amdgcn_s_sleep(1); \
    if ((++_sp & 255u) == 0u) { if (xb_ld(&(bar)[XB_TMO])) break; if (_sp > XB_SPIN_CAP) { atomicAdd(&(bar)[XB_TMO], 1u); break; } } } } while (0)
struct XcdBarrier { unsigned* bar; unsigned x; volatile LAS unsigned* st; };
__device__ __forceinline__ XcdBarrier xcd_barrier_post(unsigned* bar, volatile LAS unsigned* st) {
    XcdBarrier b; b.bar = bar; b.x = xb_xcc_id(); b.st = st;
    if (threadIdx.x == 0) (void)xb_add(&bar[XB_XCNT(b.x)], 1u);
    return b;
}
__device__ __forceinline__ void xcd_barrier_complete(unsigned* bar, unsigned x, unsigned& nloc, unsigned& nx) {
    const unsigned G = gridDim.x;
    unsigned sum, cnt, mine, sp = 0u;
    for (;;) {
        sum = 0u; cnt = 0u; mine = 0u;
#pragma unroll
        for (unsigned j = 0; j < 16; ++j) { const unsigned c = xb_ld(&bar[XB_XCNT(j)]); sum += c; cnt += (c > 0u) ? 1u : 0u; mine = (j == x) ? c : mine; }
        if (sum == G) break;
        __builtin_amdgcn_s_sleep(1);
        if ((++sp & 255u) == 0u) { if (xb_ld(&bar[XB_TMO])) break; if (sp > XB_SPIN_CAP) { atomicAdd(&bar[XB_TMO], 1u); break; } }
    }
    nloc = mine > 0u ? mine : 1u; nx = cnt > 0u ? cnt : 1u;
}
__device__ __forceinline__ void xcd_barrier(const XcdBarrier& b) {
    asm volatile("s_waitcnt vmcnt(0)" ::: "memory");
    __syncthreads();
    if (threadIdx.x == 0) {
        unsigned* bar = b.bar;
        __builtin_amdgcn_s_waitcnt(0);
        unsigned nloc = b.st[0], nx = b.st[1];
        if (nloc == 0u) { xcd_barrier_complete(bar, b.x, nloc, nx); b.st[0] = nloc; b.st[1] = nx; }
        const unsigned old = xb_add(&bar[XB_XSUB(b.x)], 1u);
        const unsigned gen = old / nloc;
        if (old + 1u == (gen + 1u) * nloc) {
            __builtin_amdgcn_fence(__ATOMIC_RELEASE, "agent");
            asm volatile("s_waitcnt vmcnt(0)" ::: "memory");
            const unsigned og = xb_add(&bar[XB_TOP], 1u);
            const unsigned tg = og / nx;
            if (og + 1u == (tg + 1u) * nx) xb_add(&bar[XB_TOPGEN], 1u);
            else XB_SPIN(xb_ld(&bar[XB_TOPGEN]) == tg, bar);
            __builtin_amdgcn_fence(__ATOMIC_ACQUIRE, "agent");
            xb_add(&bar[XB_XGEN(b.x)], 1u);
            asm volatile("s_waitcnt vmcnt(0)" ::: "memory");
        } else {
            XB_SPIN(xb_ld(&bar[XB_XGEN(b.x)]) == gen, bar);
            __builtin_amdgcn_fence(__ATOMIC_ACQUIRE, "agent");
            asm volatile("s_waitcnt vmcnt(0)" ::: "memory");
        }
    }
    __syncthreads();
}

#define GEMM_STEP_ORDERED(bs) do { \
        f16x8 xa[4], wa[4], xb[4], wb[4]; \
        _Pragma("unroll") for (int m = 0; m < 4; ++m) xa[m] = *(const f16x8*)((bs) + xoff + m * 2048 + rd0); \
        _Pragma("unroll") for (int n = 0; n < 4; ++n) wa[n] = *(const f16x8*)((bs) + woff + n * 2048 + rd0); \
        _Pragma("unroll") for (int m = 0; m < 4; ++m) xb[m] = *(const f16x8*)((bs) + xoff + m * 2048 + rd1); \
        _Pragma("unroll") for (int n = 0; n < 4; ++n) wb[n] = *(const f16x8*)((bs) + woff + n * 2048 + rd1); \
        __builtin_amdgcn_sched_barrier(0); \
        _Pragma("unroll") for (int m = 0; m < 4; ++m) _Pragma("unroll") for (int n = 0; n < 4; ++n) \
            acc[m][n] = TRANS ? __builtin_amdgcn_mfma_f32_16x16x32_f16(wa[n], xa[m], acc[m][n], 0, 0, 0) : __builtin_amdgcn_mfma_f32_16x16x32_f16(xa[m], wa[n], acc[m][n], 0, 0, 0); \
        _Pragma("unroll") for (int m = 0; m < 4; ++m) _Pragma("unroll") for (int n = 0; n < 4; ++n) \
            acc[m][n] = TRANS ? __builtin_amdgcn_mfma_f32_16x16x32_f16(wb[n], xb[m], acc[m][n], 0, 0, 0) : __builtin_amdgcn_mfma_f32_16x16x32_f16(xb[m], wb[n], acc[m][n], 0, 0, 0); \
        __builtin_amdgcn_sched_barrier(0); \
    } while (0)
struct NoSeg { __device__ __forceinline__ void operator()(int, f32x4 (&)[4][4]) const {} };
template <bool TRANS, class XR, class WR, class SEG = NoSeg>
__device__ __forceinline__ void gemm_core(f32x4 (&acc)[4][4], XR xrow, WR wrow, const int nk, char* smem, SEG seg = SEG()) {
    const int tid = TID, lane = tid & 63, wid = tid >> 6, wr = wid >> 1, wc = wid & 1, fr = lane & 15, fq = lane >> 4;
#pragma unroll
    for (int m = 0; m < 4; ++m)
#pragma unroll
        for (int n = 0; n < 4; ++n) acc[m][n] = (f32x4){0.f, 0.f, 0.f, 0.f};
#if FAST_GEMM
    const int sc = ((tid & 7) ^ ((tid >> 4) & 7)) * 8;
    const f16* px[4]; const f16* pw[4];
#pragma unroll
    for (int i = 0; i < 4; ++i) { px[i] = xrow((tid >> 3) + 32 * i) + sc; pw[i] = wrow((tid >> 3) + 32 * i) + sc; }
    const int rd0 = ((0 * 4 + fq) ^ (fr >> 1)) * 16, rd1 = ((1 * 4 + fq) ^ (fr >> 1)) * 16;
    const int xoff = (wr * 64 + fr) * 128, woff = 16384 + (wc * 64 + fr) * 128;
    BSYNC();
    auto stage = [&](int kt, int s) {
        char* base = smem + s * 32768 + tid * 16;
#pragma unroll
        for (int i = 0; i < 4; ++i) {
            __builtin_amdgcn_global_load_lds((const void*)(px[i] + kt * 64), (LAS void*)(base + i * 4096), 16, 0, 0);
            __builtin_amdgcn_global_load_lds((const void*)(pw[i] + kt * 64), (LAS void*)(base + 16384 + i * 4096), 16, 0, 0);
        }
    };
    stage(0, 0);
    for (int kt = 0; kt < nk; ++kt) {
        const int s = kt & 1;
        asm volatile("s_waitcnt vmcnt(0)" ::: "memory");
        BSYNC();
        __builtin_amdgcn_sched_barrier(0);
        if (kt + 1 < nk) stage(kt + 1, s ^ 1);
        __builtin_amdgcn_sched_barrier(0);
        seg(kt, acc);
        const char* bs = smem + s * 32768;
        GEMM_STEP_ORDERED(bs);
    }
#else
    float* ctile = (float*)smem;
    BSYNC();
    for (int i = 0; i < 64; ++i) {
        const int idx = tid + 256 * i, r = idx >> 7, c = idx & 127;
        const f16* xp = xrow(r); const f16* wp = wrow(c);
        float s = 0.f;
        for (int k = 0; k < nk * 64; k += 8) {
            const f16x8 a = *(const f16x8*)(xp + k), b = *(const f16x8*)(wp + k);
#pragma unroll
            for (int e = 0; e < 8; ++e) s += (float)a[e] * (float)b[e];
        }
        ctile[idx] = s;
    }
    BSYNC();
#pragma unroll
    for (int m = 0; m < 4; ++m)
#pragma unroll
        for (int n = 0; n < 4; ++n)
#pragma unroll
            for (int j = 0; j < 4; ++j)
                acc[m][n][j] = TRANS ? ctile[(wr * 64 + m * 16 + fr) * 128 + wc * 64 + n * 16 + 4 * fq + j] : ctile[(wr * 64 + m * 16 + 4 * fq + j) * 128 + wc * 64 + n * 16 + fr];
    BSYNC();
#endif
}

struct GPipe { int staged, b0; };
#define GEMM_W_SETUP \
    const int tid = TID, lane = tid & 63, wid = tid >> 6, wr = wid >> 1, wc = wid & 1, fr = lane & 15, fq = lane >> 4; \
    _Pragma("unroll") for (int m = 0; m < 8; ++m) _Pragma("unroll") for (int n = 0; n < 4; ++n) acc[m][n] = (f32x4){0.f, 0.f, 0.f, 0.f}; \
    const int sc = ((tid & 3) ^ ((0x78 >> (((tid >> 4) & 3) * 2)) & 3)) * 8; \
    const int rdc = (fq ^ ((0x78 >> (((fr >> 2) & 3) * 2)) & 3)) * 16; \
    const int poff = (wr * 128 + fr) * 64 + rdc, qoff = 16384 + (wc * 64 + fr) * 64 + rdc;
#define GEMM_W_STEP(bs) do { \
        f16x8 xf[8], wf[4]; \
        _Pragma("unroll") for (int m = 0; m < 8; ++m) xf[m] = *(const f16x8*)((bs) + poff + m * 1024); \
        _Pragma("unroll") for (int n = 0; n < 4; ++n) wf[n] = *(const f16x8*)((bs) + qoff + n * 1024); \
        __builtin_amdgcn_sched_barrier(0); \
        _Pragma("unroll") for (int m = 0; m < 8; ++m) _Pragma("unroll") for (int n = 0; n < 4; ++n) \
            acc[m][n] = SWAP ? __builtin_amdgcn_mfma_f32_16x16x32_f16(xf[m], wf[n], acc[m][n], 0, 0, 0) \
                             : __builtin_amdgcn_mfma_f32_16x16x32_f16(wf[n], xf[m], acc[m][n], 0, 0, 0); \
        __builtin_amdgcn_sched_barrier(0); \
    } while (0)
template <bool SWAP, class PR, class QR, class SEG>
__device__ __forceinline__ void gemm_core_w(f32x4 (&acc)[8][4], PR prow, QR qrow, const int nk, char* smem, SEG seg) {
    GEMM_W_SETUP
    const f16* pp[4]; const f16* pq[2];
#pragma unroll
    for (int i = 0; i < 4; ++i) pp[i] = prow((tid >> 2) + 64 * i) + sc;
#pragma unroll
    for (int i = 0; i < 2; ++i) pq[i] = qrow((tid >> 2) + 64 * i) + sc;
    BSYNC();
    auto stage = [&](int kt, int s) {
        char* base = smem + s * 24576 + tid * 16;
#pragma unroll
        for (int i = 0; i < 4; ++i) __builtin_amdgcn_global_load_lds((const void*)(pp[i] + kt * 32), (LAS void*)(base + i * 4096), 16, 0, 0);
#pragma unroll
        for (int i = 0; i < 2; ++i) __builtin_amdgcn_global_load_lds((const void*)(pq[i] + kt * 32), (LAS void*)(base + 16384 + i * 4096), 16, 0, 0);
    };
    stage(0, 0);
    for (int kt = 0; kt < nk; ++kt) {
        const int s = kt & 1;
        asm volatile("s_waitcnt vmcnt(0)" ::: "memory");
        BSYNC();
        __builtin_amdgcn_sched_barrier(0);
        if (kt + 1 < nk) stage(kt + 1, s ^ 1);
        __builtin_amdgcn_sched_barrier(0);
        seg(kt, acc);
        const char* bs = smem + s * 24576;
        GEMM_W_STEP(bs);
    }
}
template <bool SWAP, class PR, class QR, class SEG>
__device__ __forceinline__ void gemm_core_w_pf(f32x4 (&acc)[8][4], PR pr, QR qr, int rt, int ct, const int nk, bool has_next, int nrt, int nct, GPipe& gp, char* smem, SEG seg) {
    GEMM_W_SETUP
    const f16* pp[4]; const f16* pq[2];
#pragma unroll
    for (int i = 0; i < 4; ++i) pp[i] = pr(rt, ct, (tid >> 2) + 64 * i) + sc;
#pragma unroll
    for (int i = 0; i < 2; ++i) pq[i] = qr(rt, ct, (tid >> 2) + 64 * i) + sc;
    auto stage = [&](int kt, int s) {
        char* base = smem + s * 24576 + tid * 16;
#pragma unroll
        for (int i = 0; i < 4; ++i) __builtin_amdgcn_global_load_lds((const void*)(pp[i] + kt * 32), (LAS void*)(base + i * 4096), 16, 0, 0);
#pragma unroll
        for (int i = 0; i < 2; ++i) __builtin_amdgcn_global_load_lds((const void*)(pq[i] + kt * 32), (LAS void*)(base + 16384 + i * 4096), 16, 0, 0);
    };
    if (!gp.staged) { BSYNC(); gp.b0 = 0; stage(0, 0); }
    const int b0 = gp.b0;
    for (int kt = 0; kt < nk; ++kt) {
        const int s = (kt + b0) & 1;
        asm volatile("s_waitcnt vmcnt(0)" ::: "memory");
        BSYNC();
        if (kt + 1 < nk) stage(kt + 1, s ^ 1);
        else if (has_next) {
            char* base = smem + (s ^ 1) * 24576 + tid * 16;
#pragma unroll
            for (int i = 0; i < 4; ++i) __builtin_amdgcn_global_load_lds((const void*)(pr(nrt, nct, (tid >> 2) + 64 * i) + sc), (LAS void*)(base + i * 4096), 16, 0, 0);
#pragma unroll
            for (int i = 0; i < 2; ++i) __builtin_amdgcn_global_load_lds((const void*)(qr(nrt, nct, (tid >> 2) + 64 * i) + sc), (LAS void*)(base + 16384 + i * 4096), 16, 0, 0);
        }
        seg(kt, acc);
        const char* bs = smem + s * 24576;
        GEMM_W_STEP(bs);
    }
    gp.staged = has_next ? 1 : 0; gp.b0 = ((nk - 1 + b0) & 1) ^ 1;
}
struct NoSegW { __device__ __forceinline__ void operator()(int, f32x4 (&)[8][4]) const {} };

template <class TR> __device__ __forceinline__ void row_stats_table(const float* pst, TR tokrow, float* srow) {
    const int tid = TID;
    float su = 0.f, sq = 0.f;
    if (tid < 128) {
        const float* ps = pst + (size_t)tokrow(tid) * 32;
#pragma unroll
        for (int i = 0; i < 8; ++i) { const f32x4 v = *(const f32x4*)(ps + i * 4); su += v[0] + v[2]; sq += v[1] + v[3]; }
    }
    BSYNC();
    if (tid < 128) {
        const float mean = su * (1.0f / 1024.0f), var = fmaxf(sq * (1.0f / 1024.0f) - mean * mean, 0.f);
        srow[tid * 2] = mean; srow[tid * 2 + 1] = rsqrtf(var + 1e-5f);
    }
}

template <bool TRANS, class XP, class WP, class SEG = NoSeg>
__device__ __forceinline__ void gemm_core_pf(f32x4 (&acc)[4][4], XP xp, WP wp, int rt, int ct, const int nk, bool has_next, int nrt, int nct, GPipe& gp,
                                             char* smem, SEG seg = SEG()) {
    const int tid = TID, lane = tid & 63, wid = tid >> 6, wr = wid >> 1, wc = wid & 1, fr = lane & 15, fq = lane >> 4;
#pragma unroll
    for (int m = 0; m < 4; ++m)
#pragma unroll
        for (int n = 0; n < 4; ++n) acc[m][n] = (f32x4){0.f, 0.f, 0.f, 0.f};
    const int sc = ((tid & 7) ^ ((tid >> 4) & 7)) * 8;
    const f16* px[4]; const f16* pw[4];
#pragma unroll
    for (int i = 0; i < 4; ++i) { px[i] = xp(rt, ct, (tid >> 3) + 32 * i) + sc; pw[i] = wp(rt, ct, (tid >> 3) + 32 * i) + sc; }
    const int rd0 = ((0 * 4 + fq) ^ (fr >> 1)) * 16, rd1 = ((1 * 4 + fq) ^ (fr >> 1)) * 16;
    const int xoff = (wr * 64 + fr) * 128, woff = 16384 + (wc * 64 + fr) * 128;
    auto stage = [&](int kt, int s) {
        char* base = smem + s * 32768 + tid * 16;
#pragma unroll
        for (int i = 0; i < 4; ++i) {
            __builtin_amdgcn_global_load_lds((const void*)(px[i] + kt * 64), (LAS void*)(base + i * 4096), 16, 0, 0);
            __builtin_amdgcn_global_load_lds((const void*)(pw[i] + kt * 64), (LAS void*)(base + 16384 + i * 4096), 16, 0, 0);
        }
    };
    if (!gp.staged) { BSYNC(); gp.b0 = 0; stage(0, 0); }
    const int b0 = gp.b0;
    for (int kt = 0; kt < nk; ++kt) {
        const int s = (kt + b0) & 1;
        asm volatile("s_waitcnt vmcnt(0)" ::: "memory");
        BSYNC();
        __builtin_amdgcn_sched_barrier(0);
        if (kt + 1 < nk) stage(kt + 1, s ^ 1);
        else if (has_next) {
            char* base = smem + (s ^ 1) * 32768 + tid * 16;
#pragma unroll
            for (int i = 0; i < 4; ++i) {
                __builtin_amdgcn_global_load_lds((const void*)(xp(nrt, nct, (tid >> 3) + 32 * i) + sc), (LAS void*)(base + i * 4096), 16, 0, 0);
                __builtin_amdgcn_global_load_lds((const void*)(wp(nrt, nct, (tid >> 3) + 32 * i) + sc), (LAS void*)(base + 16384 + i * 4096), 16, 0, 0);
            }
        }
        __builtin_amdgcn_sched_barrier(0);
        seg(kt, acc);
        const char* bs = smem + s * 32768;
        GEMM_STEP_ORDERED(bs);
    }
    gp.staged = has_next ? 1 : 0; gp.b0 = ((nk - 1 + b0) & 1) ^ 1;
}

template <class F> __device__ __forceinline__ void tile_loop2(int nrt, int nct, F f) {
    const int xcd = BID & 7, lb = BID >> 3, nlb = NBLK >> 3;
    const int per = (nrt >> 3) * nct;
    for (int j = lb; j < per; j += nlb) {
        const int jn = j + nlb; const bool hn = jn < per; const int je = hn ? jn : j;
        f(((j / nct) << 3) + xcd, j % nct, hn, ((je / nct) << 3) + xcd, je % nct);
    }
}

template <class F> __device__ __forceinline__ void tile_loop(int nrt, int nct, F f) {
    const int xcd = BID & 7, lb = BID >> 3, nlb = NBLK >> 3;
    const int per = (nrt >> 3) * nct;
    for (int j = lb; j < per; j += nlb) f(((j / nct) << 3) + xcd, j % nct);
}

#define WAVE_IDS const int tid = TID, lane = tid & 63, wid = tid >> 6, wr = wid >> 1, wc = wid & 1, fr = lane & 15, fq = lane >> 4; (void)lane; (void)wid; (void)wr; (void)wc; (void)fr; (void)fq;

template <class RowMap, class KScale>
__device__ __forceinline__ void conv_T(const float* src, f16* dst, int nbatch, int K, int N, size_t src_bs, size_t dst_bs, int ldd, RowMap rowmap, KScale kscale, int& off, float* tile, int myid, int G) {
    const int tk = K / 64, tn = (N + 63) / 64, total = nbatch * tk * tn, t = TID;
    int start = (myid - off) % G; if (start < 0) start += G;
    auto load = [&](int i, f32x4 (&v)[4]) {
        const int bi = i / (tk * tn), r = i % (tk * tn), k0 = (r / tn) * 64, n0 = (r % tn) * 64;
#pragma unroll
        for (int j = 0; j < 4; ++j) {
            const int k = (t >> 4) + 16 * j, c = (t & 15) * 4;
            v[j] = (f32x4){0.f, 0.f, 0.f, 0.f};
            if (i < total && n0 + c < N) v[j] = *(const f32x4*)(src + (size_t)bi * src_bs + (size_t)(k0 + k) * N + n0 + c);
        }
    };
    f32x4 va[4], vb[4];
    load(start, va); load(start + G, vb);
    for (int i = start; i < total; i += G) {
        const int bi = i / (tk * tn), r = i % (tk * tn), k0 = (r / tn) * 64, n0 = (r % tn) * 64;
        BSYNC();
#pragma unroll
        for (int j = 0; j < 4; ++j) {
            const int k = (t >> 4) + 16 * j, c = (t & 15) * 4;
            const float s = kscale(k0 + k);
            tile[k * 65 + c + 0] = va[j][0] * s; tile[k * 65 + c + 1] = va[j][1] * s; tile[k * 65 + c + 2] = va[j][2] * s; tile[k * 65 + c + 3] = va[j][3] * s;
        }
#pragma unroll
        for (int j = 0; j < 4; ++j) va[j] = vb[j];
        load(i + 2 * G, vb);
        BSYNC();
        const int n = t >> 2, kc = (t & 3) * 16;
        if (n0 + n < N) {
            f16x8 o0, o1;
#pragma unroll
            for (int j = 0; j < 8; ++j) { o0[j] = (f16)tile[(kc + j) * 65 + n]; o1[j] = (f16)tile[(kc + 8 + j) * 65 + n]; }
            f16* dp = dst + (size_t)bi * dst_bs + (size_t)rowmap(n0 + n) * ldd + k0 + kc;
            *(f16x8*)dp = o0; *(f16x8*)(dp + 8) = o1;
        }
    }
    off = (off + total) % G;
}

__device__ __forceinline__ void cvt_stream(const float* src, f16* dst, size_t n4, float sc, int gtid, int gsz) {
    size_t i = gtid;
    for (; i + (size_t)3 * gsz < n4; i += (size_t)4 * gsz) {
        const f32x4 a = *(const f32x4*)(src + i * 4), b = *(const f32x4*)(src + (i + gsz) * 4), c = *(const f32x4*)(src + (i + 2 * (size_t)gsz) * 4), d = *(const f32x4*)(src + (i + 3 * (size_t)gsz) * 4);
        *(f16x4*)(dst + i * 4) = cvt4(a * sc); *(f16x4*)(dst + (i + gsz) * 4) = cvt4(b * sc);
        *(f16x4*)(dst + (i + 2 * (size_t)gsz) * 4) = cvt4(c * sc); *(f16x4*)(dst + (i + 3 * (size_t)gsz) * 4) = cvt4(d * sc);
    }
    for (; i < n4; i += gsz) *(f16x4*)(dst + i * 4) = cvt4(*(const f32x4*)(src + i * 4) * sc);
}

__device__ __forceinline__ void convert_late(const Params& p, char* smem, int cb, int cn) {
    char* ws = WS;
    float* tile = (float*)smem;
    int off = 0;
    auto ident = [](int n) { return n; };
    auto one = [](int) { return 1.0f; };
    conv_T(IN(2) + (size_t)1024 * 2816, (f16*)(ws + W_ABIN) + (size_t)2816 * 1024, 1, 1024, 2816, (size_t)1024 * 2816, (size_t)2816 * 1024, 1024, ident, one, off, tile, cb, cn);
    conv_T(IN(18), (f16*)(ws + W_ABOUT), 2, 1024, 1024, (size_t)1024 * 1024, (size_t)1024 * 1024, 1024, ident, one, off, tile, cb, cn);
    conv_T(IN(19), (f16*)(ws + W_MLAIN), 2, 1024, 544, (size_t)1024 * 544, (size_t)640 * 1024, 1024, ident, one, off, tile, cb, cn);
    for (int l = 0; l < 2; ++l) {
        const float* qn = IN(20) + l * 256; const float* kvn = IN(21) + l * 256;
        const float qs = 0.10206207261596577f * LOG2E;
        conv_T(IN(22) + (size_t)l * 256 * 1536, (f16*)(ws + W_Q) + (size_t)l * 1536 * 256, 1, 256, 1536, 0, 0, 256, ident, [=](int k) { return qn[k] * qs; }, off, tile, cb, cn);
        conv_T(IN(23) + (size_t)l * 256 * 2048, (f16*)(ws + W_KV) + (size_t)l * 2048 * 256, 1, 256, 2048, 0, 0, 256,
               [](int n) { const int h = n >> 7, j = n & 127; return j < 64 ? h * 64 + j : 1024 + h * 64 + (j - 64); }, [=](int k) { return kvn[k]; }, off, tile, cb, cn);
    }
    conv_T(IN(24), (f16*)(ws + W_MLAOUT), 2, 1024, 1024, (size_t)1024 * 1024, (size_t)1024 * 1024, 1024, ident, one, off, tile, cb, cn);
}

__device__ __forceinline__ void phase_convert(const Params& p, char* smem) {
    char* ws = WS;
    float* tile = (float*)smem;
    const int gtid = BID * 256 + TID, gsz = NBLK * 256;
    int off = 0;
    const int cb = BID, cn = NBLK;
    auto ident = [](int n) { return n; };
    auto one = [](int) { return 1.0f; };
    {
        const float* x = IN(0); f16* h16 = (f16*)(ws + OFF_H16);
        cvt_stream(x, h16, (size_t)T * D / 4, 1.0f, gtid, gsz);
        const float* mem = IN(1); f16* m16 = (f16*)(ws + OFF_MEM16);
        cvt_stream(mem, m16, (size_t)1024 * 1024 / 4, 1.0f, gtid, gsz);
    }
    {
        const float* w = IN(16); f16* o = (f16*)(ws + W_SGW);
        for (int i = gtid; i < 2 * 4 * 128 * 128; i += gsz) { const int s = i & 127, tt = (i >> 7) & 127; o[i] = (s <= tt) ? (f16)w[i] : (f16)0.f; }
    }
    {
        f32x2* rt = (f32x2*)(ws + OFF_ROPE);
        for (int i = gtid; i < SEQ * 16; i += gsz) {
            const int pos = i >> 4, fi = i & 15;
            const double inv = exp2(-(double)fi * (13.287712379549449 / 16.0));
            double rev = (double)pos * inv * 0.15915494309189535;
            rev -= floor(rev);
            const float fr_ = (float)rev;
            rt[i] = (f32x2){__builtin_amdgcn_cosf(fr_), __builtin_amdgcn_sinf(fr_)};
        }
    }
    {
        unsigned* cnt = (unsigned*)(ws + OFF_CNT);
        if (gtid < 192) cnt[gtid] = 0u;
        f16* wr_ = (f16*)(ws + W_ROUTER);
        for (int i = gtid; i < 4 * 92 * 1024; i += gsz) { const int l = i / (92 * 1024), r = i % (92 * 1024); wr_[(size_t)l * 128 * 1024 + 36 * 1024 + r] = (f16)0.f; }
        f16* wm = (f16*)(ws + W_MLAIN);
        for (int i = gtid; i < 2 * 96 * 1024; i += gsz) { const int l = i / (96 * 1024), r = i % (96 * 1024); wm[(size_t)l * 640 * 1024 + 544 * 1024 + r] = (f16)0.f; }
    }
    conv_T(IN(2), (f16*)(ws + W_ABIN), 1, 1024, 2816, (size_t)1024 * 2816, (size_t)2816 * 1024, 1024, ident, one, off, tile, cb, cn);
    conv_T(IN(5), (f16*)(ws + W_W2T), 2, 64, 512, (size_t)64 * 512, (size_t)512 * 64, 64, ident, one, off, tile, cb, cn);
    conv_T(IN(7), (f16*)(ws + W_A2T), 2, 64, 512, (size_t)64 * 512, (size_t)512 * 64, 64, ident, one, off, tile, cb, cn);
    conv_T(IN(8), (f16*)(ws + W_G2T), 2, 128, 512, (size_t)128 * 512, (size_t)512 * 128, 128, ident, one, off, tile, cb, cn);
    {
        const float* w = IN(27); f16* o = (f16*)(ws + W_XAQ); const float sc = 0.0625f * LOG2E;
        cvt_stream(w, o, (size_t)4 * 1024 * 1024 / 4, sc, gtid, gsz);
    }
    conv_T(IN(28), (f16*)(ws + W_XAKV), 4, 1024, 2048, (size_t)1024 * 2048, (size_t)2048 * 1024, 1024, ident, one, off, tile, cb, cn);
    conv_T(IN(29), (f16*)(ws + W_XAO), 4, 1024, 1024, (size_t)1024 * 1024, (size_t)1024 * 1024, 1024, ident, one, off, tile, cb, cn);
    for (int l = 0; l < 4; ++l) {
        const float* g2 = IN(30) + l * 1024;
        conv_T(IN(32) + (size_t)l * 1024 * 4, (f16*)(ws + W_ROUTER) + (size_t)l * 128 * 1024, 1, 1024, 4, 0, 0, 1024, ident, [=](int k) { return g2[k]; }, off, tile, cb, cn);
        conv_T(IN(34) + (size_t)l * 1024 * 32, (f16*)(ws + W_ROUTER) + (size_t)l * 128 * 1024, 1, 1024, 32, 0, 0, 1024, [](int n) { return n + 4; }, [=](int k) { return g2[k]; }, off, tile, cb, cn);
    }
    {
        const int gw = BID * 4 + (TID >> 6), lane = TID & 63;
        if (gw < 4 * 36) {
            const int l = gw / 36, n = gw % 36;
            const float* g2 = IN(30) + l * 1024; const float* b2 = IN(31) + l * 1024;
            const float* w = (n < 4) ? (IN(32) + (size_t)l * 1024 * 4 + n) : (IN(34) + (size_t)l * 1024 * 32 + (n - 4));
            const int ldw = (n < 4) ? 4 : 32;
            float su = 0.f, sc = 0.f;
            for (int k = lane; k < 1024; k += 64) { const float wv = w[(size_t)k * ldw]; su += g2[k] * wv; sc += b2[k] * wv; }
            su = wave_sum(su); sc = wave_sum(sc);
            if (lane == 0) { float* ruc = (float*)(ws + OFF_RUC) + l * 128; ruc[n] = su; ruc[64 + n] = sc; }
        }
    }
}

__device__ __forceinline__ void convert_moe_dyn(const Params& p, char* smem, int l0, unsigned* ctr) {
    char* ws = WS;
    float* tile = (float*)smem; int* sidx = (int*)(smem + SMEM_MAIN + 64);
    const int t = TID;
    constexpr int CH = 16, NB = 64, TOTAL = 3 * NB * 128;
    const size_t bofs = (size_t)l0 * 32;
    const float* srcs[3] = {IN(36) + bofs * 1024 * 512, IN(37) + bofs * 1024 * 512, IN(38) + bofs * 512 * 1024};
    f16* dgu = (f16*)(ws + W_GU) + bofs * 1024 * 1024; f16* dd = (f16*)(ws + W_D) + bofs * 1024 * 512;
    for (;;) {
        BSYNC();
        if (t == 0) *sidx = (int)atomicAdd(ctr, (unsigned)CH);
        BSYNC();
        const int base = *sidx;
        if (base >= TOTAL) break;
        auto load = [&](int v, f32x4 (&x)[4]) {
            const int ten = v / (NB * 128), r = v % 128, bi = (v >> 7) % NB;
            const int tn = ten == 2 ? 16 : 8, N = ten == 2 ? 1024 : 512, K = ten == 2 ? 512 : 1024;
            const int k0 = (r / tn) * 64, n0 = (r % tn) * 64;
            const float* src = (ten == 0 ? srcs[0] : (ten == 1 ? srcs[1] : srcs[2])) + (size_t)bi * K * N;
#pragma unroll
            for (int j = 0; j < 4; ++j) {
                const int k = (t >> 4) + 16 * j, c = (t & 15) * 4;
                x[j] = (f32x4){0.f, 0.f, 0.f, 0.f};
                if (v < base + CH) x[j] = __builtin_nontemporal_load((const f32x4*)(src + (size_t)(k0 + k) * N + n0 + c));
            }
        };
        f32x4 va[4], vb[4];
        load(base, va); load(base + 1, vb);
        for (int v = base; v < base + CH; ++v) {
            const int ten = v / (NB * 128), r = v % 128, bi = (v >> 7) % NB;
            const int tn = ten == 2 ? 16 : 8;
            const int k0 = (r / tn) * 64, n0 = (r % tn) * 64;
            BSYNC();
#pragma unroll
            for (int j = 0; j < 4; ++j) {
                const int k = (t >> 4) + 16 * j, c = (t & 15) * 4;
                tile[k * 65 + c + 0] = va[j][0]; tile[k * 65 + c + 1] = va[j][1]; tile[k * 65 + c + 2] = va[j][2]; tile[k * 65 + c + 3] = va[j][3];
            }
#pragma unroll
            for (int j = 0; j < 4; ++j) va[j] = vb[j];
            load(v + 2, vb);
            BSYNC();
            const int n = t >> 2, kc = (t & 3) * 16, nn = n0 + n;
            f16x8 o0, o1;
#pragma unroll
            for (int j = 0; j < 8; ++j) { o0[j] = (f16)tile[(kc + j) * 65 + n]; o1[j] = (f16)tile[(kc + 8 + j) * 65 + n]; }
            f16* dp;
            if (ten == 2) dp = dd + (size_t)bi * 1024 * 512 + (size_t)nn * 512 + k0 + kc;
            else dp = dgu + (size_t)bi * 1024 * 1024 + (size_t)((nn >> 6) * 128 + ((nn >> 5) & 1) * 64 + (ten == 1 ? 32 : 0) + (nn & 31)) * 1024 + k0 + kc;
            __builtin_nontemporal_store(o0, (f16x8*)dp); __builtin_nontemporal_store(o1, (f16x8*)(dp + 8));
        }
    }
}

template <int MODE>
__device__ __forceinline__ void phase_ln(const f16* src, const f16* ff0, const f16* ff1, const float* gp, const float* bp, const float* g, const float* b,
                                         float* dst32, f16* dst16, float* stat) {
    const int lane = TID & 63, gw = BID * 4 + (TID >> 6), nw = NBLK * 4;
    for (int row = gw; row < T; row += nw) {
        f32x4 v[4]; float s = 0.f;
#pragma unroll
        for (int i = 0; i < 4; ++i) {
            v[i] = cvt4f(*(const f16x4*)(src + (size_t)row * D + i * 256 + lane * 4));
            s += (v[i][0] + v[i][1]) + (v[i][2] + v[i][3]);
        }
        float mean = wave_sum(s) * (1.0f / 1024.0f);
        float q = 0.f;
#pragma unroll
        for (int i = 0; i < 4; ++i) { const f32x4 d = v[i] - mean; q += (d[0] * d[0] + d[1] * d[1]) + (d[2] * d[2] + d[3] * d[3]); }
        float rstd = rsqrtf(wave_sum(q) * (1.0f / 1024.0f) + 1e-5f);
        if (MODE == 1) {
            s = 0.f;
#pragma unroll
            for (int i = 0; i < 4; ++i) {
                const int c = i * 256 + lane * 4; const size_t o = (size_t)row * D + c;
                const f32x4 h2 = (v[i] - mean) * rstd * *(const f32x4*)(gp + c) + *(const f32x4*)(bp + c);
                v[i] = h2 * DN_ALPHA + cvt4f(*(const f16x4*)(ff0 + o)) + cvt4f(*(const f16x4*)(ff1 + o));
                s += (v[i][0] + v[i][1]) + (v[i][2] + v[i][3]);
            }
            mean = wave_sum(s) * (1.0f / 1024.0f);
            q = 0.f;
#pragma unroll
            for (int i = 0; i < 4; ++i) { const f32x4 d = v[i] - mean; q += (d[0] * d[0] + d[1] * d[1]) + (d[2] * d[2] + d[3] * d[3]); }
            rstd = rsqrtf(wave_sum(q) * (1.0f / 1024.0f) + 1e-5f);
        }
        if (MODE == 0 && lane == 0) *(f32x2*)(stat + (size_t)row * 2) = (f32x2){mean, rstd};
#pragma unroll
        for (int i = 0; i < 4; ++i) {
            const int c = i * 256 + lane * 4; const size_t o = (size_t)row * D + c;
            const f32x4 y = (v[i] - mean) * rstd * *(const f32x4*)(g + c) + *(const f32x4*)(b + c);
            if (MODE == 1 && dst32) *(f32x4*)(dst32 + o) = y;
            if (dst16) *(f16x4*)(dst16 + o) = cvt4(y);
        }
    }
}

__device__ __forceinline__ void phase_ln3(const f16* src, const f16* ff0, const f16* ff1, const float* gp, const float* bp, const float* g, const float* b,
                                          float* dst32, f16* dst16) {
    const int lane = TID & 63, gw = BID * 4 + (TID >> 6), nw = NBLK * 4;
    f16x8 ny[2], na[2], nb2[2];
    auto load = [&](int row) {
        const size_t o = (size_t)(row < T ? row : gw) * D + lane * 8;
#pragma unroll
        for (int i = 0; i < 2; ++i) { ny[i] = *(const f16x8*)(src + o + i * 512); na[i] = *(const f16x8*)(ff0 + o + i * 512); nb2[i] = *(const f16x8*)(ff1 + o + i * 512); }
    };
    load(gw);
    for (int row = gw; row < T; row += nw) {
        float v[16], f[16];
#pragma unroll
        for (int i = 0; i < 2; ++i)
#pragma unroll
            for (int e = 0; e < 8; ++e) { v[i * 8 + e] = (float)ny[i][e]; f[i * 8 + e] = (float)na[i][e] + (float)nb2[i][e]; }
        load(row + nw);
        float s = 0.f;
#pragma unroll
        for (int e = 0; e < 16; ++e) s += v[e];
        float mean = wave_sum(s) * (1.0f / 1024.0f);
        float q = 0.f;
#pragma unroll
        for (int e = 0; e < 16; ++e) { const float d = v[e] - mean; q += d * d; }
        float rstd = rsqrtf(wave_sum(q) * (1.0f / 1024.0f) + 1e-5f);
        s = 0.f;
#pragma unroll
        for (int i = 0; i < 2; ++i) {
            const int c = i * 512 + lane * 8;
            const f32x4 g0 = *(const f32x4*)(gp + c), g1 = *(const f32x4*)(gp + c + 4), b0 = *(const f32x4*)(bp + c), b1 = *(const f32x4*)(bp + c + 4);
#pragma unroll
            for (int e = 0; e < 8; ++e) {
                const float h2 = (v[i * 8 + e] - mean) * rstd * (e < 4 ? g0[e & 3] : g1[e & 3]) + (e < 4 ? b0[e & 3] : b1[e & 3]);
                v[i * 8 + e] = h2 * DN_ALPHA + f[i * 8 + e];
                s += v[i * 8 + e];
            }
        }
        mean = wave_sum(s) * (1.0f / 1024.0f);
        q = 0.f;
#pragma unroll
        for (int e = 0; e < 16; ++e) { const float d = v[e] - mean; q += d * d; }
        rstd = rsqrtf(wave_sum(q) * (1.0f / 1024.0f) + 1e-5f);
#pragma unroll
        for (int i = 0; i < 2; ++i) {
            const int c = i * 512 + lane * 8; const size_t o = (size_t)row * D + c;
            const f32x4 g0 = *(const f32x4*)(g + c), g1 = *(const f32x4*)(g + c + 4), b0 = *(const f32x4*)(b + c), b1 = *(const f32x4*)(b + c + 4);
            f32x4 y0, y1;
#pragma unroll
            for (int e = 0; e < 4; ++e) { y0[e] = (v[i * 8 + e] - mean) * rstd * g0[e] + b0[e]; y1[e] = (v[i * 8 + 4 + e] - mean) * rstd * g1[e] + b1[e]; }
            if (dst32) { *(f32x4*)(dst32 + o) = y0; *(f32x4*)(dst32 + o + 4) = y1; }
            if (dst16) { f16x8 o8; for (int e = 0; e < 4; ++e) { o8[e] = (f16)y0[e]; o8[4 + e] = (f16)y1[e]; } *(f16x8*)(dst16 + o) = o8; }
        }
    }
}

__device__ __forceinline__ void phase_ln2(const f16* src, const float* g, const float* b, f16* dst16, int bskip) {
    if (BID < bskip) return;
    const int lane = TID & 63, gw = (BID - bskip) * 4 + (TID >> 6), nw = (NBLK - bskip) * 4;
    f16x8 ny[2];
    auto load = [&](int row) {
        const size_t o = (size_t)(row < T ? row : gw) * D + lane * 8;
        ny[0] = *(const f16x8*)(src + o); ny[1] = *(const f16x8*)(src + o + 512);
    };
    load(gw);
    for (int row = gw; row < T; row += nw) {
        float v[16];
#pragma unroll
        for (int i = 0; i < 2; ++i)
#pragma unroll
            for (int e = 0; e < 8; ++e) v[i * 8 + e] = (float)ny[i][e];
        load(row + nw);
        float s = 0.f;
#pragma unroll
        for (int e = 0; e < 16; ++e) s += v[e];
        const float mean = wave_sum(s) * (1.0f / 1024.0f);
        float q = 0.f;
#pragma unroll
        for (int e = 0; e < 16; ++e) { const float d = v[e] - mean; q += d * d; }
        const float rstd = rsqrtf(wave_sum(q) * (1.0f / 1024.0f) + 1e-5f);
#pragma unroll
        for (int i = 0; i < 2; ++i) {
            const int c = i * 512 + lane * 8; const size_t o = (size_t)row * D + c;
            const f32x4 g0 = *(const f32x4*)(g + c), g1 = *(const f32x4*)(g + c + 4), b0 = *(const f32x4*)(b + c), b1 = *(const f32x4*)(b + c + 4);
            f16x8 o8;
#pragma unroll
            for (int e = 0; e < 4; ++e) { o8[e] = (f16)((v[i * 8 + e] - mean) * rstd * g0[e] + b0[e]); o8[4 + e] = (f16)((v[i * 8 + 4 + e] - mean) * rstd * g1[e] + b1[e]); }
            *(f16x8*)(dst16 + o) = o8;
        }
    }
}

__device__ __forceinline__ void phase_gemm_res(const f16* X, const f16* Wt, const float* res32, const f16* res16, f16* y16, float* pst, char* smem) {
    WAVE_IDS
    tile_loop(64, 8, [&](int rt, int ct) {
        f32x4 acc[8][4];
        gemm_core_w<false>(acc, [&](int r) { return X + (size_t)(rt * 256 + r) * 1024; }, [&](int r) { return Wt + (size_t)(ct * 128 + r) * 1024; }, 32, smem, NoSegW());
#pragma unroll
        for (int m = 0; m < 8; ++m) {
            float su = 0.f, sq = 0.f;
            const int row = rt * 256 + wr * 128 + m * 16 + fr;
#pragma unroll
            for (int n = 0; n < 4; ++n) {
                const size_t o = (size_t)row * 1024 + ct * 128 + wc * 64 + n * 16 + 4 * fq;
                const f32x4 r4 = res32 ? *(const f32x4*)(res32 + o) : cvt4f(*(const f16x4*)(res16 + o));
                const f16x4 y4 = cvt4(r4 * DN_ALPHA + acc[m][n]);
                *(f16x4*)(y16 + o) = y4;
                const f32x4 yr = cvt4f(y4);
                su += (yr[0] + yr[1]) + (yr[2] + yr[3]); sq += (yr[0] * yr[0] + yr[1] * yr[1]) + (yr[2] * yr[2] + yr[3] * yr[3]);
            }
            su += __shfl_xor(su, 16); su += __shfl_xor(su, 32); sq += __shfl_xor(sq, 16); sq += __shfl_xor(sq, 32);
            if (fq == 0) *(f32x2*)(pst + ((size_t)row * 16 + ct * 2 + wc) * 2) = (f32x2){su, sq};
        }
    });
}

__device__ __forceinline__ void phase_xa_out(const Params& p, int L, f16* y16, char* smem) {
    WAVE_IDS
    const f16* XP = (const f16*)(WS + S_XP16); const float* LP = (const float*)(WS + S_XLP); const float* PST = (const float*)(WS + S_PST1);
    const float* g1 = IN(25) + L * 1024; const float* b1 = IN(26) + L * 1024;
    float* srow = (float*)(smem + SMEM_MAIN + 1024); float* pst2 = (float*)(WS + S_PST2);
    GPipe gp{0, 0};
    const f16* XNb = (const f16*)(WS + OFF_XN) + (size_t)(L * 4) * 1024 * 1024;
    tile_loop2(128, 8, [&](int rt, int ct, bool hn, int nrt, int nct) {
        row_stats_table(PST, [&](int r) { return rt * 128 + r; }, srow);
        float ratio[4][4];
#pragma unroll
        for (int m = 0; m < 4; ++m) {
            const float* lp = LP + (size_t)(rt * 128 + wr * 64 + m * 16 + fr) * 16;
            float l[4];
#pragma unroll
            for (int h = 0; h < 4; ++h) { const f32x4 v = *(const f32x4*)(lp + 4 * h); l[h] = (v[0] + v[1]) + (v[2] + v[3]); }
            ratio[m][0] = l[1] / l[0]; ratio[m][1] = l[2] / l[1]; ratio[m][2] = l[3] / l[2]; ratio[m][3] = 1.0f / l[3];
        }
        f32x4 acc[4][4];
        gemm_core_pf<true>(acc, [&](int a, int, int r) { return XP + (size_t)(a * 128 + r) * 1024; },
            [&](int a, int c, int r) { return XNb + (size_t)(a >> 5) * 1024 * 1024 + (size_t)(c * 128 + r) * 1024; }, rt, ct, 16, hn, nrt, nct, gp, smem,
            [&](int kt, f32x4 (&a)[4][4]) {
                if (kt == 4 || kt == 8 || kt == 12) {
#pragma unroll
                    for (int m = 0; m < 4; ++m) {
                        const float sc = kt == 4 ? ratio[m][0] : (kt == 8 ? ratio[m][1] : ratio[m][2]);
#pragma unroll
                        for (int n = 0; n < 4; ++n) a[m][n] = a[m][n] * sc;
                    }
                }
            });
        f32x4 gv[4], bv[4];
#pragma unroll
        for (int n = 0; n < 4; ++n) { const int c = ct * 128 + wc * 64 + n * 16 + 4 * fq; gv[n] = *(const f32x4*)(g1 + c); bv[n] = *(const f32x4*)(b1 + c); }
#pragma unroll
        for (int m = 0; m < 4; ++m) {
            const int row = rt * 128 + wr * 64 + m * 16 + fr;
            const f32x2 st = *(const f32x2*)(srow + (wr * 64 + m * 16 + fr) * 2);
            float su = 0.f, sq = 0.f;
#pragma unroll
            for (int n = 0; n < 4; ++n) {
                const size_t o = (size_t)row * 1024 + ct * 128 + wc * 64 + n * 16 + 4 * fq;
                const f32x4 hres = (cvt4f(*(const f16x4*)(y16 + o)) - st[0]) * st[1] * gv[n] + bv[n];
                const f16x4 y4 = cvt4(hres * DN_ALPHA + acc[m][n] * ratio[m][3]);
                *(f16x4*)(y16 + o) = y4;
                const f32x4 yr = cvt4f(y4);
                su += (yr[0] + yr[1]) + (yr[2] + yr[3]); sq += (yr[0] * yr[0] + yr[1] * yr[1]) + (yr[2] * yr[2] + yr[3] * yr[3]);
            }
            su += __shfl_xor(su, 16); su += __shfl_xor(su, 32); sq += __shfl_xor(sq, 16); sq += __shfl_xor(sq, 32);
            if (fq == 0) *(f32x2*)(pst2 + ((size_t)row * 16 + ct * 2 + wc) * 2) = (f32x2){su, sq};
        }
    });
}

__device__ __forceinline__ void phase_memkv(const Params& p, char* smem, int nbk) {
    WAVE_IDS
    if (BID >= nbk) return;
    const f16* mem16 = (const f16*)(WS + OFF_MEM16);
    for (int item = BID; item < 4 * 8 * 16; item += nbk) {
        const int L = item >> 7, rt = (item >> 4) & 7, ct = item & 15;
        const f16* Wt = (const f16*)(WS + W_XAKV) + (size_t)L * 2048 * 1024;
        f16* kv = (f16*)(WS + OFF_KVMEM) + (size_t)L * 1024 * 2048;
        f32x4 acc[4][4];
        gemm_core<true>(acc, [&](int r) { return mem16 + (size_t)(rt * 128 + r) * 1024; }, [&](int r) { return Wt + (size_t)(ct * 128 + r) * 1024; }, 16, smem);
#pragma unroll
        for (int m = 0; m < 4; ++m)
#pragma unroll
            for (int n = 0; n < 4; ++n)
                *(f16x4*)(kv + (size_t)(rt * 128 + wr * 64 + m * 16 + fr) * 2048 + ct * 128 + wc * 64 + n * 16 + 4 * fq) = cvt4(acc[m][n]);
    }
}

__device__ __forceinline__ void xa_pre_item(const Params& p, int item, char* smem) {
    WAVE_IDS
    const int ct = item & 7, rt = (item >> 3) & 7, which = (item >> 6) & 1, b = (item >> 7) & 3, L = item >> 9;
    const f16* kv = (const f16*)(WS + OFF_KVMEM) + (size_t)L * 1024 * 2048;
    f32x4 acc[4][4];
    f16* out;
    if (which == 0) {
        const int hd = rt >> 1, key0 = (rt & 1) * 128;
        const f16* wq = (const f16*)(WS + W_XAQ) + (size_t)L * 1024 * 1024;
        gemm_core<true>(acc, [&](int r) { return kv + (size_t)(b * 256 + key0 + r) * 2048 + hd * 256; }, [&](int r) { return wq + (size_t)(ct * 128 + r) * 1024 + hd * 256; }, 4, smem);
        out = (f16*)(WS + OFF_XM) + (size_t)(L * 4 + b) * 1024 * 1024;
    } else {
        const int hd = ct >> 1, key0 = (ct & 1) * 128;
        const f16* wo = (const f16*)(WS + W_XAO) + (size_t)L * 1024 * 1024;
        gemm_core<true>(acc, [&](int r) { return wo + (size_t)(rt * 128 + r) * 1024 + hd * 256; }, [&](int r) { return kv + (size_t)(b * 256 + key0 + r) * 2048 + 1024 + hd * 256; }, 4, smem);
        out = (f16*)(WS + OFF_XN) + (size_t)(L * 4 + b) * 1024 * 1024;
    }
    if (which == 0) {
        const float* g1 = IN(25) + L * 1024; const float* b1 = IN(26) + L * 1024;
        float* up = (float*)(WS + OFF_XUP) + (size_t)(L * 4 + b) * 1024 * 16; float* cp = (float*)(WS + OFF_XCP) + (size_t)(L * 4 + b) * 1024 * 16;
#pragma unroll
        for (int m = 0; m < 4; ++m) {
            const int row = rt * 128 + wr * 64 + m * 16 + fr;
            float us = 0.f, cs = 0.f;
#pragma unroll
            for (int n = 0; n < 4; ++n) {
                const int k = ct * 128 + wc * 64 + n * 16 + 4 * fq;
                const f16x4 xm = cvt4(acc[m][n] * *(const f32x4*)(g1 + k));
                __builtin_nontemporal_store(xm, (f16x4*)(out + (size_t)row * 1024 + k));
                const f32x4 xr = cvt4f(xm), cb = acc[m][n] * *(const f32x4*)(b1 + k);
                us += (xr[0] + xr[1]) + (xr[2] + xr[3]); cs += (cb[0] + cb[1]) + (cb[2] + cb[3]);
            }
            us += __shfl_xor(us, 16); us += __shfl_xor(us, 32); cs += __shfl_xor(cs, 16); cs += __shfl_xor(cs, 32);
            if (fq == 0) { up[(size_t)row * 16 + ct * 2 + wc] = us; cp[(size_t)row * 16 + ct * 2 + wc] = cs; }
        }
        return;
    }
#pragma unroll
    for (int m = 0; m < 4; ++m)
#pragma unroll
        for (int n = 0; n < 4; ++n)
            __builtin_nontemporal_store(cvt4(acc[m][n]), (f16x4*)(out + (size_t)(rt * 128 + wr * 64 + m * 16 + fr) * 1024 + ct * 128 + wc * 64 + n * 16 + 4 * fq));
}

__device__ __forceinline__ void xa_uc_reduce(const Params& p, int lo) {
    const float* up = (const float*)(WS + OFF_XUP); const float* cp = (const float*)(WS + OFF_XCP);
    float* xu = (float*)(WS + OFF_XU); float* xc = (float*)(WS + OFF_XC);
    for (int i = lo + BID * 256 + TID; i < lo + 8 * 1024; i += NBLK * 256) {
        float a = 0.f, c = 0.f;
#pragma unroll
        for (int q4 = 0; q4 < 4; ++q4) { const f32x4 v = *(const f32x4*)(up + (size_t)i * 16 + q4 * 4), w = *(const f32x4*)(cp + (size_t)i * 16 + q4 * 4); a += (v[0] + v[1]) + (v[2] + v[3]); c += (w[0] + w[1]) + (w[2] + w[3]); }
        xu[i] = a; xc[i] = c;
    }
}

__device__ __forceinline__ void phase_ab_in(const Params& p, int j, char* smem) {
    WAVE_IDS
    const f16* X = (const f16*)(WS + OFF_H16);
    const f16* Wt = (const f16*)(WS + W_ABIN) + (size_t)j * 2816 * 1024;
    f16* P = (f16*)(WS + S_P16);
    GPipe gp{0, 0};
    tile_loop2(128, 22, [&](int rt, int ct, bool hn, int nrt, int nct) {
        f32x4 acc[4][4];
        gemm_core_pf<true>(acc, [&](int a, int, int r) { return X + (size_t)(a * 128 + r) * 1024; }, [&](int, int c, int r) { return Wt + (size_t)(c * 128 + r) * 1024; },
                           rt, ct, 16, hn, nrt, nct, gp, smem);
#pragma unroll
        for (int m = 0; m < 4; ++m)
#pragma unroll
            for (int n = 0; n < 4; ++n)
                *(f16x4*)(P + (size_t)(rt * 128 + wr * 64 + m * 16 + fr) * 2816 + ct * 128 + wc * 64 + n * 16 + 4 * fq) = cvt4(acc[m][n]);
    });
}

__device__ __forceinline__ void phase_shift(const Params& p, int j, int bskip) {
    const f16* P = (const f16*)(WS + S_P16); f16* PS = (f16*)(WS + S_PS16);
    const float* mu = IN(3) + j * 1792;
    const int total = T * 224;
    if (BID < bskip) return;
    const int step = (NBLK - bskip) * 256;
    f16x8 cq[3], pq[3];
    auto load = [&](int i, f16x8& cur, f16x8& prv) {
        const int ii = i < total ? i : 0;
        const int t = ii / 224, c = (ii % 224) * 8;
        cur = *(const f16x8*)(P + (size_t)t * 2816 + c);
        prv = *(const f16x8*)(P + (size_t)(t > 0 ? t - 1 : 0) * 2816 + c);
    };
    int i = (BID - bskip) * 256 + TID;
    load(i, cq[0], pq[0]); load(i + step, cq[1], pq[1]);
    for (; i < total; i += step) {
        load(i + 2 * step, cq[2], pq[2]);
        const int t = i / 224, c = (i % 224) * 8;
        const f16x8 cur = cq[0]; f16x8 prv = pq[0];
        if ((t & (SEQ - 1)) == 0) { for (int e = 0; e < 8; ++e) prv[e] = (f16)0.f; }
        f16x8 o;
        const f32x4 mu0 = *(const f32x4*)(mu + c), mu1 = *(const f32x4*)(mu + c + 4);
#pragma unroll
        for (int e = 0; e < 8; ++e) {
            const float a = (float)cur[e]; float v = a + ((float)prv[e] - a) * (e < 4 ? mu0[e & 3] : mu1[e & 3]);
            if (c >= 1536 && c < 1600) v = tanh_(v);
            else if (c >= 1664) v = sigmoid_(v);
            o[e] = (f16)v;
        }
        *(f16x8*)(PS + (size_t)t * 1792 + c) = o;
        cq[0] = cq[1]; pq[0] = pq[1]; cq[1] = cq[2]; pq[1] = pq[2];
    }
}

__device__ __forceinline__ void phase_lora(const Params& p, int j, char* smem) {
    WAVE_IDS
    const f16* PS = (const f16*)(WS + S_PS16);
    float* WD = (float*)(WS + S_WD32); f16* NKK = (f16*)(WS + S_NKK); f16* BB = (f16*)(WS + S_BB); f16* KP = (f16*)(WS + S_KP);
    f16* G16 = (f16*)(WS + S_G16); float* BSUM = (float*)(WS + S_BSUM);
    const float* w0 = IN(4) + j * 512; const float* a0 = IN(6) + j * 512; const float* k_k = IN(9) + j * 512; const float* k_a = IN(10) + j * 512; const float* r_k = IN(11) + j * 512;
    GPipe gp{0, 0};
    const f16* Wl0 = (const f16*)(WS + W_W2T) + (size_t)j * 512 * 64; const f16* Wl1 = (const f16*)(WS + W_A2T) + (size_t)j * 512 * 64;
    const f16* Wl2 = (const f16*)(WS + W_G2T) + (size_t)j * 512 * 128;
    tile_loop2(128, 12, [&](int rt, int ct, bool hn, int nrt, int nct) {
        const int type = ct >> 2, c4 = ct & 3;
        f32x4 acc[4][4];
        gemm_core_pf<true>(acc, [&](int a, int c, int r) { const int ty = c >> 2; return PS + (size_t)(a * 128 + r) * 1792 + (ty == 0 ? 1536 : (ty == 1 ? 1600 : 1664)); },
                           [&](int, int c, int r) { const int ty = c >> 2, cc = c & 3; return ty == 0 ? Wl0 + (size_t)(cc * 128 + r) * 64 : (ty == 1 ? Wl1 + (size_t)(cc * 128 + r) * 64 : Wl2 + (size_t)(cc * 128 + r) * 128); },
                           rt, ct, type == 2 ? 2 : 1, hn, nrt, nct, gp, smem);
        if (type == 0) {
#pragma unroll
            for (int m = 0; m < 4; ++m)
#pragma unroll
                for (int n = 0; n < 4; ++n) {
                    const int row = rt * 128 + wr * 64 + m * 16 + fr, col = c4 * 128 + wc * 64 + n * 16 + 4 * fq;
                    f32x4 o;
#pragma unroll
                    for (int e = 0; e < 4; ++e) {
                        const float z = -(w0[col + e] + acc[m][n][e]);
                        const float sp = fmaxf(z, 0.f) + __logf(1.0f + __expf(-fabsf(z)));
                        o[e] = __expf(-__expf(-sp - 0.5f));
                    }
                    *(f32x4*)(WD + (size_t)row * 512 + col) = o;
                }
        } else if (type == 1) {
            const int head = c4 * 2 + wc;
#pragma unroll
            for (int m = 0; m < 4; ++m) {
                const int row = rt * 128 + wr * 64 + m * 16 + fr;
                f32x4 av[4], kv[4], kr[4];
                float ss = 0.f, bs = 0.f;
#pragma unroll
                for (int n = 0; n < 4; ++n) {
                    const int col = head * 64 + n * 16 + 4 * fq;
                    const f32x4 kk_ = cvt4f(*(const f16x4*)(PS + (size_t)row * 1792 + 512 + col));
                    const f32x4 rr = cvt4f(*(const f16x4*)(PS + (size_t)row * 1792 + col));
#pragma unroll
                    for (int e = 0; e < 4; ++e) {
                        const float a = sigmoid_(a0[col + e] + acc[m][n][e]);
                        const float kraw = kk_[e] * k_k[col + e];
                        const float kp = kk_[e] * (1.0f + (a - 1.0f) * k_a[col + e]);
                        av[n][e] = a; kr[n][e] = kraw; kv[n][e] = kp;
                        ss += kraw * kraw; bs += rr[e] * kp * r_k[col + e];
                    }
                }
                ss += __shfl_xor(ss, 16); ss += __shfl_xor(ss, 32);
                bs += __shfl_xor(bs, 16); bs += __shfl_xor(bs, 32);
                const float inv = 1.0f / fmaxf(sqrtf(ss), 1e-12f);
#pragma unroll
                for (int n = 0; n < 4; ++n) {
                    const int col = head * 64 + n * 16 + 4 * fq;
                    f32x4 nk_, bb_;
#pragma unroll
                    for (int e = 0; e < 4; ++e) { const float kkn = kr[n][e] * inv; nk_[e] = -kkn; bb_[e] = kkn * av[n][e]; }
                    *(f16x4*)(NKK + (size_t)row * 512 + col) = cvt4(nk_);
                    *(f16x4*)(BB + (size_t)row * 512 + col) = cvt4(bb_);
                    *(f16x4*)(KP + (size_t)row * 512 + col) = cvt4(kv[n]);
                }
                if (fq == 0) BSUM[(size_t)row * 8 + head] = bs;
            }
        } else {
#pragma unroll
            for (int m = 0; m < 4; ++m)
#pragma unroll
                for (int n = 0; n < 4; ++n)
                    *(f16x4*)(G16 + (size_t)(rt * 128 + wr * 64 + m * 16 + fr) * 512 + c4 * 128 + wc * 64 + n * 16 + 4 * fq) = cvt4(acc[m][n]);
        }
    });
}

#if FAST_REC
constexpr int NREC = 128;
constexpr int SEG_C0 = 76;
__device__ __forceinline__ void rwkv_rec(const Params& p, int bh, int q, int c0, int nc, int part, bool wr_end, char* smem) {
    const int tid = TID, lane = tid & 63, wid = tid >> 6;
    const int b = bh >> 3, h = bh & 7;
    const int rl = lane >> 4, ks = lane & 15, vrow = wid * 4 + rl;
    const float* WD = (const float*)(WS + S_WD32); const f16* NKK = (const f16*)(WS + S_NKK); const f16* BB = (const f16*)(WS + S_BB);
    const f16* KP = (const f16*)(WS + S_KP); const f16* PS = (const f16*)(WS + S_PS16); float* Y = (float*)(WS + (part == 2 ? S_YT : S_Y32));
    float* sW = (float*)smem; float* sN = sW + 32 * 64; float* sB = sN + 32 * 64; float* sK = sB + 32 * 64; float* sWR = sK + 32 * 64;
    float* sV = sWR + 32 * 64; float* sS = sV + 32 * 16; float* sY = sS + 32 * 2;
    const size_t tb = (size_t)b * SEQ + (size_t)c0 * 32;
    f32x4 pw0, pw1; f16x8 pn, pb, pk, pr, pv;
    const int pst = tid >> 3, pc8 = tid & 7;
    auto prefetch = [&](int c) {
        const size_t t0 = tb + c * 32;
        const size_t o = (t0 + pst) * 512 + h * 64 + pc8 * 8;
        pw0 = *(const f32x4*)(WD + o); pw1 = *(const f32x4*)(WD + o + 4);
        pn = *(const f16x8*)(NKK + o); pb = *(const f16x8*)(BB + o); pk = *(const f16x8*)(KP + o); pr = *(const f16x8*)(PS + (t0 + pst) * 1792 + h * 64 + pc8 * 8);
        if (tid < 64) { const int st = tid >> 1, hf = tid & 1; pv = *(const f16x8*)(PS + (t0 + st) * 1792 + 1024 + h * 64 + q * 16 + hf * 8); }
    };
    f32x4 S = {0.f, 0.f, 0.f, 0.f};
    if (part == 2) {
#pragma unroll
        for (int e = 0; e < 4; ++e) S[e] = (4 * ks + e == q * 16 + vrow) ? 1.0f : 0.0f;
    }
    BSYNC();
    prefetch(0);
    for (int c = 0; c < nc; ++c) {
        BSYNC();
        if (c > 0) {
#pragma unroll
            for (int i = 0; i < 2; ++i) { const int e = tid + 256 * i, st = e >> 4, r = e & 15; Y[(tb + (c - 1) * 32 + st) * 512 + h * 64 + q * 16 + r] = sY[e]; }
        }
        {
            const int o = tid * 8;
            float br = 0.f, kr = 0.f;
            f32x4 wr0, wr1, n0, n1, b0, b1, k0, k1;
#pragma unroll
            for (int e = 0; e < 4; ++e) {
                const float r0 = (float)pr[e], r1 = (float)pr[4 + e];
                n0[e] = (float)pn[e]; n1[e] = (float)pn[4 + e]; b0[e] = (float)pb[e]; b1[e] = (float)pb[4 + e]; k0[e] = (float)pk[e]; k1[e] = (float)pk[4 + e];
                wr0[e] = pw0[e] * r0; wr1[e] = pw1[e] * r1;
                br += b0[e] * r0 + b1[e] * r1; kr += k0[e] * r0 + k1[e] * r1;
            }
            *(f32x4*)(sW + o) = pw0; *(f32x4*)(sW + o + 4) = pw1; *(f32x4*)(sN + o) = n0; *(f32x4*)(sN + o + 4) = n1;
            *(f32x4*)(sB + o) = b0; *(f32x4*)(sB + o + 4) = b1; *(f32x4*)(sK + o) = k0; *(f32x4*)(sK + o + 4) = k1;
            *(f32x4*)(sWR + o) = wr0; *(f32x4*)(sWR + o + 4) = wr1;
            br += __shfl_xor(br, 1); br += __shfl_xor(br, 2); br += __shfl_xor(br, 4);
            kr += __shfl_xor(kr, 1); kr += __shfl_xor(kr, 2); kr += __shfl_xor(kr, 4);
            if (pc8 == 0) { sS[pst * 2] = br; sS[pst * 2 + 1] = kr; }
            if (tid < 64) {
#pragma unroll
                for (int e = 0; e < 8; ++e) sV[tid * 8 + e] = (part == 2) ? 0.0f : (float)pv[e];
            }
        }
        BSYNC();
        if (c + 1 < nc) prefetch(c + 1);
        float y0 = 0.f, y1 = 0.f;
        f32x4 w4 = *(const f32x4*)(sW + ks * 4), n4 = *(const f32x4*)(sN + ks * 4), b4 = *(const f32x4*)(sB + ks * 4);
        f32x4 k4 = *(const f32x4*)(sK + ks * 4), q4 = *(const f32x4*)(sWR + ks * 4);
        float vv = sV[vrow]; f32x2 sc = *(const f32x2*)(sS);
#pragma unroll
        for (int s = 0; s < 32; ++s) {
            f32x4 w4n = w4, n4n = n4, b4n = b4, k4n = k4, q4n = q4; float vvn = vv; f32x2 scn = sc;
            if (s + 1 < 32) {
                w4n = *(const f32x4*)(sW + (s + 1) * 64 + ks * 4); n4n = *(const f32x4*)(sN + (s + 1) * 64 + ks * 4); b4n = *(const f32x4*)(sB + (s + 1) * 64 + ks * 4);
                k4n = *(const f32x4*)(sK + (s + 1) * 64 + ks * 4); q4n = *(const f32x4*)(sWR + (s + 1) * 64 + ks * 4);
                vvn = sV[(s + 1) * 16 + vrow]; scn = *(const f32x2*)(sS + (s + 1) * 2);
            }
            __builtin_amdgcn_sched_barrier(0);
            float d1 = fmaf(S[3], n4[3], fmaf(S[2], n4[2], fmaf(S[1], n4[1], S[0] * n4[0])));
            float d2 = fmaf(S[3], q4[3], fmaf(S[2], q4[2], fmaf(S[1], q4[1], S[0] * q4[0])));
            d1 = row16_sum(d1); d2 = row16_sum(d2);
            const float y = d2 + d1 * sc[0] + vv * sc[1];
            S = S * w4 + (b4 * d1 + k4 * vv);
            if (s < 16) y0 = (ks == s) ? y : y0; else y1 = (ks == s - 16) ? y : y1;
            __builtin_amdgcn_sched_barrier(0);
            w4 = w4n; n4 = n4n; b4 = b4n; k4 = k4n; q4 = q4n; vv = vvn; sc = scn;
        }
        sY[ks * 16 + vrow] = y0; sY[(16 + ks) * 16 + vrow] = y1;
    }
    BSYNC();
#pragma unroll
    for (int i = 0; i < 2; ++i) { const int e = tid + 256 * i, st = e >> 4, r = e & 15; Y[(tb + (size_t)(nc - 1) * 32 + st) * 512 + h * 64 + q * 16 + r] = sY[e]; }
    if (wr_end) *(f32x4*)((float*)(WS + S_SMID) + ((size_t)bh * 64 + q * 16 + vrow) * 64 + ks * 4) = S;
}
#else
constexpr int NREC = 8;
__device__ __forceinline__ void rwkv_rec(const Params& p, int rb, char*) {
    const int gt = rb * 256 + TID, bh = gt >> 6, v = gt & 63, b = bh >> 3, h = bh & 7;
    const float* WD = (const float*)(WS + S_WD32); const f16* NKK = (const f16*)(WS + S_NKK); const f16* BB = (const f16*)(WS + S_BB);
    const f16* KP = (const f16*)(WS + S_KP); const f16* PS = (const f16*)(WS + S_PS16); float* Y = (float*)(WS + S_Y32);
    float S[64];
#pragma unroll
    for (int k = 0; k < 64; ++k) S[k] = 0.f;
    for (int s = 0; s < SEQ; ++s) {
        const size_t t = (size_t)b * SEQ + s, o = t * 512 + h * 64;
        const float vv = (float)PS[t * 1792 + 1024 + h * 64 + v];
        float sa = 0.f;
#pragma unroll
        for (int k8 = 0; k8 < 8; ++k8) { const f16x8 n8 = *(const f16x8*)(NKK + o + k8 * 8);
#pragma unroll
            for (int e = 0; e < 8; ++e) sa += S[k8 * 8 + e] * (float)n8[e]; }
        float y = 0.f;
#pragma unroll
        for (int k8 = 0; k8 < 8; ++k8) {
            const f16x8 b8 = *(const f16x8*)(BB + o + k8 * 8), kp8 = *(const f16x8*)(KP + o + k8 * 8), r8 = *(const f16x8*)(PS + t * 1792 + h * 64 + k8 * 8);
            const f32x4 wa = *(const f32x4*)(WD + o + k8 * 8), wb = *(const f32x4*)(WD + o + k8 * 8 + 4);
#pragma unroll
            for (int e = 0; e < 8; ++e) {
                const float w = e < 4 ? wa[e & 3] : wb[e & 3];
                const float sn = S[k8 * 8 + e] * w + (sa * (float)b8[e] + vv * (float)kp8[e]);
                S[k8 * 8 + e] = sn; y += sn * (float)r8[e];
            }
        }
        Y[t * 512 + h * 64 + v] = y;
    }
}
#endif

__device__ __forceinline__ void sg_item(const Params& p, int j, int item, char* smem) {
    WAVE_IDS
    const int g = item & 3, bc = item >> 2;
    const f16* P = (const f16*)(WS + S_P16);
    f16* ZT = (f16*)(WS + S_ZT) + (size_t)item * 128 * 128;
    const float* lg = IN(14) + (j * 4 + g) * 128; const float* lb = IN(15) + (j * 4 + g) * 128;
    {
        const int sub = tid & 15, rloc = tid >> 4;
        for (int it = 0; it < 8; ++it) {
            const int s = it * 16 + rloc;
            const f16x8 x = *(const f16x8*)(P + (size_t)(bc * 128 + s) * 2816 + 2304 + g * 128 + sub * 8);
            float z[8], sum = 0.f;
#pragma unroll
            for (int e = 0; e < 8; ++e) { z[e] = gelu_((float)x[e]); sum += z[e]; }
            const float mean = row16_sum(sum) * (1.0f / 128.0f);
            float qq = 0.f;
#pragma unroll
            for (int e = 0; e < 8; ++e) { const float d = z[e] - mean; qq += d * d; }
            const float rstd = rsqrtf(row16_sum(qq) * (1.0f / 128.0f) + 1e-5f);
#pragma unroll
            for (int e = 0; e < 8; ++e) { const int d = sub * 8 + e; ZT[(size_t)d * 128 + s] = (f16)((z[e] - mean) * rstd * lg[d] + lb[d]); }
        }
    }
    asm volatile("s_waitcnt vmcnt(0)" ::: "memory");
    BSYNC();
    const f16* Wm = (const f16*)(WS + W_SGW) + (size_t)(j * 4 + g) * 128 * 128;
    f32x4 acc[4][4];
    gemm_core<true>(acc, [&](int r) { return Wm + (size_t)r * 128; }, [&](int r) { return (const f16*)ZT + (size_t)r * 128; }, 2, smem);
    const float* bs = IN(17) + (j * 4 + g) * 128;
    f16* MIX = (f16*)(WS + S_MIX16);
#pragma unroll
    for (int m = 0; m < 4; ++m)
#pragma unroll
        for (int n = 0; n < 4; ++n) {
            const int tl = wr * 64 + m * 16 + fr, d = wc * 64 + n * 16 + 4 * fq;
            const size_t t = (size_t)bc * 128 + tl;
            const f32x4 u = cvt4f(*(const f16x4*)(P + t * 2816 + 1792 + g * 128 + d));
            f32x4 o;
#pragma unroll
            for (int e = 0; e < 4; ++e) o[e] = gelu_(u[e]) * (acc[m][n][e] + bs[tl]);
            *(f16x4*)(MIX + t * 1024 + 512 + g * 128 + d) = cvt4(o);
        }
}

__device__ __forceinline__ float quad_sum(float x) {
    x += __builtin_bit_cast(float, __builtin_amdgcn_update_dpp(0, __builtin_bit_cast(int, x), 0xB1, 0xf, 0xf, false));
    x += __builtin_bit_cast(float, __builtin_amdgcn_update_dpp(0, __builtin_bit_cast(int, x), 0x4E, 0xf, 0xf, false));
    return x;
}
__device__ __forceinline__ void rwkv_rec4(const Params& p, int bh, int c0, int nc, bool ident, int end_slot, char* smem) {
    const int tid = TID, lane = tid & 63, wid = tid >> 6;
    const int b = bh >> 3, h = bh & 7;
    const int ks = lane & 3, vrow = wid * 16 + (lane >> 2);
    const float* WD = (const float*)(WS + S_WD32); const f16* NKK = (const f16*)(WS + S_NKK); const f16* BB = (const f16*)(WS + S_BB);
    const f16* KP = (const f16*)(WS + S_KP); const f16* PS = (const f16*)(WS + S_PS16); f16* Y = (f16*)(WS + (ident ? S_YT : S_Y32));
    float* sW = (float*)smem; float* sN = sW + 32 * 64; float* sB = sN + 32 * 64; float* sK = sB + 32 * 64; float* sWR = sK + 32 * 64;
    float* sV = sWR + 32 * 64; float* sS = sV + 32 * 64; float* sY = sS + 32 * 2;
    const size_t tb = (size_t)b * SEQ + (size_t)c0 * 32;
    f32x4 pw0, pw1; f16x8 pn, pb, pk, pr, pv;
    const int pst = tid >> 3, pc8 = tid & 7;
    auto prefetch = [&](int c) {
        const size_t t0 = tb + c * 32;
        const size_t o = (t0 + pst) * 512 + h * 64 + pc8 * 8;
        pw0 = *(const f32x4*)(WD + o); pw1 = *(const f32x4*)(WD + o + 4);
        pn = *(const f16x8*)(NKK + o); pb = *(const f16x8*)(BB + o); pk = *(const f16x8*)(KP + o); pr = *(const f16x8*)(PS + (t0 + pst) * 1792 + h * 64 + pc8 * 8);
        pv = *(const f16x8*)(PS + (t0 + pst) * 1792 + 1024 + h * 64 + pc8 * 8);
    };
    f32x4 S[4];
#pragma unroll
    for (int i = 0; i < 4; ++i)
#pragma unroll
        for (int e = 0; e < 4; ++e) S[i][e] = (ident && (i * 16 + ks * 4 + e == vrow)) ? 1.0f : 0.0f;
    BSYNC();
    prefetch(0);
    for (int c = 0; c < nc; ++c) {
        BSYNC();
        if (c > 0) {
#pragma unroll
            for (int i = 0; i < 4; ++i) { const int e = (tid + 256 * i) * 2, st = e >> 6, r = e & 63; *(f16x2*)(Y + (tb + (c - 1) * 32 + st) * 512 + h * 64 + r) = (f16x2){(f16)sY[e], (f16)sY[e + 1]}; }
        }
        {
            const int o = tid * 8;
            float br = 0.f, kr = 0.f;
            f32x4 wr0, wr1, n0, n1, b0, b1, k0, k1, v0, v1;
#pragma unroll
            for (int e = 0; e < 4; ++e) {
                const float r0 = (float)pr[e], r1 = (float)pr[4 + e];
                n0[e] = (float)pn[e]; n1[e] = (float)pn[4 + e]; b0[e] = (float)pb[e]; b1[e] = (float)pb[4 + e]; k0[e] = (float)pk[e]; k1[e] = (float)pk[4 + e];
                v0[e] = ident ? 0.0f : (float)pv[e]; v1[e] = ident ? 0.0f : (float)pv[4 + e];
                wr0[e] = pw0[e] * r0; wr1[e] = pw1[e] * r1;
                br += b0[e] * r0 + b1[e] * r1; kr += k0[e] * r0 + k1[e] * r1;
            }
            *(f32x4*)(sW + o) = pw0; *(f32x4*)(sW + o + 4) = pw1; *(f32x4*)(sN + o) = n0; *(f32x4*)(sN + o + 4) = n1;
            *(f32x4*)(sB + o) = b0; *(f32x4*)(sB + o + 4) = b1; *(f32x4*)(sK + o) = k0; *(f32x4*)(sK + o + 4) = k1;
            *(f32x4*)(sWR + o) = wr0; *(f32x4*)(sWR + o + 4) = wr1; *(f32x4*)(sV + o) = v0; *(f32x4*)(sV + o + 4) = v1;
            br += __shfl_xor(br, 1); br += __shfl_xor(br, 2); br += __shfl_xor(br, 4);
            kr += __shfl_xor(kr, 1); kr += __shfl_xor(kr, 2); kr += __shfl_xor(kr, 4);
            if (pc8 == 0) { sS[pst * 2] = br; sS[pst * 2 + 1] = kr; }
        }
        BSYNC();
        if (c + 1 < nc) prefetch(c + 1);
        float yv[8];
#pragma unroll
        for (int i = 0; i < 8; ++i) yv[i] = 0.f;
        f32x4 n4[4], q4[4], w4[4], b4[4], k4[4];
#pragma unroll
        for (int i = 0; i < 4; ++i) { n4[i] = *(const f32x4*)(sN + i * 16 + ks * 4); q4[i] = *(const f32x4*)(sWR + i * 16 + ks * 4); }
#pragma unroll
        for (int s = 0; s < 32; ++s) {
#pragma unroll
            for (int i = 0; i < 4; ++i) {
                w4[i] = *(const f32x4*)(sW + s * 64 + i * 16 + ks * 4); b4[i] = *(const f32x4*)(sB + s * 64 + i * 16 + ks * 4); k4[i] = *(const f32x4*)(sK + s * 64 + i * 16 + ks * 4);
            }
            const float vv = sV[s * 64 + vrow]; const f32x2 sc = *(const f32x2*)(sS + s * 2);
            __builtin_amdgcn_sched_barrier(0);
#define LO2(v) __builtin_shufflevector(v, v, 0, 1)
#define HI2(v) __builtin_shufflevector(v, v, 2, 3)
            f32x2 a0 = LO2(S[0]) * LO2(n4[0]), a1 = HI2(S[0]) * HI2(n4[0]), c0_ = LO2(S[0]) * LO2(q4[0]), c1_ = HI2(S[0]) * HI2(q4[0]);
#pragma unroll
            for (int i = 1; i < 4; ++i) {
                a0 = __builtin_elementwise_fma(LO2(S[i]), LO2(n4[i]), a0); a1 = __builtin_elementwise_fma(HI2(S[i]), HI2(n4[i]), a1);
                c0_ = __builtin_elementwise_fma(LO2(S[i]), LO2(q4[i]), c0_); c1_ = __builtin_elementwise_fma(HI2(S[i]), HI2(q4[i]), c1_);
            }
            a0 = a0 + a1; c0_ = c0_ + c1_;
            float d1 = a0[0] + a0[1], d2 = c0_[0] + c0_[1];
            __builtin_amdgcn_sched_barrier(0);
            if (s + 1 < 32) {
#pragma unroll
                for (int i = 0; i < 4; ++i) { n4[i] = *(const f32x4*)(sN + (s + 1) * 64 + i * 16 + ks * 4); q4[i] = *(const f32x4*)(sWR + (s + 1) * 64 + i * 16 + ks * 4); }
            }
            __builtin_amdgcn_sched_barrier(0);
            d1 = quad_sum(d1); d2 = quad_sum(d2);
            const float y = d2 + d1 * sc[0] + vv * sc[1];
#pragma unroll
            for (int i = 0; i < 4; ++i) S[i] = S[i] * w4[i] + (b4[i] * d1 + k4[i] * vv);
            yv[s >> 2] = (ks == (s & 3)) ? y : yv[s >> 2];
            __builtin_amdgcn_sched_barrier(0);
        }
#pragma unroll
        for (int i = 0; i < 8; ++i) sY[(i * 4 + ks) * 64 + vrow] = yv[i];
    }
    BSYNC();
#pragma unroll
    for (int i = 0; i < 4; ++i) { const int e = (tid + 256 * i) * 2, st = e >> 6, r = e & 63; *(f16x2*)(Y + (tb + (size_t)(nc - 1) * 32 + st) * 512 + h * 64 + r) = (f16x2){(f16)sY[e], (f16)sY[e + 1]}; }
    if (end_slot >= 0) {
        float* E = (float*)(WS + S_SEND) + (((size_t)bh * 5 + end_slot) * 64 + vrow) * 64;
#pragma unroll
        for (int i = 0; i < 4; ++i) *(f32x4*)(E + i * 16 + ks * 4) = S[i];
    }
}
__device__ __forceinline__ void phase_rw_combine(const Params& p, char* smem) {
    const int tid = TID, vl = tid >> 4, j4 = (tid & 15) * 4;
    float* sX = (float*)smem; float* sA = sX + 16 * 65;
    for (int item = BID; item < 128; item += NBLK) {
        const int bh = item >> 2, v = (item & 3) * 16 + vl;
        const float* E = (const float*)(WS + S_SEND) + (size_t)bh * 5 * 4096; float* M = (float*)(WS + S_SMID3) + (size_t)bh * 3 * 4096;
        f32x4 x = *(const f32x4*)(E + v * 64 + j4);
        *(f32x4*)(M + v * 64 + j4) = x;
        for (int k = 1; k < 3; ++k) {
            BSYNC();
#pragma unroll
            for (int e = 0; e < 4; ++e) sX[vl * 65 + j4 + e] = x[e];
#pragma unroll
            for (int i = 0; i < 4; ++i) *(f32x4*)(sA + (i * 256 + tid) * 4) = *(const f32x4*)(E + (size_t)(2 + k) * 4096 + (i * 256 + tid) * 4);
            BSYNC();
            x = *(const f32x4*)(E + (size_t)k * 4096 + v * 64 + j4);
#pragma unroll 8
            for (int m = 0; m < 64; ++m) x = x + *(const f32x4*)(sA + m * 64 + j4) * sX[vl * 65 + m];
            *(f32x4*)(M + (size_t)k * 4096 + v * 64 + j4) = x;
        }
    }
}

__device__ __forceinline__ void phase_rec_sg(const Params& p, int j, bool pre, bool segmode, char* smem) {
#if FAST_REC
    (void)segmode;
    const int bid = BID, nb = NBLK;
    constexpr int NRB = 224;
    if (bid < NRB) {
        const int bh = bid / 7, r = bid % 7, seg = (r + 1) >> 1;
        const bool ident = (r > 0) && ((r & 1) == 0);
        const int slot = (seg == 3) ? -1 : (ident ? 2 + seg : seg);
        rwkv_rec4(p, bh, seg * 32, 32, ident, slot, smem);
        BSYNC();
        convert_moe_dyn(p, smem, pre ? 0 : 2, (unsigned*)(WS + OFF_CNT) + (pre ? 128 : 160));
    } else {
        const int hid = bid - NRB, nh = nb - NRB;
        for (int item = hid; item < 512; item += nh) sg_item(p, j, item, smem);
        if (pre) {
            for (int item = hid; item < 1024; item += nh) xa_pre_item(p, item, smem);
            BSYNC();
            convert_late(p, smem, hid, nh);
        } else {
            for (int item = 1024 + hid; item < 2048; item += nh) xa_pre_item(p, item, smem);
        }
        BSYNC();
        convert_moe_dyn(p, smem, pre ? 0 : 2, (unsigned*)(WS + OFF_CNT) + (pre ? 128 : 160));
    }
#else
    if (BID < NREC) rwkv_rec(p, BID, smem);
    else {
        for (int item = BID - NREC; item < 512; item += NBLK - NREC) sg_item(p, j, item, smem);
        if (pre) { for (int item = BID - NREC; item < 2048; item += NBLK - NREC) xa_pre_item(p, item, smem); BSYNC(); convert_moe_dyn(p, smem, 0, (unsigned*)(WS + OFF_CNT) + 128); convert_moe_dyn(p, smem, 2, (unsigned*)(WS + OFF_CNT) + 160); }
    }
#endif
}

__device__ __forceinline__ void phase_rw_fin_seg(const Params& p, int j, char* smem) {
    const int tid = TID, tl = tid >> 2, vq = tid & 3;
    const f16* Y = (const f16*)(WS + S_Y32); const f16* YT = (const f16*)(WS + S_YT); const float* SM = (const float*)(WS + S_SMID3);
    const f16* PS = (const f16*)(WS + S_PS16); const f16* G16 = (const f16*)(WS + S_G16);
    const float* BSUM = (const float*)(WS + S_BSUM); f16* MIX = (f16*)(WS + S_MIX16);
    const float* gg = IN(12) + j * 512; const float* gb = IN(13) + j * 512;
    float* sST = (float*)smem;
    float* sYT = sST + 64 * 64;
    f16x8 yv[2], ytv[2], nyv[2], nytv[2]; f32x4 smv[4], nsmv[4]; f16x8 v8[2], g8[2], nv8[2], ng8[2]; float bsum, nbsum;
    auto load = [&](int item, f16x8 (&a)[2], f16x8 (&bt)[2], f32x4 (&sm)[4], f16x8 (&vv)[2], f16x8 (&gv)[2], float& bs) {
        const int it = item < 2048 ? item : BID;
        const int bh = it >> 6, tile = it & 63, b = bh >> 3, h = bh & 7;
        const size_t t = (size_t)b * SEQ + tile * 64 + tl;
        const int c = h * 64 + vq * 16;
        a[0] = *(const f16x8*)(Y + t * 512 + c); a[1] = *(const f16x8*)(Y + t * 512 + c + 8);
        if (tile >= 16) {
            const int v = tid >> 2, i0 = (tid & 3) * 16;
#pragma unroll
            for (int i4 = 0; i4 < 4; ++i4) sm[i4] = *(const f32x4*)(SM + (((size_t)bh * 3 + (tile >> 4) - 1) * 64 + v) * 64 + i0 + i4 * 4);
            bt[0] = *(const f16x8*)(YT + t * 512 + c); bt[1] = *(const f16x8*)(YT + t * 512 + c + 8);
        }
#pragma unroll
        for (int hf = 0; hf < 2; ++hf) { vv[hf] = *(const f16x8*)(PS + t * 1792 + 1024 + c + hf * 8); gv[hf] = *(const f16x8*)(G16 + t * 512 + c + hf * 8); }
        bs = BSUM[t * 8 + h];
    };
    load(BID, yv, ytv, smv, v8, g8, bsum);
    for (int item = BID; item < 2048; item += NBLK) {
        const int bh = item >> 6, tile = item & 63, b = bh >> 3, h = bh & 7;
        const size_t t = (size_t)b * SEQ + tile * 64 + tl;
        const int c = h * 64 + vq * 16;
        load(item + NBLK, nyv, nytv, nsmv, nv8, ng8, nbsum);
        float y[16];
#pragma unroll
        for (int i4 = 0; i4 < 4; ++i4) { y[i4 * 4] = (float)yv[i4 >> 1][(i4 & 1) * 4]; y[i4 * 4 + 1] = (float)yv[i4 >> 1][(i4 & 1) * 4 + 1]; y[i4 * 4 + 2] = (float)yv[i4 >> 1][(i4 & 1) * 4 + 2]; y[i4 * 4 + 3] = (float)yv[i4 >> 1][(i4 & 1) * 4 + 3]; }
        if (tile >= 16) {
            BSYNC();
            {
                const int v = tid >> 2, i0 = (tid & 3) * 16;
#pragma unroll
                for (int i4 = 0; i4 < 4; ++i4) {
#pragma unroll
                    for (int e = 0; e < 4; ++e) { sST[(i0 + i4 * 4 + e) * 64 + v] = smv[i4][e]; sYT[tl * 65 + vq * 16 + i4 * 4 + e] = (float)ytv[i4 >> 1][(i4 & 1) * 4 + e]; }
                }
            }
            BSYNC();
            for (int i = 0; i < 64; ++i) {
                const float a = sYT[tl * 65 + i];
#pragma unroll
                for (int i4 = 0; i4 < 4; ++i4) { const f32x4 s4 = *(const f32x4*)(sST + i * 64 + vq * 16 + i4 * 4);
                    y[i4 * 4] += a * s4[0]; y[i4 * 4 + 1] += a * s4[1]; y[i4 * 4 + 2] += a * s4[2]; y[i4 * 4 + 3] += a * s4[3]; }
            }
        }
        float sum = 0.f;
#pragma unroll
        for (int e = 0; e < 16; ++e) sum += y[e];
        sum += __shfl_xor(sum, 1); sum += __shfl_xor(sum, 2);
        const float mean = sum * (1.0f / 64.0f);
        float qq = 0.f;
#pragma unroll
        for (int e = 0; e < 16; ++e) { const float d = y[e] - mean; qq += d * d; }
        qq += __shfl_xor(qq, 1); qq += __shfl_xor(qq, 2);
        const float rstd = rsqrtf(qq * (1.0f / 64.0f) + 64e-5f);
#pragma unroll
        for (int hf = 0; hf < 2; ++hf) {
            f16x8 o;
#pragma unroll
            for (int e = 0; e < 8; ++e) {
                const float r = ((y[hf * 8 + e] - mean) * rstd * gg[c + hf * 8 + e] + gb[c + hf * 8 + e] + bsum * (float)v8[hf][e]) * (float)g8[hf][e];
                o[e] = (f16)r;
            }
            *(f16x8*)(MIX + t * 1024 + c + hf * 8) = o;
        }
#pragma unroll
        for (int i4 = 0; i4 < 4; ++i4) smv[i4] = nsmv[i4];
        yv[0] = nyv[0]; yv[1] = nyv[1]; ytv[0] = nytv[0]; ytv[1] = nytv[1];
        v8[0] = nv8[0]; v8[1] = nv8[1]; g8[0] = ng8[0]; g8[1] = ng8[1]; bsum = nbsum;
    }
}

__device__ __forceinline__ void phase_rw_fin(const Params& p, int j) {
    const int lane = TID & 63, gw = BID * 4 + (TID >> 6), nw = NBLK * 4;
    const float* Y = (const float*)(WS + S_Y32); const f16* PS = (const f16*)(WS + S_PS16); const f16* G16 = (const f16*)(WS + S_G16);
    const float* BSUM = (const float*)(WS + S_BSUM); f16* MIX = (f16*)(WS + S_MIX16);
    const float* gg = IN(12) + j * 512; const float* gb = IN(13) + j * 512;
    for (int t = gw; t < T; t += nw) {
        const int c = lane * 8, head = lane >> 3;
        const f32x4 y0 = *(const f32x4*)(Y + (size_t)t * 512 + c), y1 = *(const f32x4*)(Y + (size_t)t * 512 + c + 4);
        float s = (y0[0] + y0[1]) + (y0[2] + y0[3]) + (y1[0] + y1[1]) + (y1[2] + y1[3]);
        s += __shfl_xor(s, 1); s += __shfl_xor(s, 2); s += __shfl_xor(s, 4);
        const float mean = s * (1.0f / 64.0f);
        float qq = 0.f;
#pragma unroll
        for (int e = 0; e < 4; ++e) { const float d0 = y0[e] - mean, d1 = y1[e] - mean; qq += d0 * d0 + d1 * d1; }
        qq += __shfl_xor(qq, 1); qq += __shfl_xor(qq, 2); qq += __shfl_xor(qq, 4);
        const float rstd = rsqrtf(qq * (1.0f / 64.0f) + 64e-5f);
        const float bsum = BSUM[(size_t)t * 8 + head];
        const f16x8 v8 = *(const f16x8*)(PS + (size_t)t * 1792 + 1024 + c), g8 = *(const f16x8*)(G16 + (size_t)t * 512 + c);
        f16x8 o;
#pragma unroll
        for (int e = 0; e < 8; ++e) {
            const float yv = e < 4 ? y0[e & 3] : y1[e & 3];
            const float r = ((yv - mean) * rstd * gg[c + e] + gb[c + e] + bsum * (float)v8[e]) * (float)g8[e];
            o[e] = (f16)r;
        }
        *(f16x8*)(MIX + (size_t)t * 1024 + c) = o;
    }
}

__device__ __forceinline__ void phase_mla_in(const Params& p, int j, char* smem) {
    WAVE_IDS
    const f16* X = (const f16*)(WS + OFF_H16);
    const f16* Wt = (const f16*)(WS + W_MLAIN) + (size_t)j * 640 * 1024;
    f16* CQKV = (f16*)(WS + S_CQKV); f16* KPE = (f16*)(WS + S_KPE); float* SSQ = (float*)(WS + S_SSQ);
    const f32x2* rope = (const f32x2*)(WS + OFF_ROPE);
    GPipe gp{0, 0};
    tile_loop2(128, 5, [&](int rt, int ct, bool hn, int nrt, int nct) {
        f32x4 acc[4][4];
        gemm_core_pf<true>(acc, [&](int a, int, int r) { return X + (size_t)(a * 128 + r) * 1024; }, [&](int, int c, int r) { return Wt + (size_t)(c * 128 + r) * 1024; },
                           rt, ct, 16, hn, nrt, nct, gp, smem);
        if (ct < 4) {
#pragma unroll
            for (int m = 0; m < 4; ++m) {
                const int row = rt * 128 + wr * 64 + m * 16 + fr;
                float ss = 0.f;
#pragma unroll
                for (int n = 0; n < 4; ++n) {
                    *(f16x4*)(CQKV + (size_t)row * 512 + ct * 128 + wc * 64 + n * 16 + 4 * fq) = cvt4(acc[m][n]);
                    const f32x4 a = acc[m][n]; ss += (a[0] * a[0] + a[1] * a[1]) + (a[2] * a[2] + a[3] * a[3]);
                }
                ss += __shfl_xor(ss, 16); ss += __shfl_xor(ss, 32);
                if (fq == 0) SSQ[(size_t)row * 8 + ct * 2 + wc] = ss;
            }
        } else if (wc == 0) {
#pragma unroll
            for (int m = 0; m < 4; ++m) {
                const int row = rt * 128 + wr * 64 + m * 16 + fr, pos = row & (SEQ - 1);
                f32x4 o1, o2;
#pragma unroll
                for (int e = 0; e < 4; ++e) {
                    const f32x2 cs = rope[pos * 16 + 4 * fq + e];
                    const float x1 = acc[m][0][e], x2 = acc[m][1][e];
                    o1[e] = x1 * cs[0] - x2 * cs[1]; o2[e] = x1 * cs[1] + x2 * cs[0];
                }
                *(f16x4*)(KPE + (size_t)row * 32 + 4 * fq) = cvt4(o1);
                *(f16x4*)(KPE + (size_t)row * 32 + 16 + 4 * fq) = cvt4(o2);
            }
        }
    });
}

__device__ __forceinline__ void phase_mla_qkv(const Params& p, int j, char* smem) {
    WAVE_IDS
    const f16* CQKV = (const f16*)(WS + S_CQKV);
    f16* Q16 = (f16*)(WS + S_Q16); f16* KN = (f16*)(WS + S_KN16); f16* VT = (f16*)(WS + S_VT16);
    const f32x2* rope = (const f32x2*)(WS + OFF_ROPE);
    const float* SSQ = (const float*)(WS + S_SSQ);
    GPipe gp{0, 0};
    const f16* Wqb = (const f16*)(WS + W_Q) + (size_t)j * 1536 * 256; const f16* Wkvb = (const f16*)(WS + W_KV) + (size_t)j * 2048 * 256;
    auto xpf = [&](int a, int c, int r) { return CQKV + (size_t)(a * 128 + r) * 512 + (c < 12 ? 0 : 256); };
    auto wpf = [&](int, int c, int r) { return c < 12 ? Wqb + (size_t)(c * 128 + r) * 256 : Wkvb + (size_t)((c - 12) * 128 + r) * 256; };
    tile_loop2(128, 28, [&](int rt, int ct, bool hn, int nrt, int nct) {
        const bool isq = ct < 12;
        auto rrow = [&](int rl) { const f32x4 q4 = *(const f32x4*)(SSQ + (size_t)(rt * 128 + rl) * 8 + (isq ? 0 : 4)); return rsqrtf(((q4[0] + q4[1]) + (q4[2] + q4[3])) * (1.0f / 256.0f) + 1e-6f); };
        f32x4 acc[4][4];
        if (isq) {
            gemm_core_pf<true>(acc, xpf, wpf, rt, ct, 4, hn, nrt, nct, gp, smem);
            const int cb = ct * 128 + wc * 64;
#pragma unroll
            for (int m = 0; m < 4; ++m) {
                const int rl = wr * 64 + m * 16 + fr, row = rt * 128 + rl, pos = row & (SEQ - 1);
                const float sc = rrow(rl);
#pragma unroll
                for (int n = 0; n < 4; ++n) acc[m][n] = acc[m][n] * sc;
#pragma unroll
                for (int n = 0; n < 4; n += 2) {
                    if (((cb + n * 16) % 96) == 64) {
#pragma unroll
                        for (int e = 0; e < 4; ++e) {
                            const f32x2 cs = rope[pos * 16 + 4 * fq + e];
                            const float x1 = acc[m][n][e], x2 = acc[m][n + 1][e];
                            acc[m][n][e] = x1 * cs[0] - x2 * cs[1]; acc[m][n + 1][e] = x1 * cs[1] + x2 * cs[0];
                        }
                    }
                }
#pragma unroll
                for (int n = 0; n < 4; ++n) *(f16x4*)(Q16 + (size_t)row * 1536 + cb + n * 16 + 4 * fq) = cvt4(acc[m][n]);
            }
        } else {
            const int c2 = ct - 12;
            if (c2 < 8) {
                gemm_core_pf<true>(acc, xpf, wpf, rt, ct, 4, hn, nrt, nct, gp, smem);
#pragma unroll
                for (int m = 0; m < 4; ++m) {
                    const int rl = wr * 64 + m * 16 + fr; const float sc = rrow(rl);
#pragma unroll
                    for (int n = 0; n < 4; ++n) *(f16x4*)(KN + (size_t)(rt * 128 + rl) * 1024 + c2 * 128 + wc * 64 + n * 16 + 4 * fq) = cvt4(acc[m][n] * sc);
                }
            } else {
                gemm_core_pf<false>(acc, xpf, wpf, rt, ct, 4, hn, nrt, nct, gp, smem);
#pragma unroll
                for (int m = 0; m < 4; ++m) {
                    const int rl = wr * 64 + m * 16 + 4 * fq, row = rt * 128 + rl, b = row >> 12, s = row & (SEQ - 1);
                    f32x4 sc; sc[0] = rrow(rl); sc[1] = rrow(rl + 1); sc[2] = rrow(rl + 2); sc[3] = rrow(rl + 3);
#pragma unroll
                    for (int n = 0; n < 4; ++n) {
                        const int col = (c2 - 8) * 128 + wc * 64 + n * 16 + fr, h = col >> 6, d = col & 63;
                        *(f16x4*)(VT + ((size_t)((b * 16 + h) * 64 + d)) * SEQ + s) = cvt4(acc[m][n] * sc);
                    }
                }
            }
        }
    });
}

__device__ __forceinline__ f32x4 mfma16(f16x8 a, f16x8 b, f32x4 c) { return __builtin_amdgcn_mfma_f32_16x16x32_f16(a, b, c, 0, 0, 0); }
__device__ __forceinline__ f16x8 cat4(f16x4 lo, f16x4 hi) { return __builtin_shufflevector(lo, hi, 0, 1, 2, 3, 4, 5, 6, 7); }

__device__ __forceinline__ void phase_mla_attn(const Params& p, char* smem) {
    const int tid = TID, lane = tid & 63, wid = tid >> 6, li = lane & 15, g = lane >> 4;
    const f16* Q16 = (const f16*)(WS + S_Q16); const f16* KN = (const f16*)(WS + S_KN16); const f16* KPE = (const f16*)(WS + S_KPE);
    const f16* VT = (const f16*)(WS + S_VT16); f16* O = (f16*)(WS + S_MIX16);
    constexpr int BUF = 20480;
    const int sc8 = ((tid & 7) ^ ((tid >> 4) & 7)) * 8;
    const int scp = ((tid & 3) ^ ((0x78 >> (2 * ((tid >> 4) & 3))) & 3)) * 8;
    const int kn_rd0 = ((0 + g) ^ (li >> 1)) * 16, kn_rd1 = ((4 + g) ^ (li >> 1)) * 16;
    const int kp_rd = (g ^ ((0x78 >> (2 * ((li >> 2) & 3))) & 3)) * 16;
    const int v_rd[4] = {(((0 + (g >> 1)) ^ (li >> 1)) * 16) + (g & 1) * 8, (((2 + (g >> 1)) ^ (li >> 1)) * 16) + (g & 1) * 8,
                         (((4 + (g >> 1)) ^ (li >> 1)) * 16) + (g & 1) * 8, (((6 + (g >> 1)) ^ (li >> 1)) * 16) + (g & 1) * 8};
    const int nb_ = NBLK, xcd_ = BID & 7, lb_ = BID >> 3, nlb_ = nb_ >> 3;
    for (int j_ = lb_; j_ < 128; j_ += nlb_) {
        const int bh = xcd_ * 8 + (j_ >> 4), pr = j_ & 15, b = bh >> 4, h = bh & 15;
        const size_t tb = (size_t)b * SEQ;
        for (int half = 0; half < 2; ++half) {
            const int qb = half ? pr : 31 - pr;
            const int qw = qb * 128 + wid * 32;
            const int nch = 2 * qb + 2, lastw = (qw + 31) >> 6;
            f16x8 Qf[2][3];
#pragma unroll
            for (int jq = 0; jq < 2; ++jq)
#pragma unroll
                for (int ks = 0; ks < 3; ++ks) Qf[jq][ks] = *(const f16x8*)(Q16 + (tb + qw + jq * 16 + li) * 1536 + h * 96 + ks * 32 + 8 * g);
            asm volatile("s_waitcnt vmcnt(0)" ::: "memory");
#pragma unroll
            for (int jq = 0; jq < 2; ++jq)
#pragma unroll
                for (int ks = 0; ks < 3; ++ks) asm volatile("" : "+v"(Qf[jq][ks]));
            f32x4 Oa[5][2];
#pragma unroll
            for (int vb = 0; vb < 5; ++vb) { Oa[vb][0] = (f32x4){0.f, 0.f, 0.f, 0.f}; Oa[vb][1] = (f32x4){0.f, 0.f, 0.f, 0.f}; }
            f16x8 ones;
#pragma unroll
            for (int e = 0; e < 8; ++e) ones[e] = (f16)1.0f;
            const f16* kn_src = KN + (tb + (tid >> 3)) * 1024 + h * 64 + sc8;
            const f16* kp_src = KPE + (tb + (tid >> 2)) * 32 + scp;
            const f16* v_src = VT + ((size_t)((b * 16 + h) * 64 + (tid >> 3))) * SEQ + sc8;
            auto stage = [&](int kc, int s) {
                char* base = smem + s * BUF + tid * 16;
                __builtin_amdgcn_global_load_lds((const void*)(kn_src + (size_t)kc * 64 * 1024), (LAS void*)(base), 16, 0, 0);
                __builtin_amdgcn_global_load_lds((const void*)(kn_src + (size_t)(kc * 64 + 32) * 1024), (LAS void*)(base + 4096), 16, 0, 0);
                __builtin_amdgcn_global_load_lds((const void*)(v_src + kc * 64), (LAS void*)(base + 8192), 16, 0, 0);
                __builtin_amdgcn_global_load_lds((const void*)(v_src + (size_t)32 * SEQ + kc * 64), (LAS void*)(base + 8192 + 4096), 16, 0, 0);
                __builtin_amdgcn_global_load_lds((const void*)(kp_src + (size_t)kc * 64 * 32), (LAS void*)(base + 16384), 16, 0, 0);
            };
            BSYNC();
            stage(0, 0);
            if (nch > 1) stage(1, 1);
            asm volatile(".p2align 8");
            for (int kc = 0; kc < nch; ++kc) {
                const int s = kc % 3;
                if (kc + 1 < nch) asm volatile("s_waitcnt vmcnt(5) lgkmcnt(0)" ::: "memory"); else asm volatile("s_waitcnt vmcnt(0) lgkmcnt(0)" ::: "memory");
                __builtin_amdgcn_s_barrier();
                asm volatile("" ::: "memory");
                if (kc + 2 < nch) stage(kc + 2, (kc + 2) % 3);
                if (kc > lastw) continue;
                const char* bK = smem + s * BUF; const char* bV = bK + 8192; const char* bP = bK + 16384;
                f32x4 Sx[4][2];
#pragma unroll
                for (int kb = 0; kb < 4; ++kb) { Sx[kb][0] = (f32x4){-8.f, -8.f, -8.f, -8.f}; Sx[kb][1] = (f32x4){-8.f, -8.f, -8.f, -8.f}; }
#pragma unroll
                for (int kb = 0; kb < 4; ++kb) {
                    const f16x8 K0 = *(const f16x8*)(bK + (kb * 16 + li) * 128 + kn_rd0);
                    const f16x8 K1 = *(const f16x8*)(bK + (kb * 16 + li) * 128 + kn_rd1);
                    const f16x8 K2 = *(const f16x8*)(bP + (kb * 16 + li) * 64 + kp_rd);
                    Sx[kb][0] = mfma16(K0, Qf[0][0], Sx[kb][0]); Sx[kb][1] = mfma16(K0, Qf[1][0], Sx[kb][1]);
                    Sx[kb][0] = mfma16(K1, Qf[0][1], Sx[kb][0]); Sx[kb][1] = mfma16(K1, Qf[1][1], Sx[kb][1]);
                    Sx[kb][0] = mfma16(K2, Qf[0][2], Sx[kb][0]); Sx[kb][1] = mfma16(K2, Qf[1][2], Sx[kb][1]);
                }
                if (kc * 64 + 63 > qw) {
#pragma unroll
                    for (int jq = 0; jq < 2; ++jq) {
                        const int qpos = qw + jq * 16 + li;
#pragma unroll
                        for (int kb = 0; kb < 4; ++kb)
#pragma unroll
                            for (int r = 0; r < 4; ++r)
                                if (kc * 64 + kb * 16 + 4 * g + r > qpos) Sx[kb][jq][r] = -1e4f;
                    }
                }
                f16x8 Pf[2][2];
#pragma unroll
                for (int jq = 0; jq < 2; ++jq) {
#pragma unroll
                    for (int kb = 0; kb < 4; ++kb)
#pragma unroll
                        for (int r = 0; r < 4; ++r) Sx[kb][jq][r] = __builtin_amdgcn_exp2f(Sx[kb][jq][r]);
                    Pf[jq][0] = cat4(cvt4(Sx[0][jq]), cvt4(Sx[1][jq]));
                    Pf[jq][1] = cat4(cvt4(Sx[2][jq]), cvt4(Sx[3][jq]));
                }
#pragma unroll
                for (int kp = 0; kp < 2; ++kp) {
#pragma unroll
                    for (int vb = 0; vb < 4; ++vb) {
                        const char* vp = bV + (vb * 16 + li) * 128;
                        const f16x8 Vf = cat4(*(const f16x4*)(vp + v_rd[kp * 2]), *(const f16x4*)(vp + v_rd[kp * 2 + 1]));
                        Oa[vb][0] = mfma16(Vf, Pf[0][kp], Oa[vb][0]);
                        Oa[vb][1] = mfma16(Vf, Pf[1][kp], Oa[vb][1]);
                    }
                    Oa[4][0] = mfma16(ones, Pf[0][kp], Oa[4][0]);
                    Oa[4][1] = mfma16(ones, Pf[1][kp], Oa[4][1]);
                }
            }
#pragma unroll
            for (int jq = 0; jq < 2; ++jq) {
                const float inv = 1.0f / Oa[4][jq][0];
#pragma unroll
                for (int vb = 0; vb < 4; ++vb)
                    *(f16x4*)(O + (tb + qw + jq * 16 + li) * 1024 + h * 64 + vb * 16 + 4 * g) = cvt4(Oa[vb][jq] * inv);
            }
        }
    }
}

__device__ __forceinline__ void phase_xa_scores(const Params& p, int L, char* smem) {
    WAVE_IDS
    const f16* X = (const f16*)(WS + S_Y32R); const float* PST = (const float*)(WS + S_PST1);
    const float* XU = (const float*)(WS + OFF_XU) + (size_t)(L * 4) * 1024; const float* XC = (const float*)(WS + OFF_XC) + (size_t)(L * 4) * 1024;
    f16* XP = (f16*)(WS + S_XP16); float* LP = (float*)(WS + S_XLP);
    float* srow = (float*)(smem + SMEM_MAIN + 1024);
    GPipe gp{0, 0};
    const f16* XMb = (const f16*)(WS + OFF_XM) + (size_t)(L * 4) * 1024 * 1024;
    tile_loop2(128, 8, [&](int rt, int ct, bool hn, int nrt, int nct) {
        row_stats_table(PST, [&](int r) { return rt * 128 + r; }, srow);
        f32x4 acc[4][4];
        gemm_core_pf<true>(acc, [&](int a, int, int r) { return X + (size_t)(a * 128 + r) * 1024; },
                           [&](int a, int c, int r) { return XMb + (size_t)(a >> 5) * 1024 * 1024 + (size_t)(c * 128 + r) * 1024; }, rt, ct, 16, hn, nrt, nct, gp, smem);
        f32x4 u4[4], c4[4];
#pragma unroll
        for (int n = 0; n < 4; ++n) { const int col = (rt >> 5) * 1024 + ct * 128 + wc * 64 + n * 16 + 4 * fq; u4[n] = *(const f32x4*)(XU + col); c4[n] = *(const f32x4*)(XC + col); }
#pragma unroll
        for (int m = 0; m < 4; ++m) {
            const int row = rt * 128 + wr * 64 + m * 16 + fr;
            const f32x2 st = *(const f32x2*)(srow + (wr * 64 + m * 16 + fr) * 2);
            float ps = 0.f;
#pragma unroll
            for (int n = 0; n < 4; ++n) {
                const f32x4 sc = (acc[m][n] - u4[n] * st[0]) * st[1] + c4[n];
                f32x4 e;
#pragma unroll
                for (int q = 0; q < 4; ++q) e[q] = __builtin_amdgcn_exp2f(sc[q] - 8.0f);
                const f16x4 e16 = cvt4(e);
                const f32x4 er = cvt4f(e16);
                ps += (er[0] + er[1]) + (er[2] + er[3]);
                *(f16x4*)(XP + (size_t)row * 1024 + ct * 128 + wc * 64 + n * 16 + 4 * fq) = e16;
            }
            ps += __shfl_xor(ps, 16); ps += __shfl_xor(ps, 32);
            if (fq == 0) LP[(size_t)row * 16 + ct * 2 + wc] = ps;
        }
    });
}

__device__ __forceinline__ void phase_router(const Params& p, int L, char* smem) {
    WAVE_IDS
    const f16* X = (const f16*)(WS + S_Y32R);
    const float* PST = (const float*)(WS + S_PST2); const float* ruc = (const float*)(WS + OFF_RUC) + L * 128;
    float* srow = (float*)(smem + SMEM_MAIN + 1024);
    const f16* Wt = (const f16*)(WS + W_ROUTER) + (size_t)L * 128 * 1024;
    unsigned* cnt = (unsigned*)(WS + OFF_CNT) + L * 32;
    unsigned* list = (unsigned*)(WS + S_LIST); float* gates = (float*)(WS + S_GATES);
    const float* bg = IN(33) + L * 4; const float* be = IN(35) + L * 32;
    float* lg = (float*)smem;
    int* hist = (int*)(smem + 128 * 40 * 4); int* base = hist + 32;
    for (int rt = BID; rt < 128; rt += NBLK) {
        row_stats_table(PST, [&](int r) { return rt * 128 + r; }, srow);
        f32x4 acc[4][4];
        gemm_core<true>(acc, [&](int r) { return X + (size_t)(rt * 128 + r) * 1024; }, [&](int r) { return Wt + (size_t)r * 1024; }, 16, smem);
        BSYNC();
        if (wc == 0) {
#pragma unroll
            for (int m = 0; m < 4; ++m) {
                const int row = wr * 64 + m * 16 + fr;
                const f32x2 st = *(const f32x2*)(srow + row * 2);
#pragma unroll
                for (int n = 0; n < 3; ++n) {
                    const int col = n * 16 + 4 * fq;
                    if (col < 40) *(f32x4*)(lg + row * 40 + col) = (acc[m][n] - *(const f32x4*)(ruc + col) * st[0]) * st[1] + *(const f32x4*)(ruc + 64 + col);
                }
            }
        }
        if (tid < 32) hist[tid] = 0;
        BSYNC();
        int e0 = 0, e1 = 0, p0 = 0, p1 = 0; float g0 = 0.f, g1 = 0.f;
        if (tid < 128) {
            const float* l = lg + tid * 40;
            int grp = 0; float gm = l[0] + bg[0];
            for (int i = 1; i < 4; ++i) { const float v = l[i] + bg[i]; if (v > gm) { gm = v; grp = i; } }
            float den = 0.f;
            for (int i = 0; i < 4; ++i) den += __expf(l[i] + bg[i] - gm);
            const float pg = 1.0f / den;
            int i1 = 0; float v1 = l[4 + grp * 8] + be[grp * 8];
            for (int i = 1; i < 8; ++i) { const float v = l[4 + grp * 8 + i] + be[grp * 8 + i]; if (v > v1) { v1 = v; i1 = i; } }
            int i2 = -1; float v2 = -3.0e38f;
            for (int i = 0; i < 8; ++i) { const float v = l[4 + grp * 8 + i] + be[grp * 8 + i]; if (i != i1 && v > v2) { v2 = v; i2 = i; } }
            const float ex = __expf(v2 - v1);
            g0 = pg / (1.0f + ex); g1 = pg * ex / (1.0f + ex);
            e0 = grp * 8 + i1; e1 = grp * 8 + i2;
            p0 = atomicAdd(&hist[e0], 1); p1 = atomicAdd(&hist[e1], 1);
        }
        BSYNC();
        if (tid < 32) base[tid] = hist[tid] ? (int)atomicAdd(&cnt[tid], (unsigned)hist[tid]) : 0;
        BSYNC();
        if (tid < 128) {
            const int t = rt * 128 + tid;
            list[(size_t)e0 * 16384 + base[e0] + p0] = (unsigned)(t * 2);
            list[(size_t)e1 * 16384 + base[e1] + p1] = (unsigned)(t * 2 + 1);
            gates[t * 2] = g0; gates[t * 2 + 1] = g1;
        }
    }
}

__device__ __forceinline__ void moe_blocks(const Params& p, int L, char* smem, int* bs) {
    const unsigned* cnt = (const unsigned*)(WS + OFF_CNT) + L * 32;
    BSYNC();
    if (TID == 0) { int a = 0; for (int e = 0; e < 32; ++e) { bs[e] = a; a += ((int)cnt[e] + 127) >> 7; } bs[32] = a; }
    BSYNC();
}

__device__ __forceinline__ void phase_moe_up(const Params& p, int L, char* smem) {
    WAVE_IDS
    int* bs = (int*)(smem + SMEM_MAIN + 64); int* tab = bs + 40;
    moe_blocks(p, L, smem, bs);
    const unsigned* cnt = (const unsigned*)(WS + OFF_CNT) + L * 32; const unsigned* list = (const unsigned*)(WS + S_LIST);
    const f16* X = (const f16*)(WS + OFF_H16); f16* HB = (f16*)(WS + S_HBUF);
    const f16* Wb = (const f16*)(WS + W_GU);
    const int nitems = bs[32] * 8;
    auto expert_of = [&](int rbg) { int e = 0; for (int i = 1; i < 32; ++i) if (bs[i] <= rbg) e = i; return e; };
    auto ldtok = [&](int item) {
        int r = 0;
        if (item < nitems && tid < 128) {
            const int rbg = item >> 3, e = expert_of(rbg), rb = rbg - bs[e], nrow = (int)cnt[e] - rb * 128;
            if (tid < nrow) r = (int)(list[(size_t)e * 16384 + rb * 128 + tid] >> 1);
        }
        return r;
    };
    int r1 = ldtok(BID), r2 = ldtok(BID + NBLK);
    BSYNC();
    if (tid < 128) tab[tid] = r1;
    BSYNC();
    GPipe gp{0, 0};
    int k = 0;
    for (int item = BID; item < nitems; item += NBLK, ++k) {
        const int cur = k & 1, nxt = cur ^ 1;
        if (tid < 128) tab[nxt * 128 + tid] = r2;
        r2 = ldtok(item + 2 * NBLK);
        const bool hn = item + NBLK < nitems;
        const int rbg = item >> 3, nt = item & 7, e = expert_of(rbg);
        const int item2 = hn ? item + NBLK : item, e2 = expert_of(item2 >> 3);
        f32x4 acc[4][4];
        gemm_core_pf<true>(acc, [&](int a, int, int r) { return X + (size_t)tab[a * 128 + r] * 1024; },
                           [&](int, int c, int r) { return Wb + ((size_t)c * 128 + r) * 1024; },
                           cur, (L * 32 + e) * 8 + nt, 16, hn, nxt, (L * 32 + e2) * 8 + (item2 & 7), gp, smem);
#pragma unroll
        for (int m = 0; m < 4; ++m)
#pragma unroll
            for (int n = 0; n < 2; ++n) {
                f32x4 o;
#pragma unroll
                for (int q = 0; q < 4; ++q) { const float gv = acc[m][n][q]; o[q] = gv * sigmoid_(gv) * acc[m][n + 2][q]; }
                *(f16x4*)(HB + (size_t)(rbg * 128 + wr * 64 + m * 16 + fr) * 512 + nt * 64 + wc * 32 + n * 16 + 4 * fq) = cvt4(o);
            }
    }
}

__device__ __forceinline__ void phase_moe_down(const Params& p, int L, char* smem) {
    WAVE_IDS
    int* bs = (int*)(smem + SMEM_MAIN + 64); int* rowent = bs + 40;
    moe_blocks(p, L, smem, bs);
    const unsigned* cnt = (const unsigned*)(WS + OFF_CNT) + L * 32; const unsigned* list = (const unsigned*)(WS + S_LIST);
    const float* gates = (const float*)(WS + S_GATES);
    const f16* HB = (const f16*)(WS + S_HBUF); f16* FF = (f16*)(WS + S_FF16);
    const int nitems = bs[32] * 4;
    const int nfull = (nitems / NBLK) * NBLK, nrem = nitems - nfull;
    const int nwide = (nrem * 2 <= NBLK) ? nfull : nitems;
    for (int item = BID; item < nwide; item += NBLK) {
        const int rbg = item >> 2, nt = item & 3;
        int e = 0; for (int i = 1; i < 32; ++i) if (bs[i] <= rbg) e = i;
        const int rb = rbg - bs[e], nrow = (int)cnt[e] - rb * 128;
        BSYNC();
        if (tid < 128) rowent[tid] = (tid < nrow) ? (int)list[(size_t)e * 16384 + rb * 128 + tid] : -1;
        BSYNC();
        const f16* Wt = (const f16*)(WS + W_D) + ((size_t)(L * 32 + e) * 1024 + nt * 256) * 512;
        f32x4 acc[8][4];
        gemm_core_w<true>(acc, [&](int r) { return Wt + (size_t)r * 512; }, [&](int r) { return HB + (size_t)(rbg * 128 + r) * 512; }, 16, smem, NoSegW());
#pragma unroll
        for (int n = 0; n < 4; ++n) {
            const int ent = rowent[wc * 64 + n * 16 + fr];
            if (ent >= 0) {
                const float gt = gates[ent];
                f16* dst = FF + ((size_t)(ent & 1) * T + (ent >> 1)) * 1024 + nt * 256 + wr * 128 + 4 * fq;
#pragma unroll
                for (int m = 0; m < 8; ++m) *(f16x4*)(dst + m * 16) = cvt4(acc[m][n] * gt);
            }
        }
    }
    for (int q = BID; q < (nitems - nwide) * 2; q += NBLK) {
        const int item = nwide + (q >> 1), rbg = item >> 2, nt = (item & 3) * 2 + (q & 1);
        int e = 0; for (int i = 1; i < 32; ++i) if (bs[i] <= rbg) e = i;
        const int rb = rbg - bs[e], nrow = (int)cnt[e] - rb * 128;
        BSYNC();
        if (tid < 128) rowent[tid] = (tid < nrow) ? (int)list[(size_t)e * 16384 + rb * 128 + tid] : -1;
        BSYNC();
        const f16* Wt = (const f16*)(WS + W_D) + ((size_t)(L * 32 + e) * 1024 + nt * 128) * 512;
        f32x4 acc[4][4];
        gemm_core<true>(acc, [&](int r) { return HB + (size_t)(rbg * 128 + r) * 512; }, [&](int r) { return Wt + (size_t)r * 512; }, 8, smem);
#pragma unroll
        for (int m = 0; m < 4; ++m) {
            const int ent = rowent[wr * 64 + m * 16 + fr];
            if (ent >= 0) {
                const float gt = gates[ent];
                f16* dst = FF + ((size_t)(ent & 1) * T + (ent >> 1)) * 1024 + nt * 128 + wc * 64 + 4 * fq;
#pragma unroll
                for (int n = 0; n < 4; ++n) *(f16x4*)(dst + n * 16) = cvt4(acc[m][n] * gt);
            }
        }
    }
}

constexpr int NPHASES = 1 + 2 * 13 + 2 * 10;

__global__ void __launch_bounds__(256, 2) trunk_kernel(Params p) {
    __shared__ __attribute__((aligned(16))) char smem[SMEM_BYTES];
    volatile LAS unsigned* st = (volatile LAS unsigned*)(smem + SMEM_MAIN);
#if MEGA
    if (threadIdx.x == 0) { st[0] = 0u; st[1] = 0u; }
    BSYNC();
    const XcdBarrier xb = xcd_barrier_post((unsigned*)(WS + OFF_BAR), st);
#endif
    int ph = 0;
    char* ws = p.ws;
    f16* y16 = (f16*)(ws + S_Y32R); f16* h16 = (f16*)(ws + OFF_H16);
#ifndef ENMASK
#define ENMASK 0xFFFFFFFFu
#endif
#define EN(k) (((ENMASK) >> (k)) & 1u)
#ifndef REPMASK
#define REPMASK 0u
#endif
#ifndef REPN
#define REPN 2
#endif
#define NREP(k) ((((REPMASK) >> (k)) & 1u) ? (1 + REPN) : 1)
#if MEGA
#define STEP(k, ...) do { if (ph >= p.ph_begin && ph < p.ph_end) { if (EN(k)) { for (int rep_ = 0; rep_ < NREP(k); ++rep_) { __VA_ARGS__; } } if (ph + 1 < p.ph_end) xcd_barrier(xb); } ++ph; } while (0)
#else
#define STEP(k, ...) do { if (ph >= p.ph_begin && ph < p.ph_end) { if (EN(k)) { for (int rep_ = 0; rep_ < NREP(k); ++rep_) { __VA_ARGS__; } } } ++ph; } while (0)
#endif
    STEP(0, phase_convert(p, smem));
    for (int L = 0; L < 4; ++L) {
        const int j = L >> 1;
        const float* res32 = (L == 0) ? IN(0) : (const float*)nullptr;
        if ((L & 1) == 0) {
            STEP(1, phase_ab_in(p, j, smem); if (L == 0) phase_memkv(p, smem, NBLK));
            STEP(2, phase_shift(p, j, 0));
            STEP(3, phase_lora(p, j, smem));
            STEP(4, phase_rec_sg(p, j, L == 0, L != 0, smem));
            STEP(5, phase_rw_combine(p, smem));
            STEP(5, phase_rw_fin_seg(p, j, smem); xa_uc_reduce(p, L == 0 ? 0 : 8192));
            STEP(6, phase_gemm_res((const f16*)(ws + S_MIX16), (const f16*)(ws + W_ABOUT) + (size_t)j * 1024 * 1024, res32, h16, y16, (float*)(ws + S_PST1), smem));
        } else {
            STEP(7, phase_mla_in(p, j, smem));
            STEP(8, phase_mla_qkv(p, j, smem));
            STEP(9, phase_mla_attn(p, smem));
            STEP(6, phase_gemm_res((const f16*)(ws + S_MIX16), (const f16*)(ws + W_MLAOUT) + (size_t)j * 1024 * 1024, res32, h16, y16, (float*)(ws + S_PST1), smem));
        }
        STEP(11, phase_xa_scores(p, L, smem));
        STEP(12, phase_xa_out(p, L, y16, smem));
        STEP(13, phase_router(p, L, smem); phase_ln2(y16, IN(30) + L * 1024, IN(31) + L * 1024, h16, 128));
        STEP(14, phase_moe_up(p, L, smem));
        STEP(15, phase_moe_down(p, L, smem));
        STEP(10, phase_ln3(y16, (const f16*)(ws + S_FF16), (const f16*)(ws + S_FF16) + (size_t)T * 1024, IN(30) + L * 1024, IN(31) + L * 1024, IN(39) + L * 1024, IN(40) + L * 1024,
                           (L == 3) ? p.out : (float*)nullptr, (L == 3) ? (f16*)nullptr : h16));
    }
}

}

extern "C" void kernel_launch(void* const* d_in, const int* in_sizes, int n_in, void* d_out, int out_size, void* d_ws, size_t ws_size, hipStream_t stream) {
    (void)in_sizes; (void)n_in; (void)out_size; (void)ws_size;
    static int grid_blocks = 0;
    if (!grid_blocks) {
        int dev = 0, cus = 0, per_cu = 0;
        hipGetDevice(&dev);
        hipDeviceGetAttribute(&cus, hipDeviceAttributeMultiprocessorCount, dev);
        hipOccupancyMaxActiveBlocksPerMultiprocessor(&per_cu, trunk_kernel, 256, 0);
        if (per_cu > 2) per_cu = 2;
        if (per_cu < 1) per_cu = 1;
        grid_blocks = cus * per_cu;
        grid_blocks &= ~7;
    }
    Params p{};
    for (int i = 0; i < 41; ++i) p.in[i] = (const float*)d_in[i];
    p.out = (float*)d_out;
    p.ws = (char*)d_ws;
    hipMemsetAsync((char*)d_ws + OFF_BAR, 0, XCD_BAR_WORDS * 4, stream);
#if MEGA
    p.ph_begin = 0; p.ph_end = NPHASES;
    void* args[] = {&p};
    hipError_t e = hipLaunchCooperativeKernel((const void*)trunk_kernel, dim3(grid_blocks), dim3(256), args, 0, stream);
    if (e != hipSuccess) fprintf(stderr, "cooperative launch failed: %s (grid %d)\n", hipGetErrorString(e), grid_blocks);
#else
    for (int ph = 0; ph < NPHASES; ++ph) {
        p.ph_begin = ph; p.ph_end = ph + 1;
        hipLaunchKernelGGL(trunk_kernel, dim3(grid_blocks), dim3(256), 0, stream, p);
    }
#endif
}
```
